# Optimizing an MI355X kernel written in HIP

```python
import math
import jax
import jax.numpy as jnp
from jax import lax
import numpy as np

D_MODEL = 1024
BATCH = 4
SEQ = 4096
DEPTH = 1
DEC_BATCH = 32
DEC_SEQ = 8
PAST_LEN = 16384
PAGE_SIZE = 128

D_FF = 2816
D_SSM = 2 * D_MODEL
SSD_HEAD_DIM = 64
SSD_HEADS = D_SSM // SSD_HEAD_DIM
SSD_GROUPS = 4
D_STATE = 128
D_CONV = 4
CONV_DIM = D_SSM + 2 * SSD_GROUPS * D_STATE
SSD_CHUNK = 128
ATT_HEAD_DIM = 64
ATT_HEADS = D_MODEL // ATT_HEAD_DIM
KV_HEADS = 4
Q_PER_KV = ATT_HEADS // KV_HEADS
ATT_DIM = ATT_HEADS * ATT_HEAD_DIM
KV_DIM = KV_HEADS * ATT_HEAD_DIM
Q_BLOCK = 128
IN_DIM = D_SSM + CONV_DIM + SSD_HEADS + ATT_DIM + 2 * KV_DIM + ATT_HEADS + 2 * D_MODEL
RMS_EPS = 1e-6

kernel_name = 'hybrid_ssd_fox_macaron_step'


def rmsnorm(x, w):
    xf = x.astype(jnp.float32)
    y = xf * lax.rsqrt(jnp.mean(xf * xf, axis=-1, keepdims=True) + RMS_EPS)
    return (y * w.astype(jnp.float32)).astype(x.dtype)


def swiglu(x, w_gate, w_up, w_down):
    return (jax.nn.silu(x @ w_gate) * (x @ w_up)) @ w_down


def split_combined(proj):
    sizes = [D_SSM, CONV_DIM, SSD_HEADS, ATT_DIM, KV_DIM, KV_DIM, ATT_HEADS, D_MODEL, D_MODEL]
    offsets = [int(o) for o in np.cumsum(sizes)[:-1]]
    return jnp.split(proj, offsets, axis=-1)


def causal_conv(xbc, conv_prev, conv_w, conv_b):
    L = xbc.shape[1]
    xa = jnp.concatenate([conv_prev.astype(xbc.dtype), xbc], axis=1)
    y = conv_b + sum(xa[:, j:j + L] * conv_w[j] for j in range(D_CONV))
    return jax.nn.silu(y), xa[:, L:]


def ssd_scan(xh, dt, A, Bm, Cm, h0):
    f32 = jnp.float32
    b, L, nh, hp = xh.shape
    r = nh // SSD_GROUPS
    Q = min(SSD_CHUNK, L)
    pad = (-L) % Q
    x = xh.astype(f32)
    Bf = Bm.astype(f32)
    Cf = Cm.astype(f32)
    if pad:
        pw = ((0, 0), (0, pad), (0, 0), (0, 0))
        x = jnp.pad(x, pw)
        Bf = jnp.pad(Bf, pw)
        Cf = jnp.pad(Cf, pw)
        dt = jnp.pad(dt, ((0, 0), (0, pad), (0, 0)))
    nc = (L + pad) // Q
    x = x.reshape(b, nc, Q, SSD_GROUPS, r, hp)
    dtc = dt.reshape(b, nc, Q, SSD_GROUPS, r)
    Bc = Bf.reshape(b, nc, Q, SSD_GROUPS, D_STATE)
    Cc = Cf.reshape(b, nc, Q, SSD_GROUPS, D_STATE)
    a = dtc * A.reshape(SSD_GROUPS, r)
    acs = jnp.cumsum(a, axis=2)
    xdt = x * dtc[..., None]
    causal = jnp.tril(jnp.ones((Q, Q), dtype=bool))
    seg = acs[:, :, :, None] - acs[:, :, None, :]
    decay = jnp.exp(jnp.where(causal[None, None, :, :, None, None], seg, -jnp.inf))
    cb = jnp.einsum('bclgn,bcsgn->bclsg', Cc, Bc)
    y_diag = jnp.einsum('bclsgr,bcsgrp->bclgrp', cb[..., None] * decay, xdt)
    states = jnp.einsum('bclgn,bclgr,bclgrp->bcgrpn', Bc, jnp.exp(acs[:, :, -1:] - acs), xdt)
    chunk_decay = jnp.exp(acs[:, :, -1])

    def step(h, inp):
        dec, st = inp
        return dec[..., None, None] * h + st, h

    h_init = h0.astype(f32).reshape(b, SSD_GROUPS, r, hp, D_STATE)
    h_fin, h_prev = lax.scan(step, h_init, (jnp.moveaxis(chunk_decay, 1, 0), jnp.moveaxis(states, 1, 0)))
    h_prev = jnp.moveaxis(h_prev, 0, 1)
    y_off = jnp.einsum('bclgn,bcgrpn,bclgr->bclgrp', Cc, h_prev, jnp.exp(acs))
    y = (y_diag + y_off).reshape(b, nc * Q, nh, hp)[:, :L]
    return y, h_fin.reshape(b, nh, hp, D_STATE).astype(h0.dtype)


def ssd_branch(z, xbc, dt_raw, conv_prev, h0, p):
    b, L, _ = z.shape
    xc, conv_new = causal_conv(xbc, conv_prev, p['conv_w'], p['conv_b'])
    xs, Bm, Cm = jnp.split(xc, [D_SSM, D_SSM + SSD_GROUPS * D_STATE], axis=-1)
    xh = xs.reshape(b, L, SSD_HEADS, SSD_HEAD_DIM)
    Bm = Bm.reshape(b, L, SSD_GROUPS, D_STATE)
    Cm = Cm.reshape(b, L, SSD_GROUPS, D_STATE)
    dt = jax.nn.softplus(dt_raw.astype(jnp.float32) + p['dt_bias'].astype(jnp.float32))
    A = -jnp.exp(p['a_log'].astype(jnp.float32))
    y, h_new = ssd_scan(xh, dt, A, Bm, Cm, h0)
    y = y + p['d_skip'].astype(jnp.float32)[:, None] * xh.astype(jnp.float32)
    yg = y.reshape(b, L, D_SSM) * jax.nn.silu(z.astype(jnp.float32))
    yg = yg.reshape(b, L, SSD_GROUPS, D_SSM // SSD_GROUPS)
    yg = yg * lax.rsqrt(jnp.mean(yg * yg, axis=-1, keepdims=True) + RMS_EPS)
    yg = yg.reshape(b, L, D_SSM) * p['ssd_norm'].astype(jnp.float32)
    return yg.astype(z.dtype), h_new, conv_new


def fox_block(q, k, v, c_q, c_k, q_pos):
    s = jnp.einsum('bqkgd,bskd->bkgqs', q, k).astype(jnp.float32) * (ATT_HEAD_DIM ** -0.5)
    bias = jnp.transpose(c_q, (0, 2, 3, 1))[..., :, None] - jnp.transpose(c_k, (0, 2, 3, 1))[..., None, :]
    mask = jnp.arange(k.shape[1])[None, :] <= q_pos[:, None]
    s = jnp.where(mask, s + bias, -jnp.inf)
    prob = jax.nn.softmax(s, axis=-1)
    return jnp.einsum('bkgqs,bskd->bqkgd', prob.astype(v.dtype), v)


def fox_attention(q, k_all, v_all, logf_all):
    b, T = q.shape[:2]
    S = k_all.shape[1]
    past = S - T
    c = jnp.cumsum(logf_all.astype(jnp.float32), axis=1).reshape(b, S, KV_HEADS, Q_PER_KV)
    c_q = c[:, past:]
    qg = q.reshape(b, T, KV_HEADS, Q_PER_KV, ATT_HEAD_DIM)
    pos = past + jnp.arange(T)
    if T > Q_BLOCK and T % Q_BLOCK == 0:
        nb = T // Q_BLOCK
        qb = jnp.moveaxis(qg.reshape(b, nb, Q_BLOCK, KV_HEADS, Q_PER_KV, ATT_HEAD_DIM), 1, 0)
        cb = jnp.moveaxis(c_q.reshape(b, nb, Q_BLOCK, KV_HEADS, Q_PER_KV), 1, 0)
        o = lax.map(lambda blk: fox_block(blk[0], k_all, v_all, blk[1], c, blk[2]),
                    (qb, cb, pos.reshape(nb, Q_BLOCK)))
        o = jnp.moveaxis(o, 0, 1)
    else:
        o = fox_block(qg, k_all, v_all, c_q, c, pos)
    return o.reshape(b, T, ATT_DIM)


def trunk_layer(x, conv_prev, h0, past, p):
    b, L, _ = x.shape
    h = x + 0.5 * swiglu(rmsnorm(x, p['ffn1_norm']), p['ffn1_w_gate'], p['ffn1_w_up'], p['ffn1_w_down'])
    xn = rmsnorm(h, p['mix_norm'])
    z, xbc, dt_raw, q, k, v, f_raw, g_ssd, g_att = split_combined(xn @ p['w_in'])
    y_ssd, h_new, conv_new = ssd_branch(z, xbc, dt_raw, conv_prev, h0, p)
    q = rmsnorm(q.reshape(b, L, ATT_HEADS, ATT_HEAD_DIM), p['q_norm'])
    k = rmsnorm(k.reshape(b, L, KV_HEADS, ATT_HEAD_DIM), p['k_norm'])
    v = v.reshape(b, L, KV_HEADS, ATT_HEAD_DIM)
    logf = jax.nn.log_sigmoid(f_raw.astype(jnp.float32) + p['b_f'].astype(jnp.float32))
    if past is None:
        k_all, v_all, logf_all = k, v, logf
    else:
        k_past, v_past, logf_past = past
        k_all = jnp.concatenate([k_past.astype(k.dtype), k], axis=1)
        v_all = jnp.concatenate([v_past.astype(v.dtype), v], axis=1)
        logf_all = jnp.concatenate([logf_past.astype(jnp.float32), logf], axis=1)
    y_att = fox_attention(q, k_all, v_all, logf_all)
    merged = (jax.nn.sigmoid(g_ssd) * (y_ssd @ p['w_ssd_proj'])
              + jax.nn.sigmoid(g_att) * (y_att @ p['w_attn_proj']))
    h = h + merged @ p['w_out']
    h = h + 0.5 * swiglu(rmsnorm(h, p['ffn2_norm']), p['ffn2_w_gate'], p['ffn2_w_up'], p['ffn2_w_down'])
    return h, (k, v, logf, h_new, conv_new)


def setup_inputs(seed: int = 0) -> dict:
    key = jax.random.key(seed)
    ks = jax.random.split(key, 40)
    f32 = jnp.float32

    def nrm(k, shape, scale):
        return scale * jax.random.normal(k, shape, f32)

    n_pages = PAST_LEN // PAGE_SIZE
    n_used = DEC_BATCH * n_pages
    n_pool = n_used + max(1, n_used // 4)
    u = jax.random.uniform(ks[10], (DEPTH, SSD_HEADS), f32)
    dt0 = jnp.exp(u * (math.log(0.1) - math.log(0.001)) + math.log(0.001))
    return {
        'x_prompt': nrm(ks[0], (BATCH, SEQ, D_MODEL), 1.0),
        'x_sample': nrm(ks[1], (DEC_BATCH, DEC_SEQ, D_MODEL), 1.0),
        'cache_k': nrm(ks[2], (DEPTH, n_pool, PAGE_SIZE, KV_HEADS, ATT_HEAD_DIM), 1.0),
        'cache_v': nrm(ks[3], (DEPTH, n_pool, PAGE_SIZE, KV_HEADS, ATT_HEAD_DIM), 1.0),
        'cache_logf': jax.nn.log_sigmoid(3.0 + nrm(ks[4], (DEPTH, n_pool, PAGE_SIZE, ATT_HEADS), 1.0)),
        'state_ssm': nrm(ks[5], (DEPTH, DEC_BATCH, SSD_HEADS, SSD_HEAD_DIM, D_STATE), 0.1),
        'state_conv': nrm(ks[6], (DEPTH, DEC_BATCH, D_CONV - 1, CONV_DIM), 1.0),
        'page_table': jax.random.permutation(ks[7], n_pool)[:n_used].reshape(DEC_BATCH, n_pages).astype(jnp.int32),
        'ffn1_norm': 1.0 + nrm(ks[8], (DEPTH, D_MODEL), 0.02),
        'ffn1_w_gate': nrm(ks[9], (DEPTH, D_MODEL, D_FF), D_MODEL ** -0.5),
        'ffn1_w_up': nrm(ks[11], (DEPTH, D_MODEL, D_FF), D_MODEL ** -0.5),
        'ffn1_w_down': nrm(ks[12], (DEPTH, D_FF, D_MODEL), D_FF ** -0.5),
        'mix_norm': 1.0 + nrm(ks[13], (DEPTH, D_MODEL), 0.02),
        'w_in': nrm(ks[14], (DEPTH, D_MODEL, IN_DIM), D_MODEL ** -0.5),
        'conv_w': nrm(ks[15], (DEPTH, D_CONV, CONV_DIM), D_CONV ** -0.5),
        'conv_b': nrm(ks[16], (DEPTH, CONV_DIM), 0.01),
        'dt_bias': dt0 + jnp.log(-jnp.expm1(-dt0)),
        'a_log': jnp.log(jax.random.uniform(ks[17], (DEPTH, SSD_HEADS), f32, minval=1.0, maxval=16.0)),
        'd_skip': 1.0 + nrm(ks[18], (DEPTH, SSD_HEADS), 0.1),
        'ssd_norm': 1.0 + nrm(ks[19], (DEPTH, D_SSM), 0.02),
        'q_norm': 1.0 + nrm(ks[20], (DEPTH, ATT_HEAD_DIM), 0.02),
        'k_norm': 1.0 + nrm(ks[21], (DEPTH, ATT_HEAD_DIM), 0.02),
        'b_f': 3.0 + nrm(ks[22], (DEPTH, ATT_HEADS), 0.5),
        'w_ssd_proj': nrm(ks[23], (DEPTH, D_SSM, D_MODEL), D_SSM ** -0.5),
        'w_attn_proj': nrm(ks[24], (DEPTH, ATT_DIM, D_MODEL), ATT_DIM ** -0.5),
        'w_out': nrm(ks[25], (DEPTH, D_MODEL, D_MODEL), D_MODEL ** -0.5),
        'ffn2_norm': 1.0 + nrm(ks[26], (DEPTH, D_MODEL), 0.02),
        'ffn2_w_gate': nrm(ks[27], (DEPTH, D_MODEL, D_FF), D_MODEL ** -0.5),
        'ffn2_w_up': nrm(ks[28], (DEPTH, D_MODEL, D_FF), D_MODEL ** -0.5),
        'ffn2_w_down': nrm(ks[29], (DEPTH, D_FF, D_MODEL), D_FF ** -0.5),
    }


def reference(x_prompt, x_sample, cache_k, cache_v, cache_logf, state_ssm, state_conv, page_table,
              ffn1_norm, ffn1_w_gate, ffn1_w_up, ffn1_w_down, mix_norm, w_in, conv_w, conv_b,
              dt_bias, a_log, d_skip, ssd_norm, q_norm, k_norm, b_f, w_ssd_proj, w_attn_proj, w_out,
              ffn2_norm, ffn2_w_gate, ffn2_w_up, ffn2_w_down):
    dec_batch, n_pages = page_table.shape
    past_len = n_pages * cache_k.shape[2]
    batch = x_prompt.shape[0]
    yp, ys = x_prompt, x_sample
    prompt_states, sample_states = [], []
    for l in range(DEPTH):
        p = {
            'ffn1_norm': ffn1_norm[l], 'ffn1_w_gate': ffn1_w_gate[l], 'ffn1_w_up': ffn1_w_up[l],
            'ffn1_w_down': ffn1_w_down[l], 'mix_norm': mix_norm[l], 'w_in': w_in[l],
            'conv_w': conv_w[l], 'conv_b': conv_b[l], 'dt_bias': dt_bias[l], 'a_log': a_log[l],
            'd_skip': d_skip[l], 'ssd_norm': ssd_norm[l], 'q_norm': q_norm[l], 'k_norm': k_norm[l],
            'b_f': b_f[l], 'w_ssd_proj': w_ssd_proj[l], 'w_attn_proj': w_attn_proj[l], 'w_out': w_out[l],
            'ffn2_norm': ffn2_norm[l], 'ffn2_w_gate': ffn2_w_gate[l], 'ffn2_w_up': ffn2_w_up[l],
            'ffn2_w_down': ffn2_w_down[l],
        }
        conv0 = jnp.zeros((batch, D_CONV - 1, CONV_DIM), x_prompt.dtype)
        h0 = jnp.zeros((batch, SSD_HEADS, SSD_HEAD_DIM, D_STATE), state_ssm.dtype)
        yp, sp = trunk_layer(yp, conv0, h0, None, p)
        k_past = cache_k[l, page_table].reshape(dec_batch, past_len, KV_HEADS, ATT_HEAD_DIM)
        v_past = cache_v[l, page_table].reshape(dec_batch, past_len, KV_HEADS, ATT_HEAD_DIM)
        logf_past = cache_logf[l, page_table].reshape(dec_batch, past_len, ATT_HEADS)
        ys, ss = trunk_layer(ys, state_conv[l], state_ssm[l], (k_past, v_past, logf_past), p)
        prompt_states.append(sp)
        sample_states.append(ss)
    k_p, v_p, logf_p, ssm_p, conv_p = (jnp.stack(t) for t in zip(*prompt_states))
    k_s, v_s, logf_s, ssm_s, conv_s = (jnp.stack(t) for t in zip(*sample_states))
    return (yp, ys, k_p, v_p, logf_p, ssm_p, conv_p, k_s, v_s, logf_s, ssm_s, conv_s)
```

```cpp
#include <hip/hip_runtime.h>
#include <cstdio>
#include <cstdint>
constexpr int NWAVES = 8;
constexpr int DMODEL = 1024, NBATCH = 4, SEQ = 4096, MP = NBATCH * SEQ, DECB = 32, DECS = 8, MS = DECB * DECS, MT = MP + MS;
constexpr int DFF = 2816, DSSM = 2048, SH = 32, SP = 64, SG = 4, SN = 128, CONVD = 3072, CHUNK = 128, NCHUNK = SEQ / CHUNK;
constexpr int AH = 16, KVH = 4, HD = 64, KVD = 256, INDIM = 8752, NWIN = 35 * 256;
constexpr int PAST = 16384, PAGE = 128, NPAGES = 128;
constexpr size_t O_YP = 0, O_YS = O_YP + (size_t)MP * 1024, O_KP = O_YS + (size_t)MS * 1024, O_VP = O_KP + (size_t)MP * 256, O_LFP = O_VP + (size_t)MP * 256,
    O_SSMP = O_LFP + (size_t)MP * 16, O_CONVP = O_SSMP + (size_t)NBATCH * SH * SP * SN, O_KS = O_CONVP + (size_t)NBATCH * 3 * CONVD, O_VS = O_KS + (size_t)MS * 256,
    O_LFS = O_VS + (size_t)MS * 256, O_SSMS = O_LFS + (size_t)MS * 16, O_CONVS = O_SSMS + (size_t)DECB * SH * SP * SN, O_END = O_CONVS + (size_t)DECB * 3 * CONVD;
static_assert(O_END == 35594240, "d_out map");
constexpr size_t al256(size_t x) { return (x + 255) & ~(size_t)255; }
constexpr size_t WS_CTL = 0, CTL_ZERO_BYTES = 1u << 20;
constexpr int CW_BAR = 4096, CW_Q4 = 8192, CW_QMAX2 = 8256, CW_KMAX2 = 8320;
constexpr size_t CTL_SSQH = 256 * 1024, CTL_SSQH2 = 512 * 1024;
constexpr size_t WS_PAR = al256(WS_CTL + CTL_ZERO_BYTES);
constexpr int PAR_QN = 0, PAR_KN = 64, PAR_DTB = 128, PAR_BF = 160, PAR_ALOG = 192, PAR_DSKIP = 224, PAR_END = 256;
constexpr size_t WS_SSQX = al256(WS_PAR + 4096);
constexpr size_t WS_WGU1 = al256(WS_SSQX + (size_t)MT * 8);
constexpr size_t WS_WD1 = al256(WS_WGU1 + (size_t)5632 * 1024 * 2);
constexpr size_t WS_WIN = al256(WS_WD1 + (size_t)1024 * 2816 * 2);
constexpr size_t WS_WSP = al256(WS_WIN + (size_t)NWIN * 1024 * 2);
constexpr size_t WS_WAP = al256(WS_WSP + (size_t)1024 * 2048 * 2);
constexpr size_t WS_WO = al256(WS_WAP + (size_t)1024 * 1024 * 2);
constexpr size_t WS_WGU2 = al256(WS_WO + (size_t)1024 * 1024 * 2);
constexpr size_t WS_WD2 = al256(WS_WGU2 + (size_t)5632 * 1024 * 2);
constexpr size_t WS_XB = al256(WS_WD2 + (size_t)1024 * 2816 * 2);
constexpr size_t WS_ACT = al256(WS_XB + (size_t)MT * 1024 * 2);
constexpr size_t WS_HB = al256(WS_ACT + (size_t)MT * 2816 * 2);
constexpr size_t WS_Z = al256(WS_HB + (size_t)MT * 1024 * 2);
constexpr size_t WS_XBC = al256(WS_Z + (size_t)MT * 2048 * 2);
constexpr size_t WS_Q = al256(WS_XBC + (size_t)MT * 3072 * 2);
constexpr size_t WS_K = al256(WS_Q + (size_t)MT * 1024 * 2);
constexpr size_t WS_V = al256(WS_K + (size_t)MT * 256 * 2);
constexpr size_t WS_GS = al256(WS_V + (size_t)MT * 256 * 2);
constexpr size_t WS_GA = al256(WS_GS + (size_t)MT * 1024 * 2);
constexpr size_t WS_DT = al256(WS_GA + (size_t)MT * 1024 * 2);
constexpr size_t WS_LOGF = al256(WS_DT + (size_t)MT * 32 * 4);
constexpr size_t WS_XC = al256(WS_LOGF + (size_t)MT * 16 * 4);
constexpr size_t WS_YS = al256(WS_XC + (size_t)MT * 3072 * 2);
constexpr size_t WS_YA = al256(WS_YS + (size_t)MT * 2048 * 2);
constexpr size_t WS_MP = al256(WS_YA + (size_t)MT * 1024 * 2);
constexpr size_t WS_ST = al256(WS_MP + (size_t)MT * 1024 * 4);
constexpr size_t WS_ACS = al256(WS_ST + (size_t)NBATCH * NCHUNK * SH * SP * SN * 2);
constexpr size_t WS_CK = al256(WS_ACS + (size_t)MP * 32 * 4);
constexpr size_t WS_PTOT = al256(WS_CK + (size_t)MP * 16 * 4);
constexpr size_t WS_CPL = al256(WS_PTOT + (size_t)DECB * NPAGES * 16 * 4);
constexpr size_t WS_DPART = al256(WS_CPL + (size_t)DECB * PAST * 16 * 4);
constexpr size_t WS_YRAW = al256(WS_DPART + (size_t)64 * 1024 * 1024);
constexpr size_t WS_MG = al256(WS_YRAW + (size_t)MS * DSSM * 4);
constexpr size_t WS_HS = al256(WS_MG + (size_t)MT * 1024 * 2);
constexpr size_t WS_WD1F8 = al256(WS_HS + (size_t)NBATCH * NCHUNK * SH * SP * SN * 2);
constexpr size_t WS_WD2F8 = al256(WS_WD1F8 + (size_t)1024 * 2816);
constexpr size_t WS_WGU2F8 = al256(WS_WD2F8 + (size_t)1024 * 2816);
constexpr size_t WS_H2F8 = al256(WS_WGU2F8 + (size_t)5632 * 1024);
constexpr size_t WS_END = al256(WS_H2F8 + (size_t)MT * 1024);
constexpr int RING_OFF = 0, RING_BYTES = 131072;
constexpr int LDS_BYTES = 160 * 1024;
constexpr int MISC_OFF = LDS_BYTES - 256;
namespace pg8 {
#define PG8_LAS __attribute__((address_space(3)))
typedef unsigned short bf16_t;
typedef short bf16x8 __attribute__((ext_vector_type(8)));
typedef float f32x4 __attribute__((ext_vector_type(4)));
typedef unsigned u32x4 __attribute__((ext_vector_type(4)));
typedef int v4i __attribute__((ext_vector_type(4)));
typedef unsigned u32x2 __attribute__((ext_vector_type(2)));
typedef int v8i __attribute__((ext_vector_type(8)));
typedef unsigned long long ssq_t;
constexpr float SSQ_ONE = 1048576.f;
__device__ __forceinline__ float ssq_ld(const ssq_t* p, size_t row) { return (float)p[row] * (1.f / SSQ_ONE); }
__device__ __forceinline__ ssq_t ssq_fx(float s) { return (ssq_t)(s * SSQ_ONE + 0.5f); }
template <bool F8> struct FragSel { typedef bf16x8 type; };
template <> struct FragSel<true> { typedef v8i type; };
constexpr int BM = 256, BK = 64, HALF = 128, HTB = HALF * BK * 2  , STAGE_BYTES = 8 * HTB, NXCD = 8, WGM = 8;

__host__ __device__ __forceinline__ int lds_byte(int r, int c) { const int st = (r >> 4) * 2 + (c >> 5), rr = r & 15, cc = c & 31, ob = rr * 64 + cc * 2; return st * 1024 + (ob ^ (((ob >> 9) & 1) << 5)); }
__host__ __device__ __forceinline__ void stage_rc(int b, int& R, int& C) { const int st = b / 1024, sb = b % 1024, swz = sb ^ (((sb >> 9) & 1) << 5); R = (st >> 1) * 16 + swz / 64; C = (st & 1) * 32 + (swz % 64) / 2; }
__host__ __device__ __forceinline__ int perm32(int rho) { const int n = rho >> 4, i = rho & 15; return 8 * (i >> 2) + 4 * n + (i & 3); }

struct Unit { int pm, pn; };
struct Gemm { const bf16_t* A; const bf16_t* Bt; int M, N, K; };

struct StaticOrder {
    int nM, nN, nwg, G, c;
    __host__ __device__ void init(int M, int N, int G_, int c_) { nM = M / BM; nN = N / BM; nwg = nM * nN; G = G_; c = c_; }
    __host__ __device__ bool next(int i, Unit& u) const {
        const long L = (long)i * G + c; if (L >= nwg) return false;
        int wgid = (int)L; { const int q = nwg / NXCD, r = nwg % NXCD, xcd = wgid % NXCD, off = wgid / NXCD; wgid = (xcd < r ? xcd * (q + 1) : r * (q + 1) + (xcd - r) * q) + off; }
        const int nig = WGM * nN, gid = wgid / nig, fm = gid * WGM, gsz = (nM - fm) < WGM ? (nM - fm) : WGM;
        u.pm = fm + ((wgid % nig) % gsz); u.pn = (wgid % nig) / gsz; return true;
    }
    __device__ __forceinline__ void a_ready(const Unit&) const {}
    __device__ __forceinline__ void done(const Unit&) const {}
};

__device__ __forceinline__ unsigned cvt_pk_bf16(float lo, float hi) { unsigned r; asm volatile("v_cvt_pk_bf16_f32 %0, %1, %2" : "=v"(r) : "v"(lo), "v"(hi)); return r; }
typedef float f32x2 __attribute__((ext_vector_type(2)));
constexpr float RMS_EPS_F = 1e-6f;
constexpr float LOG2E_F = 1.4426950408889634f;
constexpr float ATT_C2 = 0.125f * 1.4426950408889634f;
constexpr int MPROMPT = 16384;
__device__ __forceinline__ float sigmoid_f(float x) { return __builtin_amdgcn_rcpf(1.f + __builtin_amdgcn_exp2f(-LOG2E_F * x)); }
__device__ __forceinline__ float silu_f(float x) { return x * sigmoid_f(x); }
__device__ __forceinline__ float softplus_f(float x) { return fmaxf(x, 0.f) + log1pf(expf(-fabsf(x))); }
__device__ __forceinline__ float logsigmoid_f(float x) { return fminf(x, 0.f) - log1pf(expf(-fabsf(x))); }
__device__ __forceinline__ float bf2f(unsigned short b) { return __uint_as_float((unsigned)b << 16); }
__device__ __forceinline__ u32x4 pack8(const f32x4 a, const f32x4 b) { u32x4 w; w.x = cvt_pk_bf16(a[0], a[1]); w.y = cvt_pk_bf16(a[2], a[3]); w.z = cvt_pk_bf16(b[0], b[1]); w.w = cvt_pk_bf16(b[2], b[3]); return w; }
__device__ __forceinline__ void unpack8(const u32x4 w, f32x4& a, f32x4& b) {
    a[0] = __uint_as_float(w.x << 16); a[1] = __uint_as_float(w.x & 0xffff0000u); a[2] = __uint_as_float(w.y << 16); a[3] = __uint_as_float(w.y & 0xffff0000u);
    b[0] = __uint_as_float(w.z << 16); b[1] = __uint_as_float(w.z & 0xffff0000u); b[2] = __uint_as_float(w.w << 16); b[3] = __uint_as_float(w.w & 0xffff0000u); }

constexpr float ACT_F8_SCALE = 4.f, WD_F8_SCALE = 64.f, H2_F8_SCALE = 16.f, WGU_F8_SCALE = 32.f;
__device__ __forceinline__ u32x2 pack8_f8(f32x4 a, f32x4 b, float sc) { int w0 = 0, w1 = 0;
    a = a * sc; b = b * sc;
#pragma unroll
    for (int e = 0; e < 4; ++e) { a[e] = __builtin_amdgcn_fmed3f(a[e], -448.f, 448.f); b[e] = __builtin_amdgcn_fmed3f(b[e], -448.f, 448.f); }
    w0 = __builtin_amdgcn_cvt_pk_fp8_f32(a[0], a[1], w0, false); w0 = __builtin_amdgcn_cvt_pk_fp8_f32(a[2], a[3], w0, true);
    w1 = __builtin_amdgcn_cvt_pk_fp8_f32(b[0], b[1], w1, false); w1 = __builtin_amdgcn_cvt_pk_fp8_f32(b[2], b[3], w1, true);
    u32x2 w; w.x = (unsigned)w0; w.y = (unsigned)w1; return w; }
template <bool F8, bool F8IN = false> struct EpiSwigluT {
    static constexpr bool PERM = true, AFTER_DRAIN = false, FP8 = F8IN;
    bf16_t* O; const ssq_t* ssq; float inv;
    __device__ __forceinline__ void operator()(const f32x4 (&acc)[2][2][4][2], const Unit& u, int wr, int wc, int fr, int fq) const {
        constexpr int ldc = 2816;
        const int row0 = u.pm * BM + wr * 64 + fr, col0 = u.pn * HALF + wc * 32 + 8 * fq;
        const bool f8 = F8 && (u.pm < MPROMPT / BM);
#pragma unroll
        for (int ai = 0; ai < 2; ++ai)
#pragma unroll
            for (int m = 0; m < 4; ++m) { const int row = row0 + ai * HALF + m * 16; const float rs = rsqrtf(ssq_ld(ssq, row) * (1.f / 1024.f) + RMS_EPS_F) * inv;
                f32x4 o[2];
#pragma unroll
                for (int n = 0; n < 2; ++n)
#pragma unroll
                    for (int e = 0; e < 4; ++e) o[n][e] = silu_f(acc[ai][0][m][n][e] * rs) * (acc[ai][1][m][n][e] * rs);
                if (f8) *(u32x2*)((unsigned char*)O + (size_t)row * ldc + col0) = pack8_f8(o[0], o[1], ACT_F8_SCALE);
                else *(u32x4*)(O + (size_t)row * ldc + col0) = pack8(o[0], o[1]); }
    }
};
using EpiSwiglu = EpiSwigluT<false>;
template <bool F8IN, bool OUT8 = false> struct EpiResidT {
    static constexpr bool PERM = true, AFTER_DRAIN = false, FP8 = F8IN;
    const float* resF; const bf16_t* resB; float* outF; bf16_t* outB; ssq_t* ssq; float alpha;
    __device__ __forceinline__ void operator()(const f32x4 (&acc)[2][2][4][2], const Unit& u, int wr, int wc, int fr, int fq) const {
        const int row0 = u.pm * BM + wr * 64 + fr, col0 = u.pn * BM + wc * 32 + 8 * fq;
#pragma unroll
        for (int ai = 0; ai < 2; ++ai)
#pragma unroll
            for (int m = 0; m < 4; ++m) { const size_t row = (size_t)(row0 + ai * HALF + m * 16); float s = 0.f;
#pragma unroll
                for (int bj = 0; bj < 2; ++bj) { const int col = col0 + bj * HALF; f32x4 r0, r1;
                    if (resF) { r0 = *(const f32x4*)(resF + row * 1024 + col); r1 = *(const f32x4*)(resF + row * 1024 + col + 4); } else unpack8(*(const u32x4*)(resB + row * 1024 + col), r0, r1);
                    const f32x4 o0 = r0 + acc[ai][bj][m][0] * alpha, o1 = r1 + acc[ai][bj][m][1] * alpha;
                    if (outF) { *(f32x4*)(outF + row * 1024 + col) = o0; *(f32x4*)(outF + row * 1024 + col + 4) = o1; }
                    if (outB) *(u32x4*)(outB + row * 1024 + col) = pack8(o0, o1);
                    if constexpr (OUT8) *(u32x2*)((unsigned char*)outB + (WS_H2F8 - WS_XB) + row * 1024 + col) = pack8_f8(o0, o1, H2_F8_SCALE);
                    s += (o0[0] * o0[0] + o0[1] * o0[1]) + (o0[2] * o0[2] + o0[3] * o0[3]) + (o1[0] * o1[0] + o1[1] * o1[1]) + (o1[2] * o1[2] + o1[3] * o1[3]); }
                if (ssq) { s += __shfl_xor(s, 16); s += __shfl_xor(s, 32); if (fq == 0) __hip_atomic_fetch_add(ssq + row, ssq_fx(s), __ATOMIC_RELAXED, __HIP_MEMORY_SCOPE_AGENT); } }
    }
};
using EpiResid = EpiResidT<false>;
struct EpiGateMul {
    static constexpr bool PERM = true, AFTER_DRAIN = false, FP8 = false;
    const bf16_t* G; bf16_t* MPb;
    __device__ __forceinline__ void operator()(const f32x4 (&acc)[2][2][4][2], const Unit& u, int wr, int wc, int fr, int fq) const {
        const int row0 = u.pm * BM + wr * 64 + fr, col0 = u.pn * BM + wc * 32 + 8 * fq;
#pragma unroll
        for (int ai = 0; ai < 2; ++ai)
#pragma unroll
            for (int m = 0; m < 4; ++m) { const size_t row = (size_t)(row0 + ai * HALF + m * 16);
#pragma unroll
                for (int bj = 0; bj < 2; ++bj) { const int col = col0 + bj * HALF; f32x4 g0, g1; unpack8(*(const u32x4*)(G + row * 1024 + col), g0, g1);
                    *(u32x4*)(MPb + row * 1024 + col) = pack8(g0 * acc[ai][bj][m][0], g1 * acc[ai][bj][m][1]); } }
    }
};
struct EpiGateAdd {
    static constexpr bool PERM = true, AFTER_DRAIN = false, FP8 = false;
    const bf16_t* G; const bf16_t* MPb; bf16_t* O;
    __device__ __forceinline__ void operator()(const f32x4 (&acc)[2][2][4][2], const Unit& u, int wr, int wc, int fr, int fq) const {
        const int row0 = u.pm * BM + wr * 64 + fr, col0 = u.pn * BM + wc * 32 + 8 * fq;
#pragma unroll
        for (int ai = 0; ai < 2; ++ai)
#pragma unroll
            for (int m = 0; m < 4; ++m) { const size_t row = (size_t)(row0 + ai * HALF + m * 16);
#pragma unroll
                for (int bj = 0; bj < 2; ++bj) { const int col = col0 + bj * HALF; f32x4 g0, g1, p0, p1; unpack8(*(const u32x4*)(G + row * 1024 + col), g0, g1); unpack8(*(const u32x4*)(MPb + row * 1024 + col), p0, p1);
                    *(u32x4*)(O + row * 1024 + col) = pack8(p0 + g0 * acc[ai][bj][m][0], p1 + g1 * acc[ai][bj][m][1]); } }
    }
};
struct EpiWin {
    static constexpr bool PERM = true, AFTER_DRAIN = false, FP8 = false;
    unsigned char* ws; float* dout;
    __device__ __forceinline__ void operator()(const f32x4 (&acc)[2][2][4][2], const Unit& u, int wr, int wc, int fr, int fq) const {
        const ssq_t* ssq = (const ssq_t*)(ws + WS_CTL + CTL_SSQH);
        bf16_t *Z = (bf16_t*)(ws + WS_Z), *XBC = (bf16_t*)(ws + WS_XBC), *Q = (bf16_t*)(ws + WS_Q), *K = (bf16_t*)(ws + WS_K), *V = (bf16_t*)(ws + WS_V), *GS = (bf16_t*)(ws + WS_GS), *GA = (bf16_t*)(ws + WS_GA);
        float *DT = (float*)(ws + WS_DT), *LOGF = (float*)(ws + WS_LOGF);
        float *koP = dout + O_KP, *koS = dout + O_KS, *voP = dout + O_VP, *voS = dout + O_VS, *lfP = dout + O_LFP, *lfS = dout + O_LFS;
        const float *qn = (const float*)(ws + WS_PAR) + PAR_QN, *kn = (const float*)(ws + WS_PAR) + PAR_KN, *dtb = (const float*)(ws + WS_PAR) + PAR_DTB, *bf = (const float*)(ws + WS_PAR) + PAR_BF;
        const int row0 = u.pm * BM + wr * 64 + fr, pn = u.pn;
        if (pn < 20 || (pn >= 25 && pn < 34)) {
            bf16_t* O; int ldc, cb; int mode = 0;
            if (pn < 8) { O = Z; ldc = 2048; cb = pn * BM; } else if (pn < 20) { O = XBC; ldc = 3072; cb = (pn - 8) * BM; }
            else if (pn == 25) { O = V; ldc = 256; cb = 0; mode = 2; } else if (pn < 30) { O = GS; ldc = 1024; cb = (pn - 26) * BM; mode = 1; } else { O = GA; ldc = 1024; cb = (pn - 30) * BM; mode = 1; }
            const int col0 = cb + wc * 32 + 8 * fq;
#pragma unroll
            for (int ai = 0; ai < 2; ++ai)
#pragma unroll
                for (int m = 0; m < 4; ++m) { const int row = row0 + ai * HALF + m * 16; const float rs = rsqrtf(ssq_ld(ssq, row) * (1.f / 1024.f) + RMS_EPS_F);
#pragma unroll
                    for (int bj = 0; bj < 2; ++bj) { f32x4 v0 = acc[ai][bj][m][0] * rs, v1 = acc[ai][bj][m][1] * rs; const int col = col0 + bj * HALF;
                        if (mode == 1) {
#pragma unroll
                            for (int e = 0; e < 4; ++e) { v0[e] = sigmoid_f(v0[e]); v1[e] = sigmoid_f(v1[e]); } }
                        if (mode == 2) { float* vo = (row < MPROMPT) ? voP + (size_t)row * 256 : voS + (size_t)(row - MPROMPT) * 256; *(f32x4*)(vo + col) = v0; *(f32x4*)(vo + col + 4) = v1; }
                        *(u32x4*)(O + (size_t)row * ldc + col) = pack8(v0, v1); } }
        } else if (pn < 25) {
            const bool isk = (pn == 24); const int head = isk ? wc : 4 * (pn - 20) + wc; const float* gw = isk ? kn : qn; const float sc = isk ? 1.f : ATT_C2;
            f32x4 g[2][2]; float nmax = 0.f;
#pragma unroll
            for (int bj = 0; bj < 2; ++bj)
#pragma unroll
                for (int n = 0; n < 2; ++n) g[bj][n] = *(const f32x4*)(gw + 32 * bj + 8 * fq + 4 * n) * sc;
#pragma unroll
            for (int ai = 0; ai < 2; ++ai)
#pragma unroll
                for (int m = 0; m < 4; ++m) { const int row = row0 + ai * HALF + m * 16; const float rs = rsqrtf(ssq_ld(ssq, row) * (1.f / 1024.f) + RMS_EPS_F);
                    f32x4 v[2][2]; float s = 0.f;
#pragma unroll
                    for (int bj = 0; bj < 2; ++bj)
#pragma unroll
                        for (int n = 0; n < 2; ++n) { v[bj][n] = acc[ai][bj][m][n] * rs; s += (v[bj][n][0] * v[bj][n][0] + v[bj][n][1] * v[bj][n][1]) + (v[bj][n][2] * v[bj][n][2] + v[bj][n][3] * v[bj][n][3]); }
                    s += __shfl_xor(s, 16); s += __shfl_xor(s, 32);
                    const float r = rsqrtf(s * (1.f / 64.f) + RMS_EPS_F);
                    float nn = 0.f;
#pragma unroll
                    for (int bj = 0; bj < 2; ++bj) { const f32x4 o0 = v[bj][0] * r * g[bj][0], o1 = v[bj][1] * r * g[bj][1]; const int col = head * 64 + 32 * bj + 8 * fq;
                        { f32x4 q0, q1; unpack8(pack8(o0, o1), q0, q1); nn += (q0[0] * q0[0] + q0[1] * q0[1]) + (q0[2] * q0[2] + q0[3] * q0[3]) + (q1[0] * q1[0] + q1[1] * q1[1]) + (q1[2] * q1[2] + q1[3] * q1[3]); }
                        if (isk) { float* ko = (row < MPROMPT) ? koP + (size_t)row * 256 : koS + (size_t)(row - MPROMPT) * 256; *(f32x4*)(ko + col) = o0; *(f32x4*)(ko + col + 4) = o1;
                                   *(u32x4*)(K + (size_t)row * 256 + col) = pack8(o0, o1); }
                        else *(u32x4*)(Q + (size_t)row * 1024 + col) = pack8(o0, o1); }
                    nn += __shfl_xor(nn, 16); nn += __shfl_xor(nn, 32); nmax = fmaxf(nmax, nn); }
            nmax = fmaxf(nmax, __shfl_xor(nmax, 1)); nmax = fmaxf(nmax, __shfl_xor(nmax, 2)); nmax = fmaxf(nmax, __shfl_xor(nmax, 4)); nmax = fmaxf(nmax, __shfl_xor(nmax, 8));
            if (fr == 0 && fq == 0) __hip_atomic_fetch_max((unsigned*)(ws + WS_CTL) + (isk ? CW_KMAX2 : CW_QMAX2), __float_as_uint(nmax), __ATOMIC_RELAXED, __HIP_MEMORY_SCOPE_AGENT);
        } else {
            if (wc == 0) {
                const f32x4 b0 = *(const f32x4*)(dtb + 8 * fq), b1 = *(const f32x4*)(dtb + 8 * fq + 4);
#pragma unroll
                for (int ai = 0; ai < 2; ++ai)
#pragma unroll
                    for (int m = 0; m < 4; ++m) { const int row = row0 + ai * HALF + m * 16; const float rs = rsqrtf(ssq_ld(ssq, row) * (1.f / 1024.f) + RMS_EPS_F);
                        f32x4 v0 = acc[ai][0][m][0] * rs + b0, v1 = acc[ai][0][m][1] * rs + b1;
#pragma unroll
                        for (int e = 0; e < 4; ++e) { v0[e] = softplus_f(v0[e]); v1[e] = softplus_f(v1[e]); }
                        *(f32x4*)(DT + (size_t)row * 32 + 8 * fq) = v0; *(f32x4*)(DT + (size_t)row * 32 + 8 * fq + 4) = v1; }
            } else if (wc == 1 && fq < 2) {
                const f32x4 b0 = *(const f32x4*)(bf + 8 * fq), b1 = *(const f32x4*)(bf + 8 * fq + 4);
#pragma unroll
                for (int ai = 0; ai < 2; ++ai)
#pragma unroll
                    for (int m = 0; m < 4; ++m) { const int row = row0 + ai * HALF + m * 16; const float rs = rsqrtf(ssq_ld(ssq, row) * (1.f / 1024.f) + RMS_EPS_F);
                        f32x4 v0 = acc[ai][0][m][0] * rs + b0, v1 = acc[ai][0][m][1] * rs + b1;
#pragma unroll
                        for (int e = 0; e < 4; ++e) { v0[e] = logsigmoid_f(v0[e]); v1[e] = logsigmoid_f(v1[e]); }
                        float* lo = (row < MPROMPT) ? lfP + (size_t)row * 16 : lfS + (size_t)(row - MPROMPT) * 16;
                        *(f32x4*)(lo + 8 * fq) = v0; *(f32x4*)(lo + 8 * fq + 4) = v1;
                        *(f32x4*)(LOGF + (size_t)row * 16 + 8 * fq) = v0; *(f32x4*)(LOGF + (size_t)row * 16 + 8 * fq + 4) = v1; }
            }
        }
    }
};
template <class Epi, class Sched, bool ALIGN_EPI = false, bool SP2 = false>
__device__ __forceinline__ void gemm_phase(PG8_LAS unsigned char* lds, const Gemm g, const Sched& S, const Epi& E) {
    const int tid = threadIdx.x, wid = __builtin_amdgcn_readfirstlane(tid >> 6), lane = tid & 63, wr = wid >> 2, wc = wid & 3, fr = lane & 15, fq = lane >> 4;
    const int K = g.K, nt = K / BK;
    unsigned voffA[2], voffB[2];
#pragma unroll
    for (int i = 0; i < 2; ++i) { int R, C; stage_rc(tid * 16 + i * 8192, R, C); const int Rb = Epi::PERM ? ((R & ~31) + perm32(R & 31)) : R;
        voffA[i] = (unsigned)(R * K + C) * 2u; voffB[i] = (unsigned)(Rb * K + C) * 2u; }
    const size_t kstep = (size_t)(BK * 2);
    const size_t hstep = (size_t)HALF * K * 2;
    const size_t tstep = 2 * hstep;
    const unsigned ldsw = (unsigned)wid * 1024u;
    const int aoff = lds_byte(wr * 64 + fr, fq * 8), boff = lds_byte(wc * 32 + fr, fq * 8);
#define PG8_SA(b, h) (((b) * 2 + (h)) * HTB)
#define PG8_SB(b, h) ((4 + (b) * 2 + (h)) * HTB)
#define PG8_STAGE(bufoff, gbase, voff) do { _Pragma("unroll") for (int _i = 0; _i < 2; ++_i) \
        __builtin_amdgcn_global_load_lds((const unsigned*)((const char*)(gbase) + (voff)[_i]), (PG8_LAS unsigned*)(lds + (bufoff) + ldsw + _i * 8192), 16, 0, 0); } while (0)
#define PG8_LDA(dst, b, h) do { _Pragma("unroll") for (int m = 0; m < 4; ++m) { if constexpr (Epi::FP8) dst[m][0] = __builtin_shufflevector(*(const PG8_LAS v4i*)(lds + PG8_SA(b, h) + aoff + m * 2048), *(const PG8_LAS v4i*)(lds + PG8_SA(b, h) + aoff + m * 2048 + 1024), 0, 1, 2, 3, 4, 5, 6, 7); \
        else { _Pragma("unroll") for (int k = 0; k < 2; ++k) dst[m][k] = *(const PG8_LAS bf16x8*)(lds + PG8_SA(b, h) + aoff + m * 2048 + k * 1024); } } } while (0)
#define PG8_LDB(dst, b, h) do { _Pragma("unroll") for (int n = 0; n < 2; ++n) { if constexpr (Epi::FP8) dst[n][0] = __builtin_shufflevector(*(const PG8_LAS v4i*)(lds + PG8_SB(b, h) + boff + n * 2048), *(const PG8_LAS v4i*)(lds + PG8_SB(b, h) + boff + n * 2048 + 1024), 0, 1, 2, 3, 4, 5, 6, 7); \
        else { _Pragma("unroll") for (int k = 0; k < 2; ++k) dst[n][k] = *(const PG8_LAS bf16x8*)(lds + PG8_SB(b, h) + boff + n * 2048 + k * 1024); } } } while (0)
#define PG8_MMA(ai, bj, At, Bt) do { __builtin_amdgcn_s_setprio(1); \
        if constexpr (Epi::FP8) {   \
            _Pragma("unroll") for (int m = 0; m < 4; ++m) _Pragma("unroll") for (int n = 0; n < 2; ++n) \
                asm volatile("v_mfma_f32_16x16x128_f8f6f4 %0, %1, %2, %0" : "+v"(acc[ai][bj][m][n]) : "v"(Bt[n][0]), "v"(At[m][0]));   \
        } else { \
        _Pragma("unroll") for (int m = 0; m < 4; ++m) _Pragma("unroll") for (int n = 0; n < 2; ++n) _Pragma("unroll") for (int k = 0; k < 2; ++k) \
        acc[ai][bj][m][n] = __builtin_amdgcn_mfma_f32_16x16x32_bf16(Bt[n][k], At[m][k], acc[ai][bj][m][n], 0, 0, 0); } __builtin_amdgcn_s_setprio(0); } while (0)
#define PG8_WAIT_V(n) asm volatile("s_waitcnt vmcnt(" #n ")" ::: "memory")
#define PG8_WAIT_L(n) asm volatile("s_waitcnt lgkmcnt(" #n ")" ::: "memory")
#define PG8_BAR __builtin_amdgcn_s_barrier()
#define PG8_SCHED __builtin_amdgcn_sched_barrier(0)
    Unit cur, nxt; int ui = 0;
    if (!S.next(0, cur)) return;
    f32x4 acc[2][2][4][2];
#pragma unroll
    for (int a = 0; a < 2; ++a)
#pragma unroll
        for (int b = 0; b < 2; ++b)
#pragma unroll
            for (int m = 0; m < 4; ++m)
#pragma unroll
                for (int n = 0; n < 2; ++n) acc[a][b][m][n] = (f32x4){0.f, 0.f, 0.f, 0.f};
    typename FragSel<Epi::FP8>::type At[4][Epi::FP8 ? 1 : 2], B0[2][Epi::FP8 ? 1 : 2], B1[2][Epi::FP8 ? 1 : 2];
    const char* cA = (const char*)g.A + (size_t)cur.pm * tstep; const char* cB = (const char*)g.Bt + (size_t)cur.pn * tstep;
    S.a_ready(cur);
    if constexpr (SP2) {
        PG8_STAGE(PG8_SB(0, 0), cB, voffB); PG8_STAGE(PG8_SB(0, 1), cB + hstep, voffB); PG8_STAGE(PG8_SA(0, 0), cA, voffA); PG8_STAGE(PG8_SA(0, 1), cA + hstep, voffA);
        if (wr == 1) PG8_BAR;
        PG8_WAIT_V(2); PG8_BAR;
        PG8_STAGE(PG8_SB(1, 0), cB + kstep, voffB); PG8_STAGE(PG8_SA(1, 0), cA + kstep, voffA); PG8_STAGE(PG8_SB(1, 1), cB + hstep + kstep, voffB);
        PG8_WAIT_V(6); PG8_BAR;
    } else {
        PG8_STAGE(PG8_SB(0, 0), cB, voffB); PG8_STAGE(PG8_SA(0, 0), cA, voffA); PG8_STAGE(PG8_SB(0, 1), cB + hstep, voffB); PG8_STAGE(PG8_SA(0, 1), cA + hstep, voffA);
        if (wr == 1) PG8_BAR;
        PG8_WAIT_V(4); PG8_BAR;
        PG8_STAGE(PG8_SB(1, 0), cB + kstep, voffB); PG8_STAGE(PG8_SA(1, 0), cA + kstep, voffA); PG8_STAGE(PG8_SB(1, 1), cB + hstep + kstep, voffB);
        PG8_WAIT_V(6); PG8_BAR;
    }
    for (;;) {
        const bool has_next = S.next(ui + 1, nxt);
        const char* nA = has_next ? (const char*)g.A + (size_t)nxt.pm * tstep : cA; const char* nB = has_next ? (const char*)g.Bt + (size_t)nxt.pn * tstep : cB;
        for (int t = 0; t < nt; t += 2) {
            const bool last = (t == nt - 2);
            const char* a1 = cA + (size_t)(t + 1) * kstep;
            const char* a2 = last ? nA : cA + (size_t)(t + 2) * kstep; const char* b2 = last ? nB : cB + (size_t)(t + 2) * kstep;
            const char* a3 = a2 + kstep; const char* b3 = b2 + kstep;
            if (last && has_next) S.a_ready(nxt);
            if constexpr (SP2) {
            PG8_LDB(B0, 0, 0); PG8_LDB(B1, 0, 1); PG8_SCHED; PG8_LDA(At, 0, 0); PG8_STAGE(PG8_SA(1, 1), a1 + hstep, voffA);
            PG8_WAIT_V(8); PG8_WAIT_L(0); PG8_BAR; PG8_MMA(0, 0, At, B0); PG8_MMA(0, 1, At, B1); PG8_BAR; PG8_SCHED;
            PG8_LDA(At, 0, 1); PG8_STAGE(PG8_SB(0, 0), b2, voffB); PG8_STAGE(PG8_SB(0, 1), b2 + hstep, voffB); PG8_STAGE(PG8_SA(0, 0), a2, voffA);
            PG8_WAIT_V(8); PG8_WAIT_L(0); PG8_BAR; PG8_MMA(1, 0, At, B0); PG8_MMA(1, 1, At, B1); PG8_BAR; PG8_SCHED;
            PG8_LDB(B0, 1, 0); PG8_LDB(B1, 1, 1); PG8_SCHED; PG8_LDA(At, 1, 0); PG8_STAGE(PG8_SA(0, 1), a2 + hstep, voffA);
            PG8_WAIT_V(8); PG8_WAIT_L(0); PG8_BAR; PG8_MMA(0, 0, At, B0); PG8_MMA(0, 1, At, B1); PG8_BAR; PG8_SCHED;
            PG8_LDA(At, 1, 1); PG8_STAGE(PG8_SB(1, 0), b3, voffB); PG8_STAGE(PG8_SB(1, 1), b3 + hstep, voffB); PG8_STAGE(PG8_SA(1, 0), a3, voffA);
            PG8_WAIT_V(8); PG8_WAIT_L(0); PG8_BAR; PG8_MMA(1, 0, At, B0); PG8_MMA(1, 1, At, B1); PG8_BAR; PG8_SCHED;
            } else {
            PG8_LDB(B0, 0, 0); PG8_SCHED; PG8_LDA(At, 0, 0); PG8_STAGE(PG8_SA(1, 1), a1 + hstep, voffA);
            PG8_WAIT_L(8); PG8_BAR; PG8_WAIT_L(0); PG8_MMA(0, 0, At, B0); PG8_BAR; PG8_SCHED;
            PG8_LDB(B1, 0, 1); PG8_STAGE(PG8_SB(0, 0), b2, voffB);
            PG8_BAR; PG8_WAIT_L(0); PG8_MMA(0, 1, At, B1); PG8_BAR;
            PG8_LDA(At, 0, 1); PG8_STAGE(PG8_SA(0, 0), a2, voffA);
            PG8_BAR; PG8_WAIT_L(0); PG8_MMA(1, 0, At, B0); PG8_BAR; PG8_SCHED;
            PG8_STAGE(PG8_SB(0, 1), b2 + hstep, voffB);
            PG8_WAIT_V(6); PG8_BAR; PG8_MMA(1, 1, At, B1); PG8_BAR;
            PG8_LDB(B0, 1, 0); PG8_SCHED; PG8_LDA(At, 1, 0); PG8_STAGE(PG8_SA(0, 1), a2 + hstep, voffA);
            PG8_WAIT_L(8); PG8_BAR; PG8_WAIT_L(0); PG8_MMA(0, 0, At, B0); PG8_BAR; PG8_SCHED;
            PG8_LDB(B1, 1, 1); PG8_STAGE(PG8_SB(1, 0), b3, voffB);
            PG8_BAR; PG8_WAIT_L(0); PG8_MMA(0, 1, At, B1); PG8_BAR;
            PG8_LDA(At, 1, 1); PG8_STAGE(PG8_SA(1, 0), a3, voffA);
            PG8_BAR; PG8_WAIT_L(0); PG8_MMA(1, 0, At, B0); PG8_BAR; PG8_SCHED;
            PG8_STAGE(PG8_SB(1, 1), b3 + hstep, voffB);
            PG8_WAIT_V(6); PG8_BAR; PG8_MMA(1, 1, At, B1); PG8_BAR;
            }
        }
        if constexpr (ALIGN_EPI) { if (wr == 0) PG8_BAR; }
        if constexpr (Epi::FP8) asm volatile("s_nop 15\n\ts_nop 15" ::: "memory");
        if constexpr (!Epi::AFTER_DRAIN) { E(acc, cur, wr, wc, fr, fq); S.done(cur); }
        if (!has_next) break;
#pragma unroll
        for (int a = 0; a < 2; ++a)
#pragma unroll
            for (int b = 0; b < 2; ++b)
#pragma unroll
                for (int m = 0; m < 4; ++m)
#pragma unroll
                    for (int n = 0; n < 2; ++n) acc[a][b][m][n] = (f32x4){0.f, 0.f, 0.f, 0.f};
        cur = nxt; cA = nA; cB = nB; ++ui;
        if constexpr (ALIGN_EPI) { if (wr == 1) PG8_BAR; }
    }
    PG8_WAIT_V(0);
    if constexpr (!ALIGN_EPI) { if (wr == 0) PG8_BAR; }
    PG8_BAR;
    if constexpr (Epi::AFTER_DRAIN) { E.fused(acc, cur, wr, wc, fr, fq, lds, wid, lane); S.done(cur); }
#undef PG8_SA
#undef PG8_SB
#undef PG8_STAGE
#undef PG8_LDA
#undef PG8_LDB
#undef PG8_MMA
#undef PG8_WAIT_V
#undef PG8_WAIT_L
#undef PG8_BAR
#undef PG8_SCHED
}
}
#define GAS __attribute__((address_space(1)))
#define LAS __attribute__((address_space(3)))
typedef unsigned short bf16;
typedef unsigned v4u __attribute__((ext_vector_type(4)));
typedef unsigned v2u __attribute__((ext_vector_type(2)));
typedef float f32x4 __attribute__((ext_vector_type(4)));
typedef float f32x16 __attribute__((ext_vector_type(16)));
typedef short bf16x8 __attribute__((ext_vector_type(8)));
typedef short s16x4 __attribute__((ext_vector_type(4)));
typedef GAS unsigned gu32;
#define RLX_AGENT __ATOMIC_RELAXED, __HIP_MEMORY_SCOPE_AGENT
#define LDS_WAIT() asm volatile("s_waitcnt lgkmcnt(0)" ::: "memory")
#define VM_WAIT() asm volatile("s_waitcnt vmcnt(0)" ::: "memory")
__device__ __forceinline__ unsigned f2bf(float f) { unsigned u = __builtin_bit_cast(unsigned, f); return (u + 0x7fffu + ((u >> 16) & 1u)) >> 16; }
__device__ __forceinline__ unsigned pk2(float lo, float hi) { unsigned r; asm("v_cvt_pk_bf16_f32 %0, %1, %2" : "=v"(r) : "v"(lo), "v"(hi)); return r; }
__device__ __forceinline__ float bflo(unsigned w) { return __uint_as_float(w << 16); }
__device__ __forceinline__ float bfhi(unsigned w) { return __uint_as_float(w & 0xffff0000u); }
__device__ __forceinline__ float wave_sum(float v) {
#pragma unroll
    for (int o = 1; o < 64; o <<= 1) v += __shfl_xor(v, o);
    return v;
}
#define XB_TMO      128
#define XB_XCNT(j)  (256  + 64 * (j))
#define XB_XSUB(j)  (1280 + 64 * (j))
#define XB_XGEN(j)  (2304 + 64 * (j))
#define XB_TOP      3328
#define XB_TOPGEN   3392
#define XCD_BAR_WORDS 3456
#define XB_SPIN_CAP (1u << 18)

__device__ __forceinline__ unsigned xb_ld(unsigned* p)              { return __hip_atomic_load(p, __ATOMIC_RELAXED, __HIP_MEMORY_SCOPE_AGENT); }
__device__ __forceinline__ unsigned xb_add(unsigned* p, unsigned v) { return __hip_atomic_fetch_add(p, v, __ATOMIC_RELAXED, __HIP_MEMORY_SCOPE_AGENT); }
__device__ __forceinline__ unsigned xb_xcc_id() { return (unsigned)__builtin_amdgcn_s_getreg((3 << 11) | 20) & 0xFu; }
#define XB_SPIN(cond, bar) do { unsigned _sp = 0; while (cond) { __builtin_amdgcn_s_sleep(1); \
    if ((++_sp & 255u) == 0u) { if (xb_ld(&(bar)[XB_TMO])) break; if (_sp > XB_SPIN_CAP) { atomicAdd(&(bar)[XB_TMO], 1u); break; } } } } while (0)

struct XcdBarrier {
    unsigned* bar; unsigned x;
    volatile LAS unsigned* st;
};

__device__ __forceinline__ XcdBarrier xcd_barrier_post(unsigned* bar, volatile LAS unsigned* st) {
    XcdBarrier b; b.bar = bar; b.x = xb_xcc_id(); b.st = st;
    if (threadIdx.x == 0) (void)xb_add(&bar[XB_XCNT(b.x)], 1u);
    return b;
}
__device__ __forceinline__ void xcd_barrier_complete(unsigned* bar, unsigned x, unsigned& nloc, unsigned& nx) {
    const unsigned G = gridDim.x * gridDim.y * gridDim.z;
    unsigned sum, cnt, mine, sp = 0u;
    for (;;) {
        sum = 0u; cnt = 0u; mine = 0u;
#pragma unroll
        for (unsigned j = 0; j < 16; ++j) { const unsigned c = xb_ld(&bar[XB_XCNT(j)]); sum += c; cnt += (c > 0u) ? 1u : 0u; mine = (j == x) ? c : mine; }
        if (sum == G) break;
        __builtin_amdgcn_s_sleep(1);
        if ((++sp & 255u) == 0u) { if (xb_ld(&bar[XB_TMO])) break; if (sp > XB_SPIN_CAP) { atomicAdd(&bar[XB_TMO], 1u); break; } }
    }
    nloc = mine > 0u ? mine : 1u; nx = cnt > 0u ? cnt : 1u;
}

__device__ __forceinline__ void xcd_barrier(const XcdBarrier& b) {
    asm volatile("s_waitcnt vmcnt(0)" ::: "memory");
    __syncthreads();
    if (threadIdx.x == 0) {
        unsigned* bar = b.bar;
        __builtin_amdgcn_s_waitcnt(0);
        unsigned nloc = b.st[0], nx = b.st[1];
        if (nloc == 0u) { xcd_barrier_complete(bar, b.x, nloc, nx); b.st[0] = nloc; b.st[1] = nx; }
        const unsigned old = xb_add(&bar[XB_XSUB(b.x)], 1u);
        const unsigned gen = old / nloc;
        if (old + 1u == (gen + 1u) * nloc) {
            __builtin_amdgcn_fence(__ATOMIC_RELEASE, "agent");
            asm volatile("s_waitcnt vmcnt(0)" ::: "memory");
            const unsigned og = xb_add(&bar[XB_TOP], 1u);
            const unsigned tg = og / nx;
            if (og + 1u == (tg + 1u) * nx) xb_add(&bar[XB_TOPGEN], 1u);
            else XB_SPIN(xb_ld(&bar[XB_TOPGEN]) == tg, bar);
            __builtin_amdgcn_fence(__ATOMIC_ACQUIRE, "agent");
            xb_add(&bar[XB_XGEN(b.x)], 1u);
            asm volatile("s_waitcnt vmcnt(0)" ::: "memory");
        } else {
            XB_SPIN(xb_ld(&bar[XB_XGEN(b.x)]) == gen, bar);
            __builtin_amdgcn_fence(__ATOMIC_ACQUIRE, "agent");
            asm volatile("s_waitcnt vmcnt(0)" ::: "memory");
        }
    }
    __syncthreads();
}
struct MapPlain { const float* W; int N; __device__ __forceinline__ const float* operator()(int n, int& ld) const { ld = N; return W + n; } };
struct MapGU { const float* W; __device__ __forceinline__ const float* operator()(int n, int& ld) const { ld = DFF; const int pn = n >> 8, j = n & 127; return W + 128 * pn + j; } };
struct MapWin { const float* W; __device__ __forceinline__ const float* operator()(int n, int& ld) const { ld = INDIM; const int pn = n >> 8, ct = n & 255; int c;
        if (pn < 20) c = n;
        else if (pn < 25) { const int bj = ct >> 7, wc = (ct >> 5) & 3, j = ct & 31; c = (pn == 24 ? 6176 + 64 * wc : 5152 + 64 * (4 * (pn - 20) + wc)) + 32 * bj + j; }
        else if (pn == 25) c = 6432 + ct;
        else if (pn < 30) c = 6704 + (n - 26 * 256);
        else if (pn < 34) c = 7728 + (n - 30 * 256);
        else c = ct < 32 ? 5120 + ct : (ct < 48 ? 6688 + (ct - 32) : -1);
        return c < 0 ? nullptr : W + c; } };
template <class Map> __device__ __forceinline__ void p0_transpose_item(const Map& mp, const float* ksc, int K, bf16* WT, LAS float* scr, int kb, int nb, int lane, unsigned char* W8 = nullptr, float SC = 1.f) {
    const int k0 = 64 * kb, n0 = 64 * nb; int ld; const float* src = mp(n0 + lane, ld);
    float v[64];
#pragma unroll
    for (int i = 0; i < 64; ++i) v[i] = src ? src[(size_t)(k0 + i) * ld] : 0.f;
    const float sc = ksc ? ksc[k0 + lane] : 1.f;
#pragma unroll
    for (int i = 0; i < 64; ++i) scr[i * 65 + lane] = v[i] * __shfl(sc, i);
    LDS_WAIT(); asm volatile("" ::: "memory");
    const int c = lane & 7;
#pragma unroll
    for (int j = 0; j < 8; ++j) { const int n = (lane >> 3) + 8 * j; const LAS float* s = scr + (8 * c) * 65 + n;
        v4u o; o.x = pk2(s[0 * 65], s[1 * 65]); o.y = pk2(s[2 * 65], s[3 * 65]); o.z = pk2(s[4 * 65], s[5 * 65]); o.w = pk2(s[6 * 65], s[7 * 65]);
        if (WT) *(GAS v4u*)(WT + (size_t)(n0 + n) * K + k0 + 8 * c) = o;
        if (W8) { int w0 = 0, w1 = 0;
            w0 = __builtin_amdgcn_cvt_pk_fp8_f32(s[0 * 65] * SC, s[1 * 65] * SC, w0, false); w0 = __builtin_amdgcn_cvt_pk_fp8_f32(s[2 * 65] * SC, s[3 * 65] * SC, w0, true);
            w1 = __builtin_amdgcn_cvt_pk_fp8_f32(s[4 * 65] * SC, s[5 * 65] * SC, w1, false); w1 = __builtin_amdgcn_cvt_pk_fp8_f32(s[6 * 65] * SC, s[7 * 65] * SC, w1, true);
            v2u o8; o8.x = (unsigned)w0; o8.y = (unsigned)w1; *(GAS v2u*)(W8 + (size_t)(n0 + n) * K + k0 + 8 * c) = o8; } }
    LDS_WAIT(); asm volatile("" ::: "memory");
}
__device__ __forceinline__ void p0_row_to_bf16(const float* xrow, bf16* orow, pg8::ssq_t* ssq, int lane) {
    const GAS f32x4* xr = (const GAS f32x4*)xrow + lane;
    f32x4 v[4]; float s = 0.f;
#pragma unroll
    for (int j = 0; j < 4; ++j) { v[j] = xr[64 * j]; s += (v[j].x * v[j].x + v[j].y * v[j].y) + (v[j].z * v[j].z + v[j].w * v[j].w); }
    s = wave_sum(s);
    GAS unsigned long long* o8 = (GAS unsigned long long*)orow + lane;
#pragma unroll
    for (int j = 0; j < 4; ++j) o8[64 * j] = (unsigned long long)pk2(v[j].x, v[j].y) | ((unsigned long long)pk2(v[j].z, v[j].w) << 32);
    if (lane == 0) *ssq = pg8::ssq_fx(s);
}
__device__ __forceinline__ void p0_rows_to_bf16(const float* xrow, bf16* orow, pg8::ssq_t* ssq, int lane) {
    const GAS f32x4* xr = (const GAS f32x4*)xrow + lane;
    f32x4 v[8]; float s0 = 0.f, s1 = 0.f;
#pragma unroll
    for (int j = 0; j < 8; ++j) v[j] = xr[64 * j];
#pragma unroll
    for (int j = 0; j < 4; ++j) { s0 += (v[j].x * v[j].x + v[j].y * v[j].y) + (v[j].z * v[j].z + v[j].w * v[j].w); s1 += (v[4 + j].x * v[4 + j].x + v[4 + j].y * v[4 + j].y) + (v[4 + j].z * v[4 + j].z + v[4 + j].w * v[4 + j].w); }
    s0 = wave_sum(s0); s1 = wave_sum(s1);
    GAS unsigned long long* o8 = (GAS unsigned long long*)orow + lane;
#pragma unroll
    for (int j = 0; j < 8; ++j) o8[64 * j] = (unsigned long long)pk2(v[j].x, v[j].y) | ((unsigned long long)pk2(v[j].z, v[j].w) << 32);
    if (lane == 0) { ssq[0] = pg8::ssq_fx(s0); ssq[1] = pg8::ssq_fx(s1); }
}
__device__ __forceinline__ f32x16 mfma32(bf16x8 a, bf16x8 b, f32x16 c) { return __builtin_amdgcn_mfma_f32_32x32x16_bf16(a, b, c, 0, 0, 0); }
__device__ __forceinline__ int crow(int r, int hi) { return (r & 3) + 8 * (r >> 2) + 4 * hi; }
typedef short v4i16_t __attribute__((ext_vector_type(4)));
__device__ __forceinline__ s16x4 ds_tr(LAS const unsigned char* p) { return __builtin_bit_cast(s16x4, __builtin_amdgcn_ds_read_tr16_b64_v4i16((LAS v4i16_t*)p)); }
__device__ __forceinline__ bf16x8 tr_frag(LAS const unsigned char* tile, int pitch, int ka, int kb, int cb, int lane) {
    const int i = lane & 15, q = i >> 2, pp = i & 3, c16 = cb + 16 * ((lane >> 4) & 1);
    const s16x4 lo = ds_tr(tile + (ka + q) * pitch + (c16 + 4 * pp) * 2), hi = ds_tr(tile + (kb + q) * pitch + (c16 + 4 * pp) * 2);
    return (bf16x8){lo[0], lo[1], lo[2], lo[3], hi[0], hi[1], hi[2], hi[3]};
}
__device__ __forceinline__ float wave_scan_incl(float v, int lane) {
#pragma unroll
    for (int o = 1; o < 64; o <<= 1) { const float t = __shfl_up(v, o); if (lane >= o) v += t; }
    return v;
}
__device__ __forceinline__ float silu1(float x) { return x * __builtin_amdgcn_rcpf(1.f + __builtin_amdgcn_exp2f(-1.4426950408889634f * x)); }
__device__ __forceinline__ float exp_fast(float x) { return __builtin_amdgcn_exp2f(1.4426950408889634f * x); }
__device__ __forceinline__ void unpk8(const v4u w, float (&f)[8]) { f[0] = bflo(w.x); f[1] = bfhi(w.x); f[2] = bflo(w.y); f[3] = bfhi(w.y); f[4] = bflo(w.z); f[5] = bfhi(w.z); f[6] = bflo(w.w); f[7] = bfhi(w.w); }
__device__ __forceinline__ v4u pk8(const float (&f)[8]) { v4u o; o.x = pk2(f[0], f[1]); o.y = pk2(f[2], f[3]); o.z = pk2(f[4], f[5]); o.w = pk2(f[6], f[7]); return o; }

struct ConvW { float w[4][8]; float b[8]; };
__device__ __forceinline__ void conv_load_w(ConvW& cw, const float* convw, const float* convb, int col) {
#pragma unroll
    for (int j = 0; j < 4; ++j) { const f32x4 a = *(const f32x4*)(convw + (size_t)j * CONVD + col), b = *(const f32x4*)(convw + (size_t)j * CONVD + col + 4);
        cw.w[j][0] = a[0]; cw.w[j][1] = a[1]; cw.w[j][2] = a[2]; cw.w[j][3] = a[3]; cw.w[j][4] = b[0]; cw.w[j][5] = b[1]; cw.w[j][6] = b[2]; cw.w[j][7] = b[3]; }
    const f32x4 a = *(const f32x4*)(convb + col), b = *(const f32x4*)(convb + col + 4);
    cw.b[0] = a[0]; cw.b[1] = a[1]; cw.b[2] = a[2]; cw.b[3] = a[3]; cw.b[4] = b[0]; cw.b[5] = b[1]; cw.b[6] = b[2]; cw.b[7] = b[3];
}
__device__ __forceinline__ void conv_item(unsigned char* ws, const float* convw, const float* convb, int item, int lane) {
    asm volatile("" : "+v"(lane));
    const int cbk = item % 6, rb = item / 6; const int col = 512 * cbk + 8 * lane; const long row0 = 16l * rb; const int tpos0 = (int)(row0 & (SEQ - 1));
    const bf16* XBC = (const bf16*)(ws + WS_XBC); bf16* XC = (bf16*)(ws + WS_XC);
    v4u raw[19];
#pragma unroll
    for (int k = 0; k < 19; ++k) { raw[k] = (v4u){0u, 0u, 0u, 0u}; if (tpos0 - 3 + k >= 0) raw[k] = *(const GAS v4u*)(XBC + (size_t)(row0 - 3 + k) * CONVD + col); }
    ConvW cw; conv_load_w(cw, convw, convb, col);
    float x0[8], x1[8], x2[8], x3[8];
    unpk8(raw[0], x1); unpk8(raw[1], x2); unpk8(raw[2], x3);
#pragma unroll
    for (int k = 3; k < 19; ++k) {
#pragma unroll
        for (int e = 0; e < 8; ++e) { x0[e] = x1[e]; x1[e] = x2[e]; x2[e] = x3[e]; }
        unpk8(raw[k], x3); float y[8];
#pragma unroll
        for (int e = 0; e < 8; ++e) y[e] = silu1(cw.b[e] + cw.w[0][e] * x0[e] + cw.w[1][e] * x1[e] + cw.w[2][e] * x2[e] + cw.w[3][e] * x3[e]);
        *(GAS v4u*)(XC + (size_t)(row0 - 3 + k) * CONVD + col) = pk8(y); }
}

__device__ __forceinline__ void conv_item_q(unsigned char* ws, const float* convw, const float* convb, long row0, int colbase, int lane) {
    asm volatile("" : "+v"(lane));
    const int col = colbase + 8 * (lane & 15); const long r0 = row0 + 16 * (lane >> 4); const int tpos0 = (int)(r0 & (SEQ - 1));
    const bf16* XBC = (const bf16*)(ws + WS_XBC); bf16* XC = (bf16*)(ws + WS_XC);
    v4u raw[19];
#pragma unroll
    for (int k = 0; k < 19; ++k) { raw[k] = (v4u){0u, 0u, 0u, 0u}; if (tpos0 - 3 + k >= 0) raw[k] = *(const GAS v4u*)(XBC + (size_t)(r0 - 3 + k) * CONVD + col); }
    ConvW cw; conv_load_w(cw, convw, convb, col);
    float x0[8], x1[8], x2[8], x3[8];
    unpk8(raw[0], x1); unpk8(raw[1], x2); unpk8(raw[2], x3);
#pragma unroll
    for (int k = 3; k < 19; ++k) {
#pragma unroll
        for (int e = 0; e < 8; ++e) { x0[e] = x1[e]; x1[e] = x2[e]; x2[e] = x3[e]; }
        unpk8(raw[k], x3); float y[8];
#pragma unroll
        for (int e = 0; e < 8; ++e) y[e] = silu1(cw.b[e] + cw.w[0][e] * x0[e] + cw.w[1][e] * x1[e] + cw.w[2][e] * x2[e] + cw.w[3][e] * x3[e]);
        *(GAS v4u*)(XC + (size_t)(r0 - 3 + k) * CONVD + col) = pk8(y); }
}

constexpr int P4_BM = 0, P4_BM_PITCH = 320, P4_X = 40960, P4_X_PITCH = 1088, P4_WGT = P4_X + 64 * P4_X_PITCH;
static_assert(P4_WGT + 4096 <= MISC_OFF, "states LDS map");
__device__ __forceinline__ void p4_unit(unsigned char* ws, const float* convw, const float* convb, LAS unsigned char* lds, int unit, int tid, int lane, int wave) {
    asm volatile("" : "+v"(tid));
    lane = tid & 63;
    const int g = unit & 3, c = (unit >> 2) & 31, b = unit >> 7;
    const size_t row0 = (size_t)b * SEQ + (size_t)c * CHUNK;
    const bf16* XC = (const bf16*)(ws + WS_XC);
    const float* DT = (const float*)(ws + WS_DT); float* ACS = (float*)(ws + WS_ACS); const float* par = (const float*)(ws + WS_PAR);
    LAS float* wgtT = (LAS float*)(lds + P4_WGT);
    conv_item(ws, convw, convb, (int)(((row0 >> 4) + wave) * 6 + g), lane);
    if (wave < 4) conv_item_q(ws, convw, convb, (long)row0 + 64 * (wave & 1), ((wave >> 1) ? 2560 : 2048) + 128 * g, lane);
    __syncthreads();
    v4u braw[4], xraw[8];
#pragma unroll
    for (int i = 0; i < 4; ++i) { const int id = tid + 512 * i, l = id >> 4, ch = id & 15; braw[i] = *(const GAS v4u*)(XC + (row0 + l) * CONVD + 2048 + 128 * g + 8 * ch); }
#pragma unroll
    for (int i = 0; i < 8; ++i) { const int id = tid + 512 * i, l = id >> 6, ch = id & 63; xraw[i] = *(const GAS v4u*)(XC + (row0 + l) * CONVD + 512 * g + 8 * ch); }
    { const int hd = 8 * g + wave; const float Ah = -expf(par[PAR_ALOG + hd]);
      const float d0 = DT[(row0 + 2 * lane) * 32 + hd], d1 = DT[(row0 + 2 * lane + 1) * 32 + hd];
      const float a0 = d0 * Ah, a1 = d1 * Ah; const float inc = wave_scan_incl(a0 + a1, lane);
      const float acs1 = inc, acs0 = inc - a1, last = __shfl(inc, 63);
      wgtT[wave * 128 + 2 * lane] = d0 * exp_fast(last - acs0); wgtT[wave * 128 + 2 * lane + 1] = d1 * exp_fast(last - acs1);
      ACS[(row0 + 2 * lane) * 32 + hd] = acs0; ACS[(row0 + 2 * lane + 1) * 32 + hd] = acs1; }
#pragma unroll
    for (int i = 0; i < 4; ++i) { const int id = tid + 512 * i, l = id >> 4, ch = id & 15; *(LAS v4u*)(lds + P4_BM + l * P4_BM_PITCH + 16 * ch) = braw[i]; }
    f32x16 acc[2][4];
#pragma unroll
    for (int pt = 0; pt < 2; ++pt)
#pragma unroll
        for (int nt = 0; nt < 4; ++nt) acc[pt][nt] = (f32x16){};
#pragma unroll 1
    for (int hf = 0; hf < 2; ++hf) {
#pragma unroll
        for (int i = 0; i < 8; ++i) { const int id = tid + 512 * i, l = id >> 6, ch = id & 63; *(LAS v4u*)(lds + P4_X + l * P4_X_PITCH + 16 * ch) = xraw[i]; }
        __syncthreads();
        if (hf == 0) {
#pragma unroll
            for (int i = 0; i < 8; ++i) { const int id = tid + 512 * i, l = id >> 6, ch = id & 63; xraw[i] = *(const GAS v4u*)(XC + (row0 + 64 + l) * CONVD + 512 * g + 8 * ch); } }
        { LAS const unsigned char* xt = lds + P4_X; LAS const unsigned char* bm = lds + P4_BM; const int h = lane >> 5;
#pragma unroll
          for (int ks = 0; ks < 4; ++ks) { bf16x8 af[2], bfr[4];
              const f32x4 w0 = *(LAS const f32x4*)(wgtT + wave * 128 + 64 * hf + 16 * ks + 8 * h), w1 = *(LAS const f32x4*)(wgtT + wave * 128 + 64 * hf + 16 * ks + 8 * h + 4);
#pragma unroll
              for (int pt = 0; pt < 2; ++pt) { const v4u xr = __builtin_bit_cast(v4u, tr_frag(xt, P4_X_PITCH, 16 * ks + 8 * h, 16 * ks + 8 * h + 4, 64 * wave + 32 * pt, lane));
                  v4u xw; xw.x = pk2(bflo(xr.x) * w0[0], bfhi(xr.x) * w0[1]); xw.y = pk2(bflo(xr.y) * w0[2], bfhi(xr.y) * w0[3]); xw.z = pk2(bflo(xr.z) * w1[0], bfhi(xr.z) * w1[1]); xw.w = pk2(bflo(xr.w) * w1[2], bfhi(xr.w) * w1[3]);
                  af[pt] = __builtin_bit_cast(bf16x8, xw); }
#pragma unroll
              for (int nt = 0; nt < 4; ++nt) bfr[nt] = tr_frag(bm, P4_BM_PITCH, 64 * hf + 16 * ks + 8 * h, 64 * hf + 16 * ks + 8 * h + 4, 32 * nt, lane);
#pragma unroll
              for (int pt = 0; pt < 2; ++pt)
#pragma unroll
                  for (int nt = 0; nt < 4; ++nt) acc[pt][nt] = mfma32(af[pt], bfr[nt], acc[pt][nt]); } }
        __syncthreads();
    }
    { bf16* ST = (bf16*)(ws + WS_ST) + ((size_t)(b * NCHUNK + c) * SH + 8 * g + wave) * (SP * SN); const int h = lane >> 5, r = lane & 31;
#pragma unroll
      for (int pt = 0; pt < 2; ++pt)
#pragma unroll
          for (int nt = 0; nt < 4; ++nt)
#pragma unroll
              for (int q = 0; q < 16; ++q) ST[(32 * pt + crow(q, h)) * SN + 32 * nt + r] = (bf16)f2bf(acc[pt][nt][q]); }
}
constexpr int P4S_WAVE = 12288, P4S_BS = 0, P4S_CS = 4096, P4S_XS = 8192, P4S_YO = 10240;
__device__ __forceinline__ void p4s_item(unsigned char* ws, float* dout, const float* convw, const float* convb, const float* sconv, const float* sssm, LAS unsigned char* wl, int item, int lane) {
    asm volatile("" : "+v"(lane));
    const int hd = item & 31, b = item >> 5, g = hd >> 3; const size_t row0 = (size_t)MP + (size_t)b * DECS;
    const bf16* XBC = (const bf16*)(ws + WS_XBC); const float* DT = (const float*)(ws + WS_DT); const float* par = (const float*)(ws + WS_PAR); float* YRAW = (float*)(ws + WS_YRAW);
    LAS float* Bs = (LAS float*)(wl + P4S_BS); LAS float* Cs = (LAS float*)(wl + P4S_CS); LAS float* xsl = (LAS float*)(wl + P4S_XS); LAS float* yo = (LAS float*)(wl + P4S_YO);
    float xs[8];
#pragma unroll
    for (int part = 0; part < 5; ++part) {
        const int col = part == 0 ? 64 * hd + lane : (part == 1 ? 2048 + 128 * g + lane : (part == 2 ? 2048 + 128 * g + 64 + lane : (part == 3 ? 2560 + 128 * g + lane : 2560 + 128 * g + 64 + lane)));
        float xa[11];
#pragma unroll
        for (int j = 0; j < 3; ++j) xa[j] = sconv[((size_t)b * 3 + j) * CONVD + col];
#pragma unroll
        for (int i = 0; i < 8; ++i) xa[3 + i] = __uint_as_float((unsigned)XBC[(row0 + i) * CONVD + col] << 16);
        const float w0 = convw[col], w1 = convw[CONVD + col], w2 = convw[2 * CONVD + col], w3 = convw[3 * CONVD + col], bb = convb[col];
#pragma unroll
        for (int i = 0; i < 8; ++i) { const float y = silu1(bb + w0 * xa[i] + w1 * xa[i + 1] + w2 * xa[i + 2] + w3 * xa[i + 3]);
            if (part == 0) { xs[i] = y; xsl[i * 64 + lane] = y; } else if (part == 1) Bs[i * 128 + lane] = y; else if (part == 2) Bs[i * 128 + 64 + lane] = y; else if (part == 3) Cs[i * 128 + lane] = y; else Cs[i * 128 + 64 + lane] = y; }
        if (part == 0 || (hd & 7) == 0) {
#pragma unroll
            for (int j = 0; j < 3; ++j) dout[O_CONVS + ((size_t)b * 3 + j) * CONVD + col] = xa[8 + j]; }
    }
    float dt[8], acs[8]; { const float Ah = -expf(par[PAR_ALOG + hd]); float cs = 0.f;
#pragma unroll
      for (int i = 0; i < 8; ++i) { dt[i] = DT[(row0 + i) * 32 + hd]; cs += dt[i] * Ah; acs[i] = cs; } }
    float cb = 0.f; { const int l = lane >> 3, sx = lane & 7;
#pragma unroll 8
      for (int n = 0; n < 128; n += 4) { const f32x4 c = *(LAS const f32x4*)(Cs + l * 128 + n), bv = *(LAS const f32x4*)(Bs + sx * 128 + n); cb += (c[0] * bv[0] + c[1] * bv[1]) + (c[2] * bv[2] + c[3] * bv[3]); } }
    float y[8]; const float Dk = par[PAR_DSKIP + hd];
#pragma unroll
    for (int l = 0; l < 8; ++l) { float a = Dk * xs[l];
#pragma unroll
        for (int s = 0; s <= l; ++s) a += __shfl(cb, 8 * l + s) * exp_fast(acs[l] - acs[s]) * dt[s] * xs[s];
        y[l] = a; }
    const float* h0 = sssm + ((size_t)b * SH + hd) * (SP * SN); float* hout = dout + O_SSMS + ((size_t)b * SH + hd) * (SP * SN);
    float wg[8], ea[8];
#pragma unroll
    for (int l = 0; l < 8; ++l) { wg[l] = dt[l] * exp_fast(acs[7] - acs[l]); ea[l] = exp_fast(acs[l]); }
    const float ed = ea[7]; const int pp = lane >> 3, nc = lane & 7;
#pragma unroll 2
    for (int it = 0; it < 8; ++it) { const int p = 8 * it + pp;
        f32x4 hv[4], nv[4];
#pragma unroll
        for (int j = 0; j < 4; ++j) { hv[j] = *(const f32x4*)(h0 + p * SN + 16 * nc + 4 * j); nv[j] = hv[j] * ed; }
#pragma unroll
        for (int l = 0; l < 8; ++l) { const float xv = xsl[l * 64 + p] * wg[l]; float d = 0.f;
#pragma unroll
            for (int j = 0; j < 4; ++j) { const f32x4 c = *(LAS const f32x4*)(Cs + l * 128 + 16 * nc + 4 * j), bv = *(LAS const f32x4*)(Bs + l * 128 + 16 * nc + 4 * j);
                d += (c[0] * hv[j][0] + c[1] * hv[j][1]) + (c[2] * hv[j][2] + c[3] * hv[j][3]); nv[j] += bv * xv; }
            d += __shfl_xor(d, 1); d += __shfl_xor(d, 2); d += __shfl_xor(d, 4);
            if (nc == l) yo[l * 64 + p] = d; }
#pragma unroll
        for (int j = 0; j < 4; ++j) *(f32x4*)(hout + p * SN + 16 * nc + 4 * j) = nv[j]; }
#pragma unroll
    for (int l = 0; l < 8; ++l) YRAW[(size_t)(8 * b + l) * DSSM + 64 * hd + lane] = y[l] + ea[l] * yo[l * 64 + lane];
}
__device__ __forceinline__ void p4s_norm_item(unsigned char* ws, const float* ssdn, int item, int lane) {
    asm volatile("" : "+v"(lane));
    const int g = item & 3, i = item >> 2; const size_t row = (size_t)MP + i; const int ch0 = 512 * g + 8 * lane;
    const bf16* Zb = (const bf16*)(ws + WS_Z); bf16* YS = (bf16*)(ws + WS_YS); const float* YRAW = (const float*)(ws + WS_YRAW) + (size_t)i * DSSM + ch0;
    float z[8], y[8]; unpk8(*(const GAS v4u*)(Zb + row * DSSM + ch0), z); const f32x4 ya = *(const f32x4*)YRAW, yb = *(const f32x4*)(YRAW + 4); float ss = 0.f;
    y[0] = ya[0]; y[1] = ya[1]; y[2] = ya[2]; y[3] = ya[3]; y[4] = yb[0]; y[5] = yb[1]; y[6] = yb[2]; y[7] = yb[3];
#pragma unroll
    for (int e = 0; e < 8; ++e) { y[e] *= silu1(z[e]); ss += y[e] * y[e]; }
    ss = wave_sum(ss); const float rs = rsqrtf(ss * (1.f / 512.f) + 1e-6f);
#pragma unroll
    for (int e = 0; e < 8; ++e) y[e] = y[e] * rs * ssdn[ch0 + e];
    *(GAS v4u*)(YS + row * DSSM + ch0) = pk8(y);
}

__device__ __forceinline__ void p5_scan(unsigned char* ws, float* dout, int gtid, int gthreads) {
    bf16* ST = (bf16*)(ws + WS_ST); const float* ACS = (const float*)(ws + WS_ACS);
    for (int gid = gtid; gid < NBATCH * SH * SP * (SN / 8); gid += gthreads) {
        const int nch = gid & 15, p = (gid >> 4) & 63, hd = (gid >> 10) & 31, b = gid >> 15;
        float h[8] = {};
#pragma unroll 4
        for (int c = 0; c < NCHUNK; ++c) {
            GAS v4u* slot = (GAS v4u*)(ST + ((size_t)(b * NCHUNK + c) * SH + hd) * (SP * SN) + p * SN + nch * 8);
            const v4u sv = *slot; *slot = pk8(h);
            const float dec = expf(ACS[((size_t)b * SEQ + (size_t)c * CHUNK + CHUNK - 1) * 32 + hd]);
            float s[8]; unpk8(sv, s);
#pragma unroll
            for (int e = 0; e < 8; ++e) h[e] = dec * h[e] + s[e];
        }
        float* o = dout + O_SSMP + ((size_t)(b * SH + hd) * SP + p) * SN + nch * 8;
        *(f32x4*)o = (f32x4){h[0], h[1], h[2], h[3]}; *(f32x4*)(o + 4) = (f32x4){h[4], h[5], h[6], h[7]};
    }
}

constexpr int P6_C = 0, P6_B = 34816, P6_PITCH = 272, P6_X = 69632, P6_X_PITCH = 192, P6_X_WAVE = 32 * 192, P6_ACS = P6_X + 8 * P6_X_WAVE, P6_DT = P6_ACS + 4096, P6_SSQ = P6_DT + 4096;
static_assert(P6_SSQ + 4096 <= MISC_OFF, "phase 6 LDS map");
__device__ __forceinline__ float half_sum32(float v) {
    v += __shfl_xor(v, 1); v += __shfl_xor(v, 2); v += __shfl_xor(v, 4); v += __shfl_xor(v, 8); v += __shfl_xor(v, 16); return v; }
__device__ __forceinline__ void p6_unit(unsigned char* ws, const float* ssdn, LAS unsigned char* lds, int unit, int tid, int lane, int wave) {
    asm volatile("" : "+v"(tid));
    lane = tid & 63;
    const int g = unit & 3, c = (unit >> 2) & 31, b = unit >> 7; const size_t row0 = (size_t)b * SEQ + (size_t)c * CHUNK;
    const bf16* XC = (const bf16*)(ws + WS_XC); const float* DT = (const float*)(ws + WS_DT); const float* ACS = (const float*)(ws + WS_ACS); const float* par = (const float*)(ws + WS_PAR);
    const bf16* Zb = (const bf16*)(ws + WS_Z); bf16* YS = (bf16*)(ws + WS_YS);
    LAS float* acsT = (LAS float*)(lds + P6_ACS); LAS float* dtT = (LAS float*)(lds + P6_DT); LAS float* ssqT = (LAS float*)(lds + P6_SSQ);
    const int h = lane >> 5, r = lane & 31, hdl = wave, hd = 8 * g + wave;
    __syncthreads();
    v4u craw[4], braw[4], xraw[16];
#pragma unroll
    for (int i = 0; i < 4; ++i) { const int id = tid + 512 * i, l = id >> 4, ch = id & 15;
        craw[i] = *(const GAS v4u*)(XC + (row0 + l) * CONVD + 2560 + 128 * g + 8 * ch); braw[i] = *(const GAS v4u*)(XC + (row0 + l) * CONVD + 2048 + 128 * g + 8 * ch); }
#pragma unroll
    for (int i = 0; i < 16; ++i) { const int id = lane + 64 * i, rr = id >> 3, ch = id & 7; xraw[i] = *(const GAS v4u*)(XC + (row0 + rr) * CONVD + 512 * g + 64 * hdl + 8 * ch); }
    float ta[2], td[2];
#pragma unroll
    for (int i = 0; i < 2; ++i) { const int l = lane + 64 * i; ta[i] = ACS[(row0 + l) * 32 + hd]; td[i] = DT[(row0 + l) * 32 + hd]; }
    const float Dk = par[PAR_DSKIP + hd];
    const float gn0 = ssdn[512 * g + 64 * hdl + r], gn1 = ssdn[512 * g + 64 * hdl + 32 + r];
    const bf16* Hc = (const bf16*)(ws + WS_ST) + ((size_t)(b * NCHUNK + c) * SH + hd) * (SP * SN) + r * SN + 8 * h;
#pragma unroll
    for (int i = 0; i < 4; ++i) { const int id = tid + 512 * i, l = id >> 4, ch = id & 15; *(LAS v4u*)(lds + P6_C + l * P6_PITCH + 16 * ch) = craw[i]; *(LAS v4u*)(lds + P6_B + l * P6_PITCH + 16 * ch) = braw[i]; }
#pragma unroll
    for (int i = 0; i < 2; ++i) { acsT[hdl * 128 + lane + 64 * i] = ta[i]; dtT[hdl * 128 + lane + 64 * i] = td[i]; }
    LAS unsigned char* xb = lds + P6_X + wave * P6_X_WAVE;
    bf16x8 xf[4][2][2];
#pragma unroll
    for (int jb = 0; jb < 4; ++jb) {
#pragma unroll
        for (int i = 0; i < 4; ++i) { const int id = lane + 64 * i, rr = id >> 3, ch = id & 7; *(LAS v4u*)(xb + rr * P6_X_PITCH + 16 * ch) = xraw[4 * jb + i]; }
#pragma unroll
        for (int t = 0; t < 2; ++t)
#pragma unroll
            for (int pt = 0; pt < 2; ++pt) xf[jb][t][pt] = tr_frag(xb, P6_X_PITCH, 16 * t + 4 * h, 16 * t + 8 + 4 * h, 32 * pt, lane);
        asm volatile("s_waitcnt lgkmcnt(0)" ::: "memory");
    }
    __syncthreads();
    const bf16* Zw = Zb + (row0 + (lane >> 3)) * DSSM + 512 * g + 64 * hdl + 8 * (lane & 7);
    v4u zraw[4];
#pragma unroll
    for (int i = 0; i < 4; ++i) zraw[i] = *(const GAS v4u*)(Zw + (size_t)(8 * i) * DSSM);
#pragma unroll 1
    for (int lt = 0; lt < 4; ++lt) {
#pragma unroll
        for (int i = 0; i < 4; ++i) *(LAS v4u*)(xb + (8 * i + (lane >> 3)) * P6_X_PITCH + 16 * (lane & 7)) = zraw[i];
        if (lt < 3) {
#pragma unroll
            for (int i = 0; i < 4; ++i) zraw[i] = *(const GAS v4u*)(Zw + (size_t)(32 * (lt + 1) + 8 * i) * DSSM); }
        f32x16 acc[2]; acc[0] = (f32x16){}; acc[1] = (f32x16){};
        { bf16x8 hf[8], hg[8];
#pragma unroll
          for (int i = 0; i < 8; ++i) { hf[i] = *(const bf16x8*)(Hc + 16 * i); hg[i] = *(const bf16x8*)(Hc + 32 * SN + 16 * i); }
          bf16x8 cfr[8];
#pragma unroll
          for (int ks = 0; ks < 8; ++ks) cfr[ks] = *(LAS const bf16x8*)(lds + P6_C + (32 * lt + r) * P6_PITCH + (16 * ks + 8 * h) * 2);
          __builtin_amdgcn_sched_barrier(0);
#pragma unroll
          for (int ks = 0; ks < 8; ++ks) { acc[0] = mfma32(cfr[ks], hf[ks], acc[0]); acc[1] = mfma32(cfr[ks], hg[ks], acc[1]); }
          __builtin_amdgcn_sched_barrier(0); }
#pragma unroll
        for (int a = 0; a < 4; ++a) { const f32x4 av = *(LAS const f32x4*)(acsT + hdl * 128 + 32 * lt + 8 * a + 4 * h);
#pragma unroll
            for (int k = 0; k < 4; ++k) { const float ea = exp_fast(av[k]); acc[0][4 * a + k] *= ea; acc[1][4 * a + k] *= ea; } }
        const float al = acsT[hdl * 128 + 32 * lt + r];
#pragma unroll
        for (int jb = 0; jb < 4; ++jb) if (jb <= lt) {
            f32x16 X = (f32x16){};
            { bf16x8 bfr[8], cfr[8];
#pragma unroll
              for (int ks = 0; ks < 8; ++ks) { bfr[ks] = *(LAS const bf16x8*)(lds + P6_B + (32 * jb + r) * P6_PITCH + (16 * ks + 8 * h) * 2); cfr[ks] = *(LAS const bf16x8*)(lds + P6_C + (32 * lt + r) * P6_PITCH + (16 * ks + 8 * h) * 2); }
              __builtin_amdgcn_sched_barrier(0);
#pragma unroll
              for (int ks = 0; ks < 8; ++ks) X = mfma32(bfr[ks], cfr[ks], X);
              __builtin_amdgcn_sched_barrier(0); }
            unsigned gp[8];
#pragma unroll
            for (int a = 0; a < 4; ++a) { const f32x4 av = *(LAS const f32x4*)(acsT + hdl * 128 + 32 * jb + 8 * a + 4 * h), dv = *(LAS const f32x4*)(dtT + hdl * 128 + 32 * jb + 8 * a + 4 * h);
                float v[4];
#pragma unroll
                for (int k = 0; k < 4; ++k) { const int sl = 8 * a + 4 * h + k;
                    float gv = X[4 * a + k] * exp_fast(fminf(al - av[k], 0.f)) * dv[k];
                    if (jb == lt) { gv = (sl <= r) ? gv : 0.f; if (sl == r) gv += Dk; }
                    v[k] = gv; }
                gp[2 * a] = pk2(v[0], v[1]); gp[2 * a + 1] = pk2(v[2], v[3]); }
            const bf16x8 g0 = __builtin_bit_cast(bf16x8, (v4u){gp[0], gp[1], gp[2], gp[3]}), g1 = __builtin_bit_cast(bf16x8, (v4u){gp[4], gp[5], gp[6], gp[7]});
#pragma unroll
            for (int pt = 0; pt < 2; ++pt) { acc[pt] = mfma32(g0, xf[jb][0][pt], acc[pt]); acc[pt] = mfma32(g1, xf[jb][1][pt], acc[pt]); }
            __builtin_amdgcn_sched_barrier(0);
        }
        { const int i15 = lane & 15, qq = i15 >> 2, pp = i15 & 3, g16 = (lane >> 4) & 1;
#pragma unroll
          for (int a = 0; a < 4; ++a) { s16x4 zv[2];
#pragma unroll
              for (int pt = 0; pt < 2; ++pt) zv[pt] = ds_tr(xb + (8 * a + 4 * h + qq) * P6_X_PITCH + (32 * pt + 16 * g16 + 4 * pp) * 2);
#pragma unroll
              for (int k = 0; k < 4; ++k) { const int q = 4 * a + k, l = 32 * lt + crow(q, h);
                  const float y0 = acc[0][q] * silu1(__uint_as_float((unsigned)(unsigned short)zv[0][k] << 16)), y1 = acc[1][q] * silu1(__uint_as_float((unsigned)(unsigned short)zv[1][k] << 16)); acc[0][q] = y0; acc[1][q] = y1;
                  const float ss = half_sum32(y0 * y0 + y1 * y1); if (r == 0) ssqT[l * 8 + hdl] = ss; } } }
        __syncthreads();
#pragma unroll
        for (int q = 0; q < 16; ++q) { const int ll = crow(q, h), l = 32 * lt + ll;
            const f32x4 sa = *(LAS const f32x4*)(ssqT + l * 8), sb = *(LAS const f32x4*)(ssqT + l * 8 + 4);
            const float rs = rsqrtf(((sa[0] + sa[1]) + (sa[2] + sa[3]) + (sb[0] + sb[1]) + (sb[2] + sb[3])) * (1.f / 512.f) + 1e-6f);
            *(LAS bf16*)(xb + ll * 144 + r * 2) = (bf16)f2bf(acc[0][q] * rs * gn0); *(LAS bf16*)(xb + ll * 144 + (32 + r) * 2) = (bf16)f2bf(acc[1][q] * rs * gn1); }
#pragma unroll
        for (int i = 0; i < 4; ++i) { const int l2 = 8 * i + (lane >> 3), ch = lane & 7;
            *(GAS v4u*)(YS + (row0 + 32 * lt + l2) * DSSM + 512 * g + 64 * hdl + 8 * ch) = *(LAS const v4u*)(xb + l2 * 144 + 16 * ch); }
    }
}
__device__ __forceinline__ void ptot_item(unsigned char* ws, const float* clogf, const int* ptab, int item, int lane) {
    asm volatile("" : "+v"(lane));
    const int b = item >> 7, pg = item & 127; const int pid = ptab[b * NPAGES + pg];
    const float* src = clogf + (size_t)pid * PAGE * AH; const int h = lane & 15, rg = lane >> 4; float s = 0.f;
#pragma unroll
    for (int i = 0; i < 32; ++i) s += src[(32 * rg + i) * AH + h];
    s += __shfl_xor(s, 16); s += __shfl_xor(s, 32);
    if (lane < 16) ((float*)(ws + WS_PTOT))[(size_t)item * AH + h] = s;
}
__device__ __forceinline__ void cpl_item(unsigned char* ws, const float* clogf, const int* ptab, int item, int lane) {
    asm volatile("" : "+v"(lane));
    const int b = item >> 7, pg = item & 127; const int pid = ptab[b * NPAGES + pg];
    const float* src = clogf + (size_t)pid * PAGE * AH; const float* ptot = (const float*)(ws + WS_PTOT) + (size_t)b * NPAGES * AH;
    const int h = lane & 15, rg = lane >> 4; float off = 0.f;
#pragma unroll 8
    for (int p = rg; p < pg; p += 4) off += ptot[p * AH + h];
    off += __shfl_xor(off, 16); off += __shfl_xor(off, 32);
    float v[32], s = 0.f;
#pragma unroll
    for (int i = 0; i < 32; ++i) { s += src[(32 * rg + i) * AH + h]; v[i] = s; }
    const float t0 = __shfl(s, h), t1 = __shfl(s, 16 + h), t2 = __shfl(s, 32 + h);
    off += (rg > 0 ? t0 : 0.f) + (rg > 1 ? t1 : 0.f) + (rg > 2 ? t2 : 0.f);
    float* dst = (float*)(ws + WS_CPL) + ((size_t)b * PAST + (size_t)pg * PAGE) * AH;
#pragma unroll
    for (int i = 0; i < 32; ++i) dst[(32 * rg + i) * AH + h] = (off + v[i]) * 1.4426950408889634f;
}
__device__ __forceinline__ void ck_item(unsigned char* ws, int item, int lane) {
    asm volatile("" : "+v"(lane));
    const int h = item & 15, b = item >> 4;
    const float* LOGF = (const float*)(ws + WS_LOGF) + ((size_t)b * SEQ + 64 * lane) * AH + h; float* CK = (float*)(ws + WS_CK) + ((size_t)b * AH + h) * SEQ + 64 * lane;
    float v[64], s = 0.f;
#pragma unroll
    for (int i = 0; i < 64; ++i) v[i] = LOGF[(size_t)i * AH];
#pragma unroll
    for (int i = 0; i < 64; ++i) { s += v[i]; v[i] = s; }
    const float off = wave_scan_incl(s, lane) - s;
#pragma unroll
    for (int i = 0; i < 64; i += 4) *(f32x4*)(CK + i) = (f32x4){(off + v[i]) * 1.4426950408889634f, (off + v[i + 1]) * 1.4426950408889634f, (off + v[i + 2]) * 1.4426950408889634f, (off + v[i + 3]) * 1.4426950408889634f};
}
#include <hip/hip_bf16.h>
#include <cmath>
namespace attn_body {
using bf16=__hip_bfloat16;
using bf16x8=__attribute__((ext_vector_type(8)))short;
using s16x4=__attribute__((ext_vector_type(4)))short;
using f32x16=__attribute__((ext_vector_type(16)))float;
using u32x4=__attribute__((ext_vector_type(4)))unsigned;
constexpr int BATCH=4,NHEAD=16,SEQ=4096,D=64,DM=NHEAD*D,KP=256;
constexpr int NW=8,QBLK=32,QB=QBLK*NW,KVBLK=64,NQB=SEQ/QB;
constexpr int ATTN_PITCH=DM, ATTN_UNIT_ROWS=QB;
__device__ __forceinline__ int crow(int r,int hi){return (r&3)+8*(r>>2)+4*hi;}
#define SBAR() __builtin_amdgcn_sched_barrier(0)
__device__ __forceinline__ void cmask(f32x16&p0,f32x16&p1,int jb,int qrel,int hi){
  const float NEG=-INFINITY; int kb=64*jb+4*hi;
  #pragma unroll
  for(int r=0;r<16;++r){int kv=kb+(r&3)+8*(r>>2); if(kv>qrel)p0[r]=NEG; if(kv+32>qrel)p1[r]=NEG;}
}

constexpr int NSLOT=3, SLOTB=8192;
constexpr int LDS_K=0, LDS_V=NSLOT*SLOTB, LDS_WS=2*NSLOT*SLOTB, LDS_OST=LDS_WS+NW*64*4, LDS_CK=LDS_OST+NW*4096, LDS_BYTES=LDS_CK+SEQ*4;
constexpr float C2=0.125f*1.4426950408889634f;
__device__ __forceinline__ void glds16(const void*gsrc,unsigned lds_dst){unsigned keep;
  asm volatile("s_mov_b32 %0, m0\n\ts_mov_b32 m0, %2\n\ts_nop 0\n\tglobal_load_lds_dwordx4 %1, off\n\ts_mov_b32 m0, %0":"=&s"(keep):"v"(gsrc),"s"(lds_dst):"memory");}
__device__ __forceinline__ float max3f(float a,float b,float c){float r;asm("v_max3_f32 %0, %1, %2, %3":"=v"(r):"v"(a),"v"(b),"v"(c));return r;}
__device__ __forceinline__ float max2f(float a,float b){float r;asm("v_max_f32_e32 %0, %1, %2":"=v"(r):"v"(a),"v"(b));return r;}
__device__ __forceinline__ float fadd_s(float a,float b){float r;asm("v_add_f32_e32 %0, %1, %2":"=v"(r):"v"(a),"v"(b));return r;}
__device__ __forceinline__ float fsub_s(float a,float b){float r;asm("v_sub_f32_e32 %0, %1, %2":"=v"(r):"v"(a),"v"(b));return r;}
typedef float f32x2_t __attribute__((ext_vector_type(2))); typedef float f32x4_t __attribute__((ext_vector_type(4))); typedef __bf16 bf16x2_t __attribute__((ext_vector_type(2)));
__device__ __forceinline__ unsigned cvtpk_s(float lo,float hi){f32x2_t v={lo,hi};bf16x2_t b=__builtin_convertvector(v,bf16x2_t);return __builtin_bit_cast(unsigned,b);}
#define WAIT_BAR(N) asm volatile("s_waitcnt vmcnt(" #N ") lgkmcnt(0)\n\ts_barrier":::"memory")

__device__ __forceinline__ void qkt(f32x16&p0,f32x16&p1,const char*Kslot,const bf16x8*qr,int r32,int hi){
  const char*kb=Kslot+hi*1024+r32*16;
  #pragma unroll
  for(int d0=0;d0<4;++d0){
    const bf16x8 b0=*reinterpret_cast<const bf16x8*>(kb+d0*2048);
    const bf16x8 b1=*reinterpret_cast<const bf16x8*>(kb+d0*2048+512);
    {p0=__builtin_amdgcn_mfma_f32_32x32x16_bf16(b0,qr[d0],p0,0,0,0);p1=__builtin_amdgcn_mfma_f32_32x32x16_bf16(b1,qr[d0],p1,0,0,0);}}
}
typedef __attribute__((address_space(3))) char* lds_cptr;
typedef short v4i16_t __attribute__((ext_vector_type(4)));
__device__ __forceinline__ void kload8(bf16x8*kf,lds_cptr kp){
  kf[0]=*(const __attribute__((address_space(3))) bf16x8*)(kp);      kf[1]=*(const __attribute__((address_space(3))) bf16x8*)(kp+512);
  kf[2]=*(const __attribute__((address_space(3))) bf16x8*)(kp+2048); kf[3]=*(const __attribute__((address_space(3))) bf16x8*)(kp+2560);
  kf[4]=*(const __attribute__((address_space(3))) bf16x8*)(kp+4096); kf[5]=*(const __attribute__((address_space(3))) bf16x8*)(kp+4608);
  kf[6]=*(const __attribute__((address_space(3))) bf16x8*)(kp+6144); kf[7]=*(const __attribute__((address_space(3))) bf16x8*)(kp+6656);
}
__device__ __forceinline__ void kload2(bf16x8*kf,lds_cptr kp,int j){ kf[2*j]=*(const __attribute__((address_space(3))) bf16x8*)(kp+j*2048); kf[2*j+1]=*(const __attribute__((address_space(3))) bf16x8*)(kp+j*2048+512); }
__device__ __forceinline__ s16x4 vtr(lds_cptr p){ return __builtin_bit_cast(s16x4,__builtin_amdgcn_ds_read_tr16_b64_v4i16((__attribute__((address_space(3))) v4i16_t*)p)); }
__device__ __forceinline__ float rowmax(const f32x16&p0,const f32x16&p1){
  float a=max3f(p0[0],p0[1],p1[0]),b=max3f(p0[2],p0[3],p1[1]);a=max3f(a,p1[2],p1[3]);
  #pragma unroll
  for(int r=4;r<16;r+=4){a=max3f(a,p0[r],p0[r+1]);b=max3f(b,p0[r+2],p0[r+3]);a=max3f(a,p1[r],p1[r+1]);b=max3f(b,p1[r+2],p1[r+3]);}
  const float m=max2f(a,b);
  auto rr=__builtin_amdgcn_permlane32_swap(__float_as_uint(m),__float_as_uint(m),false,false);
  return max2f(__uint_as_float(rr[0]),__uint_as_float(rr[1]));
}
__device__ __forceinline__ void pv(f32x16*o,int vb,bf16x8 pa0,bf16x8 pa1,bf16x8 pa2,bf16x8 pa3){
  #pragma unroll
  for(int d0=0;d0<2;++d0){s16x4 lo[4],hi[4];
    #pragma unroll
    for(int ks=0;ks<4;++ks){
      asm volatile("ds_read_b64_tr_b16 %0,%1 offset:%c2":"=&v"(lo[ks]):"v"(vb),"i"(d0*4096+ks*1024):"memory");
      asm volatile("ds_read_b64_tr_b16 %0,%1 offset:%c2":"=&v"(hi[ks]):"v"(vb),"i"(d0*4096+ks*1024+512):"memory");}
    asm volatile("s_waitcnt lgkmcnt(0)":::"memory");SBAR();
    #define PK(k) (bf16x8){lo[k][0],lo[k][1],lo[k][2],lo[k][3],hi[k][0],hi[k][1],hi[k][2],hi[k][3]}
    o[d0]=__builtin_amdgcn_mfma_f32_32x32x16_bf16(pa0,PK(0),o[d0],0,0,0);
    o[d0]=__builtin_amdgcn_mfma_f32_32x32x16_bf16(pa1,PK(1),o[d0],0,0,0);
    o[d0]=__builtin_amdgcn_mfma_f32_32x32x16_bf16(pa2,PK(2),o[d0],0,0,0);
    o[d0]=__builtin_amdgcn_mfma_f32_32x32x16_bf16(pa3,PK(3),o[d0],0,0,0);
    #undef PK
  }
}

#ifndef ATTN_STORE16
#define ATTN_STORE16(p,v) (*(u32x4*)(p)=(v))
#endif
template<int THRL> __device__ __forceinline__ void attn_unit(int b,int h,int qb,const bf16*Q,const bf16*__restrict__ K,const bf16*__restrict__ V,bf16*O,const float*__restrict__ CKT,float skip_thr,char*shm){
  int tid_=threadIdx.x; asm volatile("":"+v"(tid_));
  const int tid=tid_,lane=tid&63,r32=lane&31,hi=lane>>5; const int wid=__builtin_amdgcn_readfirstlane(tid>>6);
  const long rowbase=(long)b*SEQ; const int q0=qb*QB;
  const bf16*Qw=Q+(rowbase+q0+wid*QBLK)*DM+h*D;
  const bf16*Kh=K+rowbase*KP+(h>>2)*D,*Vh=V+rowbase*KP+(h>>2)*D;
  const unsigned lds0=(unsigned)(uintptr_t)shm;
  float*wsf=(float*)(shm+LDS_WS)+wid*64;
  const bf16*ksrc=Kh+(long)lane*KP+wid*8;
  const bf16*vsrc=Vh+(long)(16*(wid&3)+(lane>>2))*KP+(wid>>2)*32+(lane&3)*8;
  const unsigned kdst=lds0+LDS_K+wid*1024, vdst=lds0+LDS_V+wid*1024;
  #define DMA_K(t,slot) glds16(ksrc+(long)((t)+t0)*KVBLK*KP,(unsigned)__builtin_amdgcn_readfirstlane(kdst+(slot)))
  #define DMA_V(t,slot) glds16(vsrc+(long)((t)+t0)*KVBLK*KP,(unsigned)__builtin_amdgcn_readfirstlane(vdst+(slot)))
  const int vb0=(int)(lds0+LDS_V)+((lane>>4)&1)*32+(lane&3)*8+(4*hi+((lane&15)>>2))*64;
  const char*Kbase=shm+LDS_K; bf16x8 kf[8];
  const lds_cptr shm3=(lds_cptr)shm; const lds_cptr kp0=shm3+LDS_K+hi*1024+r32*16; const lds_cptr vp0=shm3+LDS_V+((lane>>4)&1)*32+(lane&3)*8+(4*hi+((lane&15)>>2))*64;
  int NT=(q0+QB)/KVBLK;
  { __attribute__((address_space(3))) float*ckt=(__attribute__((address_space(3))) float*)(shm3+LDS_CK); const float*src=CKT+((long)b*NHEAD+h)*SEQ; for(int i=tid;i<q0+QB;i+=NW*64)ckt[i]=-src[i]; }
  asm volatile("s_waitcnt lgkmcnt(0)\n\ts_barrier":::"memory");
  int t0=0; { const __attribute__((address_space(3))) float*ck0=(const __attribute__((address_space(3))) float*)(shm3+LDS_CK); const float cq=ck0[q0];
    int lo=0,hi=NT-4;
    while(lo<hi){ const int mid=(lo+hi)>>1; if(cq-ck0[64*mid+63]>skip_thr)lo=mid+1; else hi=mid; }
    t0=lo&~1; }
  NT-=t0;
  const __attribute__((address_space(3))) float*ckt3=(const __attribute__((address_space(3))) float*)(shm3+LDS_CK)+64*t0;
  #define LDBIAS(C0,C1,t) do{ const __attribute__((address_space(3))) float*cp_=ckt3+64*(t)+4*hi; \
    _Pragma("unroll") for(int a_=0;a_<4;++a_){ const f32x4_t v0_=*(const __attribute__((address_space(3))) f32x4_t*)(cp_+8*a_), v1_=*(const __attribute__((address_space(3))) f32x4_t*)(cp_+32+8*a_); \
      _Pragma("unroll") for(int b_=0;b_<4;++b_){ C0[4*a_+b_]=v0_[b_]; C1[4*a_+b_]=v1_[b_]; } } }while(0)
  DMA_K(0,0);DMA_V(0,0);DMA_K(1,SLOTB);
  bf16x8 qr[4];
  #pragma unroll
  for(int d0=0;d0<4;++d0)qr[d0]=*reinterpret_cast<const bf16x8*>(&Qw[(long)r32*DM+d0*16+hi*8]);
  float mhat=0.f,l_reg=0.f;f32x16 o[2];o[0]=f32x16{};o[1]=f32x16{};
  const int qrel=wid*QBLK+r32;
  #define CMASK(P0,P1,t) do{int jb_=(t)-(NT-4); if(jb_>=0)cmask(P0,P1,jb_,qrel,hi);}while(0)
  bool resc=false;
  #define START(P0,P1) do{ const float rm=rowmax(P0,P1); resc=false; \
    { const float dl=rm; mhat=fadd_s(mhat,dl); \
      _Pragma("unroll") for(int r=0;r<16;++r){P0[r]=fsub_s(P0[r],dl);P1[r]=fsub_s(P1[r],dl);} \
      } \
    _Pragma("unroll") for(int r=0;r<16;++r)P0[r]=__builtin_amdgcn_exp2f(P0[r]); }while(0)
  #define RESC() do{ if(resc){ asm volatile("s_waitcnt lgkmcnt(0)":::"memory"); \
      _Pragma("unroll") for(int d_=0;d_<2;++d_) _Pragma("unroll") for(int r=0;r<16;++r)o[d_][r]*=wsf[crow(r,hi)]; } }while(0)
  f32x16 pA0,pA1,pB0,pB1;
  int sl_prev=0,sl_cur=0,sl_next=SLOTB;
  #define ROT() do{sl_prev=sl_cur;sl_cur=sl_next;sl_next=(sl_next==(NSLOT-1)*SLOTB)?0:sl_next+SLOTB;}while(0)
  DMA_K(2,2*SLOTB);
  WAIT_BAR(3);
  LDBIAS(pA0,pA1,0); qkt(pA0,pA1,Kbase,qr,r32,hi);asm volatile("s_nop 15\n\ts_nop 7":"+v"(pA0),"+v"(pA1));CMASK(pA0,pA1,0);
  START(pA0,pA1);
  _Pragma("unroll") for(int r=0;r<16;++r)pA1[r]=__builtin_amdgcn_exp2f(pA1[r]);
  LDBIAS(pB0,pB1,1);
  WAIT_BAR(0);
  DMA_K(3,0);DMA_V(1,SLOTB);
  ROT();
  kload8(kf,kp0+sl_cur);
  WAIT_BAR(2);
  s16x4 vlo[8],vhi[8]; u32x4 pw0,pw1,pw2,pw3;
  #define PKW(P,B) cvtpk_s(P[B],P[B+1])
  #define PAF(k) __builtin_bit_cast(bf16x8,pw##k)
  #define VFR(i) (bf16x8){vlo[i][0],vlo[i][1],vlo[i][2],vlo[i][3],vhi[i][0],vhi[i][1],vhi[i][2],vhi[i][3]}
  #define PIN(x) asm volatile("":"+v"(x))
  #define MX3(a,b,c) __builtin_fmaxf(__builtin_fmaxf((a),(b)),(c))
  #define GAPA(MF,A0,A1,A2,A3,W0,W1,PW) do{ MF; sacc+=A0; sacc+=A1; sacc+=A2; sacc+=A3; PIN(sacc); W0; W1; PIN(PW); SBAR(); }while(0)
  #define EX(v) __builtin_amdgcn_exp2f(v)
  #define GAPB(MF,X,B) do{ MF; X[B]=EX(X[B]-mh_); X[B+1]=EX(X[B+1]-mh_); X[B+2]=EX(X[B+2]-mh_); X[B+3]=EX(X[B+3]-mh_); PIN(X); SBAR(); }while(0)
  #define VRD(i) do{ vlo[i]=vtr(vp_+(((i)>>2)*4096+((i)&3)*1024)); vhi[i]=vtr(vp_+(((i)>>2)*4096+((i)&3)*1024+512)); }while(0)
  #define KRD(G,j) do{ if(G){ kload2(kf,kp0+sl_next,j); SBAR(); } }while(0)
  #define STEP(C0,C1,P0,P1,t,GK,GV,GL) do{ SBAR(); \
    const lds_cptr vp_=vp0+sl_prev; \
    VRD(0); SBAR(); float sacc=(P0[0]+P0[1]); \
    GAPA(C0=__builtin_amdgcn_mfma_f32_32x32x16_bf16(kf[0],qr[0],C0,0,0,0), P0[2],P0[3],P0[4],P0[5],     pw0[0]=PKW(P0,0), pw0[1]=PKW(P0,2), pw0); \
    VRD(4); SBAR(); GAPA(C1=__builtin_amdgcn_mfma_f32_32x32x16_bf16(kf[1],qr[0],C1,0,0,0), P0[6],P0[7],P0[8],P0[9],     pw0[2]=PKW(P0,4), pw0[3]=PKW(P0,6), pw0); \
    VRD(1); SBAR(); GAPA(C0=__builtin_amdgcn_mfma_f32_32x32x16_bf16(kf[2],qr[1],C0,0,0,0),   P0[10],P0[11],P0[12],P0[13], pw1[0]=PKW(P0,8), pw1[1]=PKW(P0,10), pw1); \
    VRD(5); SBAR(); GAPA(C1=__builtin_amdgcn_mfma_f32_32x32x16_bf16(kf[3],qr[1],C1,0,0,0),   P0[14],P0[15],P1[0],P1[1],   pw1[2]=PKW(P0,12),pw1[3]=PKW(P0,14), pw1); \
    VRD(2); SBAR(); GAPA(C0=__builtin_amdgcn_mfma_f32_32x32x16_bf16(kf[4],qr[2],C0,0,0,0),   P1[2],P1[3],P1[4],P1[5],     pw2[0]=PKW(P1,0), pw2[1]=PKW(P1,2), pw2); \
    VRD(6); SBAR(); GAPA(C1=__builtin_amdgcn_mfma_f32_32x32x16_bf16(kf[5],qr[2],C1,0,0,0),   P1[6],P1[7],P1[8],P1[9],     pw2[2]=PKW(P1,4), pw2[3]=PKW(P1,6), pw2); \
    VRD(3); SBAR(); GAPA(C0=__builtin_amdgcn_mfma_f32_32x32x16_bf16(kf[6],qr[3],C0,0,0,0),   P1[10],P1[11],P1[12],P1[13], pw3[0]=PKW(P1,8), pw3[1]=PKW(P1,10), pw3); \
    VRD(7); SBAR(); GAPA(C1=__builtin_amdgcn_mfma_f32_32x32x16_bf16(kf[7],qr[3],C1,0,0,0),   P1[14],P1[15],0.f,0.f,       pw3[2]=PKW(P1,12),pw3[3]=PKW(P1,14), pw3); \
    l_reg+=sacc; \
    if(GK){DMA_K((t)+3,sl_cur);} if(GV){DMA_V((t)+1,sl_next);} \
    CMASK(C0,C1,t); \
    { float a=MX3(C0[0],C0[1],C1[0]),b=MX3(C0[2],C0[3],C1[1]); a=MX3(a,C1[2],C1[3]); \
      _Pragma("unroll") for(int r=4;r<16;r+=4){a=MX3(a,C0[r],C0[r+1]);b=MX3(b,C0[r+2],C0[r+3]);a=MX3(a,C1[r],C1[r+1]);b=MX3(b,C1[r+2],C1[r+3]);} \
      float rm=__builtin_fmaxf(a,b); { auto rr=__builtin_amdgcn_permlane32_swap(__float_as_uint(rm),__float_as_uint(rm),false,false); rm=__builtin_fmaxf(__uint_as_float(rr[0]),__uint_as_float(rr[1])); } \
      resc=false; \
      rm-=mhat; \
      if(__builtin_expect(__any(rm>(float)THRL),0)){ const float dl=__builtin_fmaxf(rm,0.f); mhat+=dl; \
        const float f=__builtin_amdgcn_exp2f(-dl); l_reg*=f; if(hi==0)wsf[r32]=f; resc=true; } } \
    const float mh_=mhat; if(GL){ LDBIAS(P0,P1,(t)+1); } SBAR(); \
    GAPB(o[0]=__builtin_amdgcn_mfma_f32_32x32x16_bf16(PAF(0),VFR(0),o[0],0,0,0), C0,0); \
    GAPB(o[1]=__builtin_amdgcn_mfma_f32_32x32x16_bf16(PAF(0),VFR(4),o[1],0,0,0), C0,4); \
    KRD(GL,0); GAPB(o[0]=__builtin_amdgcn_mfma_f32_32x32x16_bf16(PAF(1),VFR(1),o[0],0,0,0), C0,8); \
    KRD(GL,1); GAPB(o[1]=__builtin_amdgcn_mfma_f32_32x32x16_bf16(PAF(1),VFR(5),o[1],0,0,0), C0,12); \
    KRD(GL,2); GAPB(o[0]=__builtin_amdgcn_mfma_f32_32x32x16_bf16(PAF(2),VFR(2),o[0],0,0,0), C1,0); \
    KRD(GL,3); GAPB(o[1]=__builtin_amdgcn_mfma_f32_32x32x16_bf16(PAF(2),VFR(6),o[1],0,0,0), C1,4); \
    GAPB(o[0]=__builtin_amdgcn_mfma_f32_32x32x16_bf16(PAF(3),VFR(3),o[0],0,0,0), C1,8); \
    GAPB(o[1]=__builtin_amdgcn_mfma_f32_32x32x16_bf16(PAF(3),VFR(7),o[1],0,0,0), C1,12); \
    }while(0)
  int t=1;
  #undef CMASK
  #define CMASK(P0,P1,t) do{}while(0)
  for(;t+5<NT;t+=2){
    STEP(pB0,pB1,pA0,pA1,t,true,true,true);     WAIT_BAR(2); RESC(); ROT();
    STEP(pA0,pA1,pB0,pB1,t+1,true,true,true);   WAIT_BAR(2); RESC(); ROT();
  }
  #undef CMASK
  #define CMASK(P0,P1,t) do{int jb_=(t)-(NT-4); if(jb_>=0)cmask(P0,P1,jb_,qrel,hi);}while(0)
  #define ENDW(tt) do{ if((tt)+3<NT){WAIT_BAR(2);} else if((tt)+2<NT){WAIT_BAR(1);} else {WAIT_BAR(0);} }while(0)
  for(;t+1<NT;t+=2){
    STEP(pB0,pB1,pA0,pA1,t,(t+3<NT),(t+1<NT),(t+1<NT));       ENDW(t);   RESC(); ROT();
    STEP(pA0,pA1,pB0,pB1,t+1,(t+4<NT),(t+2<NT),(t+2<NT));     ENDW(t+1); RESC(); ROT();
  }
  STEP(pB0,pB1,pA0,pA1,NT-1,false,false,false); RESC();
  { float sacc=pB0[0]+pB0[1]; _Pragma("unroll") for(int r=2;r<16;++r)sacc+=pB0[r]; _Pragma("unroll") for(int r=0;r<16;++r)sacc+=pB1[r]; l_reg+=sacc;
    pw0=(u32x4){PKW(pB0,0),PKW(pB0,2),PKW(pB0,4),PKW(pB0,6)};pw1=(u32x4){PKW(pB0,8),PKW(pB0,10),PKW(pB0,12),PKW(pB0,14)};pw2=(u32x4){PKW(pB1,0),PKW(pB1,2),PKW(pB1,4),PKW(pB1,6)};pw3=(u32x4){PKW(pB1,8),PKW(pB1,10),PKW(pB1,12),PKW(pB1,14)};
    SBAR(); pv(o,vb0+sl_cur,PAF(0),PAF(1),PAF(2),PAF(3)); }
  #undef PKW
  #undef PAF
  #undef VFR
  #undef PIN
  #undef MX3
  #undef GAPA
  #undef GAPB
  #undef EX
  #undef VRD
  #undef KRD
  #undef STEP
  #undef ENDW
  {auto rr=__builtin_amdgcn_permlane32_swap(__float_as_uint(l_reg),__float_as_uint(l_reg),false,false);l_reg=__uint_as_float(rr[0])+__uint_as_float(rr[1]);}
  if(hi==0)wsf[32+r32]=l_reg;asm volatile("s_waitcnt lgkmcnt(0)":::"memory");
  float rli[16];
  #pragma unroll
  for(int r=0;r<16;++r)rli[r]=__builtin_amdgcn_rcpf(wsf[32+crow(r,hi)]);
  bf16*Ow=O+(rowbase+q0+wid*QBLK)*DM+h*D;
  { bf16*stg=(bf16*)(shm+LDS_OST)+wid*2048;
    #pragma unroll
    for(int r=0;r<16;++r){const int orow=crow(r,hi);
      #pragma unroll
      for(int d0=0;d0<2;++d0)stg[orow*64+d0*32+r32]=__float2bfloat16(o[d0][r]*rli[r]);}
    asm volatile("s_waitcnt lgkmcnt(0)":::"memory");
    #pragma unroll
    for(int i=0;i<4;++i){const int row=i*8+(lane>>3),ch=lane&7; const u32x4 v=*(const u32x4*)(stg+row*64+ch*8); ATTN_STORE16(Ow+(long)row*DM+ch*8,v);} }
  asm volatile("s_waitcnt lgkmcnt(0)\n\ts_barrier":::"memory");
  #undef DMA_K
  #undef DMA_V
  #undef CMASK
  #undef START
  #undef RESC
  #undef ROT
}
constexpr int ATTN_LDS_BYTES=LDS_BYTES;
struct AttnTensors { const bf16* Q; const bf16* K; const bf16* V; bf16* O; const float* CKT; };
template<int THRL=8> __device__ __forceinline__ void attn_segs(char*lds,const AttnTensors&T,float skip_thr,int nseg,int cl0,int lo0,int hi0,int cl1,int lo1,int hi1){
  #pragma unroll 1
  for(int sg=0;sg<nseg;++sg){ const int cl=sg?cl1:cl0,i_lo=sg?lo1:lo0,i_hi=sg?hi1:hi0; const int s=cl&3,bh=cl>>2;
    #pragma unroll 1
    for(int i=i_lo;i<i_hi;++i){ const int qb=(i==0)?s:(i==1)?7-s:(i==2)?8+s:15-s; attn_unit<THRL>(bh/NHEAD,bh%NHEAD,qb,T.Q,T.K,T.V,T.O,T.CKT,skip_thr,lds); } }
}
template<int THRL=8> __device__ __forceinline__ void attn_phase(char*lds,const AttnTensors&T,float skip_thr,int vcu,int G,int i_lo,int i_hi){
  for(int cl=vcu;cl<BATCH*NHEAD*4;cl+=G){ const int s=cl&3,bh=cl>>2;
    #pragma unroll 1
    for(int i=i_lo;i<i_hi;++i){ const int qb=(i==0)?s:(i==1)?7-s:(i==2)?8+s:15-s; attn_unit<THRL>(bh/NHEAD,bh%NHEAD,qb,T.Q,T.K,T.V,T.O,T.CKT,skip_thr,lds); } }
}
#undef SBAR
#undef WAIT_BAR
}
constexpr int DK_OFF = 0, DK_PITCH = 144, DK_HEAD = 64 * 144, DV_OFF = 4 * DK_HEAD, DV_PITCH = 192, DV_HEAD = 64 * 192, DC_OFF = DV_OFF + 4 * DV_HEAD, DW_OFF = DC_OFF + 4096;
constexpr int DPART_STRIDE = 32 + 32 + 32 * 64;
static_assert(DW_OFF + 2048 <= MISC_OFF, "decode LDS map");
__device__ __forceinline__ void dec_unit(unsigned char* ws, const float* ck, const float* cv, const int* ptab, LAS unsigned char* lds, int unit, int tid, int lane, int wave) {
    asm volatile("" : "+v"(tid));
    lane = tid & 63;
    const int b = unit & 31, sp = unit >> 5; const int kvh = wave >> 1, kh = wave & 1, h = lane >> 5, r = lane & 31, g = r >> 3, qi = r & 7, hq = 4 * kvh + g;
    const int tile0 = sp < 4 ? 35 * sp : (sp == 4 ? 140 : (sp == 5 ? 176 : (sp == 6 ? 212 : 238))), ntile = sp < 4 ? 35 : (sp < 6 ? 36 : (sp == 6 ? 26 : 18));
    const bf16* Qb = (const bf16*)(ws + WS_Q); const float* CPL = (const float*)(ws + WS_CPL) + ((size_t)b * PAST + (size_t)tile0 * 64) * AH;
    bf16x8 qf[4];
#pragma unroll
    for (int ks = 0; ks < 4; ++ks) qf[ks] = *(const bf16x8*)(Qb + ((size_t)MP + 8 * b + qi) * 1024 + hq * 64 + 16 * ks + 8 * h);
    float m;
    { const bf16* Kb = (const bf16*)(ws + WS_K) + ((size_t)MP + 8 * b + qi) * 256 + kvh * 64; const bf16* Qr = Qb + ((size_t)MP + 8 * b + qi) * 1024 + hq * 64; float d = 0.f;
#pragma unroll
      for (int k = 0; k < 8; ++k) { float qa[8], ka[8]; unpk8(*(const GAS v4u*)(Qr + 8 * k), qa); unpk8(*(const GAS v4u*)(Kb + 8 * k), ka);
#pragma unroll
          for (int e = 0; e < 8; ++e) d += qa[e] * ka[e]; }
      const float* LOGF = (const float*)(ws + WS_LOGF) + ((size_t)MP + 8 * b) * AH + hq; float cum = ((const float*)(ws + WS_CPL))[((size_t)b * PAST + PAST - 1) * AH + hq];
      for (int k = 0; k <= qi; ++k) cum += LOGF[k * AH] * 1.4426950408889634f;
      m = d - cum; }
    float l = 0.f; f32x16 o[2]; o[0] = (f32x16){}; o[1] = (f32x16){};
    LAS float* wsf = (LAS float*)(lds + DW_OFF) + wave * 64; LAS unsigned* flg = (LAS unsigned*)(lds + DW_OFF + 2048 - 16);
    f32x4 kr[8], vr[8], cr;
    __syncthreads();
    if (tid == 0) { flg[0] = 0u; flg[1] = 0u; }
    { const int ta = tile0 + ntile - 1; const int pid = ptab[b * NPAGES + (ta >> 1)]; const float* kb = ck + ((size_t)pid * PAGE + 64 * (ta & 1)) * 256;
#pragma unroll
      for (int i = 0; i < 8; ++i) kr[i] = *(const GAS f32x4*)(kb + 4 * (tid + 512 * i));
      if (tid < 256) cr = *(const GAS f32x4*)(CPL + (size_t)(ntile - 1) * 64 * AH + 4 * tid); }
    bool vhave = false;
#pragma unroll 1
    for (int tt = ntile - 1; tt >= 0; --tt) {
#pragma unroll
        for (int i = 0; i < 8; ++i) { const int idx = tid + 512 * i, tok = idx >> 6, w = idx & 63, hh = w >> 4, d = (w & 15) * 4;
            *(LAS v2u*)(lds + DK_OFF + hh * DK_HEAD + tok * DK_PITCH + d * 2) = (v2u){pk2(kr[i][0], kr[i][1]), pk2(kr[i][2], kr[i][3])}; }
        if (vhave) {
#pragma unroll
            for (int i = 0; i < 8; ++i) { const int idx = tid + 512 * i, tok = idx >> 6, w = idx & 63, hh = w >> 4, d = (w & 15) * 4;
                *(LAS v2u*)(lds + DV_OFF + hh * DV_HEAD + tok * DV_PITCH + d * 2) = (v2u){pk2(vr[i][0], vr[i][1]), pk2(vr[i][2], vr[i][3])}; } }
        if (tid < 256) *(LAS f32x4*)(lds + DC_OFF + 16 * tid) = cr;
        if (tid == 0) flg[(tt + 1) & 1] = 0u;
        __syncthreads();
        if (tt > 0) { const int t1 = tt - 1, ta = tile0 + t1; const int pid = ptab[b * NPAGES + (ta >> 1)]; const float* kb = ck + ((size_t)pid * PAGE + 64 * (ta & 1)) * 256;
#pragma unroll
            for (int i = 0; i < 8; ++i) kr[i] = *(const GAS f32x4*)(kb + 4 * (tid + 512 * i));
            if (tid < 256) cr = *(const GAS f32x4*)(CPL + (size_t)t1 * 64 * AH + 4 * tid); }
        f32x16 s; const LAS float* cp = (const LAS float*)(lds + DC_OFF);
#pragma unroll
        for (int q = 0; q < 16; ++q) s[q] = -cp[(32 * kh + crow(q, h)) * AH + hq];
#pragma unroll
        for (int ks = 0; ks < 4; ++ks) { const bf16x8 kf = *(LAS const bf16x8*)(lds + DK_OFF + kvh * DK_HEAD + (32 * kh + r) * DK_PITCH + (16 * ks + 8 * h) * 2); s = mfma32(kf, qf[ks], s); }
        float tm = s[0];
#pragma unroll
        for (int q = 1; q < 16; ++q) tm = fmaxf(tm, s[q]);
        { auto rr = __builtin_amdgcn_permlane32_swap(__float_as_uint(tm), __float_as_uint(tm), false, false); tm = fmaxf(__uint_as_float(rr[0]), __uint_as_float(rr[1])); }
        const bool need = __any(tm - m >= -152.f);
        if (need && lane == 0) flg[tt & 1] = 1u;
        __syncthreads();
        const bool need_any = (flg[tt & 1] != 0u);
        if (need_any) {
            if (!vhave) {
                const int ta = tile0 + tt; const int pid = ptab[b * NPAGES + (ta >> 1)]; const float* vb = cv + ((size_t)pid * PAGE + 64 * (ta & 1)) * 256;
#pragma unroll
                for (int i = 0; i < 8; ++i) vr[i] = *(const GAS f32x4*)(vb + 4 * (tid + 512 * i));
#pragma unroll
                for (int i = 0; i < 8; ++i) { const int idx = tid + 512 * i, tok = idx >> 6, w = idx & 63, hh = w >> 4, d = (w & 15) * 4;
                    *(LAS v2u*)(lds + DV_OFF + hh * DV_HEAD + tok * DV_PITCH + d * 2) = (v2u){pk2(vr[i][0], vr[i][1]), pk2(vr[i][2], vr[i][3])}; }
                __syncthreads();
            }
            if (tt > 0) { const int ta = tile0 + tt - 1; const int pid = ptab[b * NPAGES + (ta >> 1)]; const float* vb = cv + ((size_t)pid * PAGE + 64 * (ta & 1)) * 256;
#pragma unroll
                for (int i = 0; i < 8; ++i) vr[i] = *(const GAS f32x4*)(vb + 4 * (tid + 512 * i)); }
            if (need) {
                const float mn = fmaxf(m, tm), alpha = __builtin_amdgcn_exp2f(m - mn); m = mn;
                float ps = 0.f;
#pragma unroll
                for (int q = 0; q < 16; ++q) { s[q] = __builtin_amdgcn_exp2f(s[q] - mn); ps += s[q]; }
                l = l * alpha + ps;
                if (h == 0) wsf[r] = alpha;
                unsigned pp[8];
#pragma unroll
                for (int q = 0; q < 16; q += 2) pp[q >> 1] = pk2(s[q], s[q + 1]);
                const bf16x8 p0 = __builtin_bit_cast(bf16x8, (v4u){pp[0], pp[1], pp[2], pp[3]}), p1 = __builtin_bit_cast(bf16x8, (v4u){pp[4], pp[5], pp[6], pp[7]});
#pragma unroll
                for (int q = 0; q < 16; ++q) { const float a = wsf[crow(q, h)]; o[0][q] *= a; o[1][q] *= a; }
                LAS const unsigned char* vt = lds + DV_OFF + kvh * DV_HEAD;
#pragma unroll
                for (int dt = 0; dt < 2; ++dt) { const bf16x8 v0 = tr_frag(vt, DV_PITCH, 32 * kh + 4 * h, 32 * kh + 8 + 4 * h, 32 * dt, lane), v1 = tr_frag(vt, DV_PITCH, 32 * kh + 16 + 4 * h, 32 * kh + 24 + 4 * h, 32 * dt, lane);
                    o[dt] = mfma32(p0, v0, o[dt]); o[dt] = mfma32(p1, v1, o[dt]); }
            }
        }
        vhave = need_any && tt > 0;
        __syncthreads();
    }
    { auto rr = __builtin_amdgcn_permlane32_swap(__float_as_uint(l), __float_as_uint(l), false, false); l = __uint_as_float(rr[0]) + __uint_as_float(rr[1]); }
    float* part = (float*)(ws + WS_DPART) + ((size_t)(b * KVH + kvh) * 16 + 2 * sp + kh) * DPART_STRIDE;
    if (h == 0) { part[r] = m; part[32 + r] = l; }
#pragma unroll
    for (int dt = 0; dt < 2; ++dt)
#pragma unroll
        for (int q = 0; q < 16; ++q) part[64 + crow(q, h) * 64 + 32 * dt + r] = o[dt][q];
}

__device__ __forceinline__ void dec_combine(unsigned char* ws, int unit, int tid) {
    asm volatile("" : "+v"(tid));
    const int b = unit >> 2, kvh = unit & 3, j = tid >> 4, dq = tid & 15, g = j >> 3, qi = j & 7, hq = 4 * kvh + g;
    const bf16* Qb = (const bf16*)(ws + WS_Q); const bf16* Kb = (const bf16*)(ws + WS_K); const bf16* Vb = (const bf16*)(ws + WS_V); bf16* YA = (bf16*)(ws + WS_YA);
    const float* LOGF = (const float*)(ws + WS_LOGF); const float* CPL = (const float*)(ws + WS_CPL);
    const float* part = (const float*)(ws + WS_DPART) + (size_t)(b * KVH + kvh) * 16 * DPART_STRIDE;
    const size_t rq = (size_t)MP + 8 * b + qi;
    const v2u qw = *(const GAS v2u*)(Qb + rq * 1024 + hq * 64 + 4 * dq); const float q0 = bflo(qw.x), q1 = bfhi(qw.x), q2 = bflo(qw.y), q3 = bfhi(qw.y);
    float sn[8]; float cum = CPL[((size_t)b * PAST + PAST - 1) * AH + hq];
#pragma unroll
    for (int jj = 0; jj < 8; ++jj) { const size_t rk = (size_t)MP + 8 * b + jj; cum += LOGF[rk * AH + hq] * 1.4426950408889634f;
        const v2u kw = *(const GAS v2u*)(Kb + rk * 256 + kvh * 64 + 4 * dq); float d = q0 * bflo(kw.x) + q1 * bfhi(kw.x) + q2 * bflo(kw.y) + q3 * bfhi(kw.y);
        d += __shfl_xor(d, 1); d += __shfl_xor(d, 2); d += __shfl_xor(d, 4); d += __shfl_xor(d, 8);
        sn[jj] = (jj <= qi) ? d - cum : -1e30f; }
    float mp[16], M = -1e30f;
#pragma unroll
    for (int n = 0; n < 16; ++n) { mp[n] = part[(size_t)n * DPART_STRIDE + j]; M = fmaxf(M, mp[n]); }
#pragma unroll
    for (int jj = 0; jj < 8; ++jj) M = fmaxf(M, sn[jj]);
    float L = 0.f; f32x4 O = (f32x4){0.f, 0.f, 0.f, 0.f};
#pragma unroll
    for (int n = 0; n < 16; ++n) { const float w = __builtin_amdgcn_exp2f(mp[n] - M); L += w * part[(size_t)n * DPART_STRIDE + 32 + j];
        O += *(const f32x4*)(part + (size_t)n * DPART_STRIDE + 64 + j * 64 + 4 * dq) * w; }
#pragma unroll
    for (int jj = 0; jj < 8; ++jj) { const float w = __builtin_amdgcn_exp2f(sn[jj] - M); L += w; const size_t rk = (size_t)MP + 8 * b + jj;
        const v2u vw = *(const GAS v2u*)(Vb + rk * 256 + kvh * 64 + 4 * dq); O += (f32x4){bflo(vw.x), bfhi(vw.x), bflo(vw.y), bfhi(vw.y)} * w; }
    const float il = 1.f / L;
    *(GAS v2u*)(YA + rq * 1024 + hq * 64 + 4 * dq) = (v2u){pk2(O[0] * il, O[1] * il), pk2(O[2] * il, O[3] * il)};
}
template <bool OUT8 = false> struct SResidT {
    const float* resF; const bf16* resB; float* outF; bf16* outB; pg8::ssq_t* ssq; float alpha;
    __device__ __forceinline__ void operator()(int row, int col, f32x4 v, int t) const {
        f32x4 rr; if (resF) rr = *(const f32x4*)(resF + (size_t)row * 1024 + col); else { const v2u w = *(const GAS v2u*)(resB + (size_t)row * 1024 + col); rr = (f32x4){bflo(w.x), bfhi(w.x), bflo(w.y), bfhi(w.y)}; }
        const f32x4 o = rr + v * alpha;
        if (outF) *(f32x4*)(outF + (size_t)row * 1024 + col) = o;
        if (outB) *(GAS v2u*)(outB + (size_t)row * 1024 + col) = (v2u){pk2(o[0], o[1]), pk2(o[2], o[3])};
        if constexpr (OUT8) { int w = 0; const f32x4 q = o * pg8::H2_F8_SCALE; w = __builtin_amdgcn_cvt_pk_fp8_f32(__builtin_amdgcn_fmed3f(q[0], -448.f, 448.f), __builtin_amdgcn_fmed3f(q[1], -448.f, 448.f), w, false);
            w = __builtin_amdgcn_cvt_pk_fp8_f32(__builtin_amdgcn_fmed3f(q[2], -448.f, 448.f), __builtin_amdgcn_fmed3f(q[3], -448.f, 448.f), w, true);
            *(GAS unsigned*)((unsigned char*)outB + ((WS_H2F8 + (size_t)MP * 1024) - (WS_XB + (size_t)MP * 2048)) + (size_t)row * 1024 + col) = (unsigned)w; }
        if (ssq) { float s = (o[0] * o[0] + o[1] * o[1]) + (o[2] * o[2] + o[3] * o[3]); s += __shfl_xor(s, 1); s += __shfl_xor(s, 2); s += __shfl_xor(s, 4);
            if ((t & 7) == 0) __hip_atomic_fetch_add(ssq + row, pg8::ssq_fx(s), __ATOMIC_RELAXED, __HIP_MEMORY_SCOPE_AGENT); } }
};
using SResid = SResidT<false>;
struct SGateMul { const bf16* G; bf16* MPo;
    __device__ __forceinline__ void operator()(int row, int col, f32x4 v, int) const { const v2u g = *(const GAS v2u*)(G + (size_t)row * 1024 + col);
        const f32x4 o = (f32x4){bflo(g.x), bfhi(g.x), bflo(g.y), bfhi(g.y)} * v; *(GAS v2u*)(MPo + (size_t)row * 1024 + col) = (v2u){pk2(o[0], o[1]), pk2(o[2], o[3])}; } };
struct SGateAdd { const bf16* G; const bf16* MPi; bf16* O;
    __device__ __forceinline__ void operator()(int row, int col, f32x4 v, int) const { const v2u g = *(const GAS v2u*)(G + (size_t)row * 1024 + col), m = *(const GAS v2u*)(MPi + (size_t)row * 1024 + col);
        const f32x4 o = (f32x4){bflo(m.x), bfhi(m.x), bflo(m.y), bfhi(m.y)} + (f32x4){bflo(g.x), bfhi(g.x), bflo(g.y), bfhi(g.y)} * v;
        *(GAS v2u*)(O + (size_t)row * 1024 + col) = (v2u){pk2(o[0], o[1]), pk2(o[2], o[3])}; } };
template <int K, class Epi> __device__ __forceinline__ void smallm_phase(const bf16* A, const bf16* Bt, LAS unsigned char* lds, const Epi& E, int G) {
    int tid = threadIdx.x; asm volatile("" : "+v"(tid));
    const int lane = tid & 63, wave = __builtin_amdgcn_readfirstlane(tid >> 6), r = lane & 31, h = lane >> 5;
    constexpr int KW = K / 8, NS = KW / 16;
    LAS float* red = (LAS float*)lds;
    for (int tile = (int)blockIdx.x; tile < 256; tile += G) {
        const int tm = tile >> 5, tn = tile & 31;
        const bf16* ap = A + (size_t)(32 * tm + r) * K + wave * KW + 8 * h; const bf16* bp = Bt + (size_t)(32 * tn + r) * K + wave * KW + 8 * h;
        f32x16 acc = (f32x16){};
        constexpr int UN = (NS % 11 == 0) ? 11 : 8;
#pragma unroll 1
        for (int k0 = 0; k0 < NS; k0 += UN) { bf16x8 a[UN], b[UN];
#pragma unroll
            for (int k = 0; k < UN; ++k) { a[k] = *(const bf16x8*)(ap + 16 * (k0 + k)); b[k] = *(const bf16x8*)(bp + 16 * (k0 + k)); }
#pragma unroll
            for (int k = 0; k < UN; ++k) acc = mfma32(a[k], b[k], acc); }
        __syncthreads();
#pragma unroll
        for (int q = 0; q < 16; ++q) red[(wave * 32 + crow(q, h)) * 33 + r] = acc[q];
        __syncthreads();
        if (tid < 256) { const int row = tid >> 3, c4 = (tid & 7) * 4; f32x4 v = (f32x4){0.f, 0.f, 0.f, 0.f};
#pragma unroll
            for (int w = 0; w < 8; ++w) { const LAS float* p = red + (w * 32 + row) * 33 + c4; v += (f32x4){p[0], p[1], p[2], p[3]}; }
            E(32 * tm + row, 32 * tn + c4, v, tid); }
    }
    __syncthreads();
}
constexpr int NPHASE = 11;
struct Args { const float* in[30]; const int* page_table; float* out; unsigned char* ws; int ph_lo, ph_hi; };
static_assert(sizeof(Args) == 30 * 8 + 8 + 8 + 8 + 8, "Args has no padding bytes");
enum { I_XP = 0, I_XS, I_CK, I_CV, I_CLF, I_SSM, I_SCONV, I_PT, I_F1N, I_F1G, I_F1U, I_F1D, I_MIXN, I_WIN, I_CONVW, I_CONVB, I_DTB, I_ALOG, I_DSKIP, I_SSDN, I_QN, I_KN, I_BF,
       I_WSP, I_WAP, I_WO, I_F2N, I_F2G, I_F2U, I_F2D };

__global__ void __launch_bounds__(NWAVES * 64, 2) mega_fwd(Args args) {
    extern __shared__ __attribute__((aligned(16))) unsigned char lds_raw[];
    LAS unsigned char* lds = (LAS unsigned char*)lds_raw;
    volatile LAS unsigned* MISC = (volatile LAS unsigned*)(lds + MISC_OFF);
    const int tid = threadIdx.x, lane = tid & 63, wave = __builtin_amdgcn_readfirstlane(tid >> 6);
    const int G = gridDim.x; const int vcu = (G % 8 == 0) ? ((int)blockIdx.x % 8) * (G / 8) + (int)blockIdx.x / 8 : (int)blockIdx.x;
    unsigned char* ws = args.ws; float* dout = args.out;
    gu32* ctl = (gu32*)(ws + WS_CTL);
    for (int u = tid; u < 64; u += NWAVES * 64) MISC[u] = 0u;
    __syncthreads();
    XcdBarrier bar = xcd_barrier_post((unsigned*)ctl + CW_BAR, MISC + 8);
    const int lo = args.ph_lo, hi = args.ph_hi;
#define IN(k) (lo <= (k) && (k) < hi)
#define SEAM(k) do { if (IN(k) && IN((k) + 1)) xcd_barrier(bar); } while (0)
    const int gw = vcu * NWAVES + wave, NGW = G * NWAVES;
    pg8::ssq_t* ssqX = (pg8::ssq_t*)(ws + WS_SSQX); pg8::ssq_t* ssqH = (pg8::ssq_t*)(ws + WS_CTL + CTL_SSQH); pg8::ssq_t* ssqH2 = (pg8::ssq_t*)(ws + WS_CTL + CTL_SSQH2);
    bf16 *Wgu1 = (bf16*)(ws + WS_WGU1), *Wd1 = (bf16*)(ws + WS_WD1), *Win = (bf16*)(ws + WS_WIN), *Wsp = (bf16*)(ws + WS_WSP), *Wap = (bf16*)(ws + WS_WAP), *Wo = (bf16*)(ws + WS_WO),
         *Wgu2 = (bf16*)(ws + WS_WGU2), *Wd2 = (bf16*)(ws + WS_WD2);
    bf16 *XB = (bf16*)(ws + WS_XB), *ACT = (bf16*)(ws + WS_ACT), *HB = (bf16*)(ws + WS_HB), *Zb = (bf16*)(ws + WS_Z), *XBC = (bf16*)(ws + WS_XBC), *Qb = (bf16*)(ws + WS_Q), *Kb = (bf16*)(ws + WS_K),
         *Vb = (bf16*)(ws + WS_V), *GSb = (bf16*)(ws + WS_GS), *GAb = (bf16*)(ws + WS_GA);
    float *DTf = (float*)(ws + WS_DT), *LOGFf = (float*)(ws + WS_LOGF);

    constexpr int I_GU = (5632 / 64) * (1024 / 64), I_D = (1024 / 64) * (2816 / 64), I_W = (NWIN / 64) * (1024 / 64), I_SP = (1024 / 64) * (2048 / 64), I_SQ = (1024 / 64) * (1024 / 64);
    constexpr int T_GU1 = I_GU, T_D1 = T_GU1 + I_D, T_WIN = T_D1 + I_W, T_SP = T_WIN + I_SP, T_AP = T_SP + I_SQ, T_WO = T_AP + I_SQ, T_GU2 = T_WO + I_GU, T_END = T_GU2 + I_D;
#define TRANSPOSE_RANGE(LO, HI, IDX, NIDX) do { LAS float* scr = (LAS float*)(lds + RING_OFF + wave * 16640);     \
        for (int it = (LO) + (IDX); it < (HI); it += (NIDX)) { int r = it; \
            if (r < T_GU1) { if ((r % 88) & 2) p0_transpose_item(MapGU{args.in[I_F1U]}, args.in[I_F1N], 1024, Wgu1, scr, r / 88, r % 88, lane); else p0_transpose_item(MapGU{args.in[I_F1G]}, args.in[I_F1N], 1024, Wgu1, scr, r / 88, r % 88, lane); continue; } r -= T_GU1; \
            if (r < I_D) { p0_transpose_item(MapPlain{args.in[I_F1D], 1024}, nullptr, 2816, Wd1, scr, r / 16, r % 16, lane); continue; } r -= I_D; \
            if (r < I_W) { p0_transpose_item(MapWin{args.in[I_WIN]}, args.in[I_MIXN], 1024, Win, scr, r / 140, r % 140, lane); continue; } r -= I_W; \
            if (r < I_SP) { p0_transpose_item(MapPlain{args.in[I_WSP], 1024}, nullptr, 2048, Wsp, scr, r / 16, r % 16, lane); continue; } r -= I_SP; \
            if (r < I_SQ) { p0_transpose_item(MapPlain{args.in[I_WAP], 1024}, nullptr, 1024, Wap, scr, r / 16, r % 16, lane); continue; } r -= I_SQ; \
            if (r < I_SQ) { p0_transpose_item(MapPlain{args.in[I_WO], 1024}, nullptr, 1024, Wo, scr, r / 16, r % 16, lane); continue; } r -= I_SQ; \
            if (r < I_GU) { if ((r % 88) & 2) p0_transpose_item(MapGU{args.in[I_F2U]}, args.in[I_F2N], 1024, (bf16*)nullptr, scr, r / 88, r % 88, lane, ws + WS_WGU2F8, pg8::WGU_F8_SCALE); else p0_transpose_item(MapGU{args.in[I_F2G]}, args.in[I_F2N], 1024, (bf16*)nullptr, scr, r / 88, r % 88, lane, ws + WS_WGU2F8, pg8::WGU_F8_SCALE); continue; } r -= I_GU; \
            p0_transpose_item(MapPlain{args.in[I_F2D], 1024}, nullptr, 2816, Wd2, scr, r / 16, r % 16, lane, ws + WS_WD2F8, pg8::WD_F8_SCALE); } } while (0)
    if (IN(0)) {
        if (G == 256) { TRANSPOSE_RANGE(0, T_GU1, gw, NGW); } else { TRANSPOSE_RANGE(0, T_END, gw, NGW); }
        for (int m = 2 * gw; m < MT; m += 2 * NGW) { const float* xr = (m < MP) ? args.in[I_XP] + (size_t)m * 1024 : args.in[I_XS] + (size_t)(m - MP) * 1024; p0_rows_to_bf16(xr, XB + (size_t)m * 1024, ssqX + m, lane); }
        if (blockIdx.x == 0 && tid < 256) { float* par = (float*)(ws + WS_PAR); float v;
            if (tid < 64) v = args.in[I_QN][tid]; else if (tid < 128) v = args.in[I_KN][tid - 64]; else if (tid < 160) v = args.in[I_DTB][tid - 128]; else if (tid < 176) v = args.in[I_BF][tid - 160];
            else if (tid < 192) v = 0.f; else if (tid < 224) v = args.in[I_ALOG][tid - 192]; else v = args.in[I_DSKIP][tid - 224];
            par[tid] = v; }
        for (int it = gw; it < DECB * NPAGES; it += NGW) ptot_item(ws, args.in[I_CLF], args.page_table, it, lane);
    }
    SEAM(0);
    if (IN(1)) {
        if (G == 256 && blockIdx.x >= 150) { TRANSPOSE_RANGE(T_GU1, T_WIN, ((int)blockIdx.x - 150) * NWAVES + wave, 106 * NWAVES); __syncthreads(); }
        pg8::Gemm g{XB, Wgu1, MT, 5632, 1024}; pg8::StaticOrder S; S.init(MT, 5632, G, (int)blockIdx.x);
        pg8::EpiSwiglu E{ACT, ssqX, 1.f};
        pg8::gemm_phase<pg8::EpiSwiglu, pg8::StaticOrder, true, true>(lds + RING_OFF, g, S, E);
    }
    SEAM(1);
    if (IN(2)) {
        pg8::Gemm g{ACT, Wd1, MP, 1024, DFF}; pg8::StaticOrder S; S.init(MP, 1024, G, (int)blockIdx.x);
        pg8::EpiResid E{args.in[I_XP], nullptr, nullptr, HB, ssqH, 0.5f};
        pg8::gemm_phase<pg8::EpiResid, pg8::StaticOrder, true, true>(lds + RING_OFF, g, S, E);
        smallm_phase<DFF>(ACT + (size_t)MP * DFF, Wd1, lds, SResid{args.in[I_XS], nullptr, nullptr, HB + (size_t)MP * 1024, ssqH + MP, 0.5f}, G);
    }
    SEAM(2);
    if (IN(3)) {
        if (G == 256 && ((blockIdx.x >> 3) & 1)) { TRANSPOSE_RANGE(T_WIN, T_END, ((int)blockIdx.x >> 4) * 8 * NWAVES + ((int)blockIdx.x & 7) * NWAVES + wave, 128 * NWAVES); __syncthreads(); }
        pg8::Gemm g{HB, Win, MT, NWIN, 1024}; pg8::StaticOrder S; S.init(MT, NWIN, G, (int)blockIdx.x);
        pg8::EpiWin E{ws, dout};
        pg8::gemm_phase<pg8::EpiWin, pg8::StaticOrder, true, true>(lds + RING_OFF, g, S, E);
    }
    SEAM(3);
    if (IN(4)) {
        { LAS unsigned char* wl = lds + wave * P4S_WAVE;
          if (NGW == 2048) { const int half = vcu * 4 + (wave >> 1);
              if ((wave & 1) == 0) p4s_item(ws, dout, args.in[I_CONVW], args.in[I_CONVB], args.in[I_SCONV], args.in[I_SSM], wl, half, lane);
              else if (half < NBATCH * AH) ck_item(ws, half, lane);
          } else {
              for (int it = gw; it < NBATCH * AH; it += NGW) ck_item(ws, it, lane);
              for (int it = gw; it < DECB * SH; it += NGW) p4s_item(ws, dout, args.in[I_CONVW], args.in[I_CONVB], args.in[I_SCONV], args.in[I_SSM], wl, it, lane);
          }
          for (int it = gw; it < DECB * NPAGES; it += NGW) cpl_item(ws, args.in[I_CLF], args.page_table, it, lane); }
        for (int i = (int)blockIdx.x * 512 + tid; i < NBATCH * 3 * CONVD; i += G * 512) { const int bb = i / (3 * CONVD), rem = i % (3 * CONVD), j = rem / CONVD, col = rem % CONVD;
            dout[O_CONVP + i] = __uint_as_float((unsigned)XBC[((size_t)bb * SEQ + SEQ - 3 + j) * CONVD + col] << 16); }
        for (int u = (int)blockIdx.x; u < 512; u += G) p4_unit(ws, args.in[I_CONVW], args.in[I_CONVB], lds, u, tid, lane, wave);
        __syncthreads();
    }
    SEAM(4);
    if (IN(5)) {
        for (int it = gw; it < MS * SG; it += NGW) p4s_norm_item(ws, args.in[I_SSDN], it, lane);
        p5_scan(ws, dout, (int)blockIdx.x * 512 + tid, G * 512);
        const attn_body::AttnTensors AT{(const attn_body::bf16*)Qb, (const attn_body::bf16*)Kb, (const attn_body::bf16*)Vb, (attn_body::bf16*)(ws + WS_YA), (const float*)(ws + WS_CK)};
        const float skip_thr = 153.f + 2.f * sqrtf(__uint_as_float(__hip_atomic_load((unsigned*)ctl + CW_QMAX2, RLX_AGENT)) * __uint_as_float(__hip_atomic_load((unsigned*)ctl + CW_KMAX2, RLX_AGENT))) * 1.0001f;
        if (G == 256) {
            const bool decfirst = ((blockIdx.x >> 3) & 1) != 0;
            if (!decfirst) attn_body::attn_segs<8>((char*)lds_raw, AT, skip_thr, 2, vcu, 0, 4, vcu + 1, 0, 1);
            __syncthreads();
            for (int u = (int)blockIdx.x; u < DECB * 8; u += G) dec_unit(ws, args.in[I_CK], args.in[I_CV], args.page_table, lds, u, tid, lane, wave);
            __syncthreads();
            if (decfirst) attn_body::attn_segs<8>((char*)lds_raw, AT, skip_thr, 1, vcu, 1, 4, 0, 0, 0);
        } else {
            attn_body::attn_phase<8>((char*)lds_raw, AT, skip_thr, vcu, G, 0, 4);
            __syncthreads();
            for (int u = (int)blockIdx.x; u < DECB * 8; u += G) dec_unit(ws, args.in[I_CK], args.in[I_CV], args.page_table, lds, u, tid, lane, wave);
        }
    }
    SEAM(5);
    if (IN(6)) { for (int u = (int)blockIdx.x; u < DECB * KVH; u += G) dec_combine(ws, u, tid);
        for (int u = (int)blockIdx.x; u < 512; u += G) p6_unit(ws, args.in[I_SSDN], lds, u, tid, lane, wave); __syncthreads(); }
    SEAM(6);
    if (IN(7)) {
        { pg8::Gemm g{(const bf16*)(ws + WS_YS), Wsp, MP, 1024, DSSM}; pg8::StaticOrder S; S.init(MP, 1024, G, (int)blockIdx.x);
          pg8::EpiGateMul E{GSb, (bf16*)(ws + WS_MP)};
          pg8::gemm_phase<pg8::EpiGateMul, pg8::StaticOrder, true, true>(lds + RING_OFF, g, S, E); }
        { pg8::Gemm g{(const bf16*)(ws + WS_YA), Wap, MP, 1024, 1024}; pg8::StaticOrder S; S.init(MP, 1024, G, (int)blockIdx.x);
          pg8::EpiGateAdd E{GAb, (const bf16*)(ws + WS_MP), (bf16*)(ws + WS_MG)};
          pg8::gemm_phase<pg8::EpiGateAdd, pg8::StaticOrder, true, true>(lds + RING_OFF, g, S, E); }
        smallm_phase<DSSM>((const bf16*)(ws + WS_YS) + (size_t)MP * DSSM, Wsp, lds, SGateMul{GSb + (size_t)MP * 1024, (bf16*)(ws + WS_MP) + (size_t)MP * 1024}, G);
        smallm_phase<1024>((const bf16*)(ws + WS_YA) + (size_t)MP * 1024, Wap, lds, SGateAdd{GAb + (size_t)MP * 1024, (const bf16*)(ws + WS_MP) + (size_t)MP * 1024, (bf16*)(ws + WS_MG) + (size_t)MP * 1024}, G);
    }
    SEAM(7);
    if (IN(8)) {
        pg8::Gemm g{(const bf16*)(ws + WS_MG), Wo, MP, 1024, 1024}; pg8::StaticOrder S; S.init(MP, 1024, G, (int)blockIdx.x);
        pg8::EpiResidT<false, true> E{nullptr, HB, nullptr, XB, ssqH2, 1.0f};
        pg8::gemm_phase<pg8::EpiResidT<false, true>, pg8::StaticOrder, true, true>(lds + RING_OFF, g, S, E);
        smallm_phase<1024>((const bf16*)(ws + WS_MG) + (size_t)MP * 1024, Wo, lds, SResidT<true>{nullptr, HB + (size_t)MP * 1024, nullptr, XB + (size_t)MP * 1024, ssqH2 + MP, 1.0f}, G);
    }
    SEAM(8);
    if (IN(9)) {
        pg8::Gemm g{(const bf16*)(ws + WS_H2F8), (const bf16*)(ws + WS_WGU2F8), MT, 5632, 512}; pg8::StaticOrder S; S.init(MT, 5632, G, (int)blockIdx.x);
        pg8::EpiSwigluT<true, true> E{ACT, ssqH2, 1.f / (pg8::H2_F8_SCALE * pg8::WGU_F8_SCALE)};
        pg8::gemm_phase<pg8::EpiSwigluT<true, true>, pg8::StaticOrder, true, true>(lds + RING_OFF, g, S, E);
    }
    SEAM(9);
    if (IN(10)) {
        pg8::Gemm g{ACT, (const bf16*)(ws + WS_WD2F8), MP, 1024, DFF / 2}; pg8::StaticOrder S; S.init(MP, 1024, G, (int)blockIdx.x);
        pg8::EpiResidT<true> E{nullptr, XB, dout, nullptr, nullptr, 0.5f / (pg8::ACT_F8_SCALE * pg8::WD_F8_SCALE)};
        pg8::gemm_phase<pg8::EpiResidT<true>, pg8::StaticOrder, true, true>(lds + RING_OFF, g, S, E);
        smallm_phase<DFF>(ACT + (size_t)MP * DFF, Wd2, lds, SResid{nullptr, XB + (size_t)MP * 1024, dout + (size_t)MP * 1024, nullptr, nullptr, 0.5f}, G);
    }
#undef IN
#undef SEAM
}

extern "C" void kernel_launch(void* const* d_in, const int* in_sizes, int n_in, void* d_out, int out_size, void* d_ws, size_t ws_size, hipStream_t stream) {
    static int grid = 0;
    if (grid == 0) {
        if (n_in != 30 || (size_t)out_size != O_END || ws_size < WS_END) { fprintf(stderr, "kernel_launch: unexpected problem (n_in %d, out %d, ws %zu)\n", n_in, out_size, ws_size); grid = -1; return; }
        int dev = 0, cus = 0, per_cu = 0;
        if (hipGetDevice(&dev) != hipSuccess || hipDeviceGetAttribute(&cus, hipDeviceAttributeMultiprocessorCount, dev) != hipSuccess) { grid = -1; return; }
        if (hipFuncSetAttribute((const void*)mega_fwd, hipFuncAttributeMaxDynamicSharedMemorySize, LDS_BYTES) != hipSuccess) { fprintf(stderr, "kernel_launch: hipFuncSetAttribute failed\n"); grid = -1; return; }
        if (hipOccupancyMaxActiveBlocksPerMultiprocessor(&per_cu, (const void*)mega_fwd, NWAVES * 64, LDS_BYTES) != hipSuccess || per_cu < 1) { fprintf(stderr, "kernel_launch: occupancy query reports %d\n", per_cu); }
        (void)hipGetLastError();
        grid = cus;
    }
    if (grid < 0) return;
    if (hipMemsetAsync((char*)d_ws + WS_CTL, 0, CTL_ZERO_BYTES, stream) != hipSuccess) return;
    Args a{};
    for (int i = 0; i < 30; ++i) a.in[i] = (const float*)d_in[i];
    a.page_table = (const int*)d_in[I_PT]; a.out = (float*)d_out; a.ws = (unsigned char*)d_ws; a.ph_lo = 0; a.ph_hi = NPHASE;
    hipLaunchKernelGGL(mega_fwd, dim3(grid), dim3(NWAVES * 64), LDS_BYTES, stream, a);
}
```

```cpp
#include <hip/hip_runtime.h>
#include <cstdio>
#include <cstdint>
constexpr int NWAVES = 8;
constexpr int DMODEL = 1024, NBATCH = 4, SEQ = 4096, MP = NBATCH * SEQ, DECB = 32, DECS = 8, MS = DECB * DECS, MT = MP + MS;
constexpr int DFF = 2816, DSSM = 2048, SH = 32, SP = 64, SG = 4, SN = 128, CONVD = 3072, CHUNK = 128, NCHUNK = SEQ / CHUNK;
constexpr int AH = 16, KVH = 4, HD = 64, KVD = 256, INDIM = 8752, NWIN = 35 * 256;
constexpr int PAST = 16384, PAGE = 128, NPAGES = 128;
constexpr size_t O_YP = 0, O_YS = O_YP + (size_t)MP * 1024, O_KP = O_YS + (size_t)MS * 1024, O_VP = O_KP + (size_t)MP * 256, O_LFP = O_VP + (size_t)MP * 256,
    O_SSMP = O_LFP + (size_t)MP * 16, O_CONVP = O_SSMP + (size_t)NBATCH * SH * SP * SN, O_KS = O_CONVP + (size_t)NBATCH * 3 * CONVD, O_VS = O_KS + (size_t)MS * 256,
    O_LFS = O_VS + (size_t)MS * 256, O_SSMS = O_LFS + (size_t)MS * 16, O_CONVS = O_SSMS + (size_t)DECB * SH * SP * SN, O_END = O_CONVS + (size_t)DECB * 3 * CONVD;
static_assert(O_END == 35594240, "d_out map");
constexpr size_t al256(size_t x) { return (x + 255) & ~(size_t)255; }
constexpr size_t WS_CTL = 0, CTL_ZERO_BYTES = 1u << 20;
constexpr int CW_BAR = 4096, CW_Q4 = 8192, CW_QMAX2 = 8256, CW_KMAX2 = 8320;
constexpr size_t CTL_SSQH = 256 * 1024, CTL_SSQH2 = 512 * 1024;
constexpr size_t WS_PAR = al256(WS_CTL + CTL_ZERO_BYTES);
constexpr int PAR_QN = 0, PAR_KN = 64, PAR_DTB = 128, PAR_BF = 160, PAR_ALOG = 192, PAR_DSKIP = 224, PAR_END = 256;
constexpr size_t WS_SSQX = al256(WS_PAR + 4096);
constexpr size_t WS_WGU1 = al256(WS_SSQX + (size_t)MT * 8);
constexpr size_t WS_WD1 = al256(WS_WGU1 + (size_t)5632 * 1024 * 2);
constexpr size_t WS_WIN = al256(WS_WD1 + (size_t)1024 * 2816 * 2);
constexpr size_t WS_WSP = al256(WS_WIN + (size_t)NWIN * 1024 * 2);
constexpr size_t WS_WAP = al256(WS_WSP + (size_t)1024 * 2048 * 2);
constexpr size_t WS_WO = al256(WS_WAP + (size_t)1024 * 1024 * 2);
constexpr size_t WS_WGU2 = al256(WS_WO + (size_t)1024 * 1024 * 2);
constexpr size_t WS_WD2 = al256(WS_WGU2 + (size_t)5632 * 1024 * 2);
constexpr size_t WS_XB = al256(WS_WD2 + (size_t)1024 * 2816 * 2);
constexpr size_t WS_ACT = al256(WS_XB + (size_t)MT * 1024 * 2);
constexpr size_t WS_HB = al256(WS_ACT + (size_t)MT * 2816 * 2);
constexpr size_t WS_Z = al256(WS_HB + (size_t)MT * 1024 * 2);
constexpr size_t WS_XBC = al256(WS_Z + (size_t)MT * 2048 * 2);
constexpr size_t WS_Q = al256(WS_XBC + (size_t)MT * 3072 * 2);
constexpr size_t WS_K = al256(WS_Q + (size_t)MT * 1024 * 2);
constexpr size_t WS_V = al256(WS_K + (size_t)MT * 256 * 2);
constexpr size_t WS_GS = al256(WS_V + (size_t)MT * 256 * 2);
constexpr size_t WS_GA = al256(WS_GS + (size_t)MT * 1024 * 2);
constexpr size_t WS_DT = al256(WS_GA + (size_t)MT * 1024 * 2);
constexpr size_t WS_LOGF = al256(WS_DT + (size_t)MT * 32 * 4);
constexpr size_t WS_XC = al256(WS_LOGF + (size_t)MT * 16 * 4);
constexpr size_t WS_YS = al256(WS_XC + (size_t)MT * 3072 * 2);
constexpr size_t WS_YA = al256(WS_YS + (size_t)MT * 2048 * 2);
constexpr size_t WS_MP = al256(WS_YA + (size_t)MT * 1024 * 2);
constexpr size_t WS_ST = al256(WS_MP + (size_t)MT * 1024 * 4);
constexpr size_t WS_ACS = al256(WS_ST + (size_t)NBATCH * NCHUNK * SH * SP * SN * 2);
constexpr size_t WS_CK = al256(WS_ACS + (size_t)MP * 32 * 4);
constexpr size_t WS_PTOT = al256(WS_CK + (size_t)MP * 16 * 4);
constexpr size_t WS_CPL = al256(WS_PTOT + (size_t)DECB * NPAGES * 16 * 4);
constexpr size_t WS_DPART = al256(WS_CPL + (size_t)DECB * PAST * 16 * 4);
constexpr size_t WS_YRAW = al256(WS_DPART + (size_t)64 * 1024 * 1024);
constexpr size_t WS_MG = al256(WS_YRAW + (size_t)MS * DSSM * 4);
constexpr size_t WS_HS = al256(WS_MG + (size_t)MT * 1024 * 2);
constexpr size_t WS_WD1F8 = al256(WS_HS + (size_t)NBATCH * NCHUNK * SH * SP * SN * 2);
constexpr size_t WS_WD2F8 = al256(WS_WD1F8 + (size_t)1024 * 2816);
constexpr size_t WS_WGU2F8 = al256(WS_WD2F8 + (size_t)1024 * 2816);
constexpr size_t WS_H2F8 = al256(WS_WGU2F8 + (size_t)5632 * 1024);
constexpr size_t WS_END = al256(WS_H2F8 + (size_t)MT * 1024);
constexpr int RING_OFF = 0, RING_BYTES = 131072;
constexpr int LDS_BYTES = 160 * 1024;
constexpr int MISC_OFF = LDS_BYTES - 256;
namespace pg8 {
#define PG8_LAS __attribute__((address_space(3)))
typedef unsigned short bf16_t;
typedef short bf16x8 __attribute__((ext_vector_type(8)));
typedef float f32x4 __attribute__((ext_vector_type(4)));
typedef unsigned u32x4 __attribute__((ext_vector_type(4)));
typedef int v4i __attribute__((ext_vector_type(4)));
typedef unsigned u32x2 __attribute__((ext_vector_type(2)));
typedef int v8i __attribute__((ext_vector_type(8)));
typedef unsigned long long ssq_t;
constexpr float SSQ_ONE = 1048576.f;
__device__ __forceinline__ float ssq_ld(const ssq_t* p, size_t row) { return (float)p[row] * (1.f / SSQ_ONE); }
__device__ __forceinline__ ssq_t ssq_fx(float s) { return (ssq_t)(s * SSQ_ONE + 0.5f); }
template <bool F8> struct FragSel { typedef bf16x8 type; };
template <> struct FragSel<true> { typedef v8i type; };
constexpr int BM = 256, BK = 64, HALF = 128, HTB = HALF * BK * 2  , STAGE_BYTES = 8 * HTB, NXCD = 8, WGM = 8;

__host__ __device__ __forceinline__ int lds_byte(int r, int c) { const int st = (r >> 4) * 2 + (c >> 5), rr = r & 15, cc = c & 31, ob = rr * 64 + cc * 2; return st * 1024 + (ob ^ (((ob >> 9) & 1) << 5)); }
__host__ __device__ __forceinline__ void stage_rc(int b, int& R, int& C) { const int st = b / 1024, sb = b % 1024, swz = sb ^ (((sb >> 9) & 1) << 5); R = (st >> 1) * 16 + swz / 64; C = (st & 1) * 32 + (swz % 64) / 2; }
__host__ __device__ __forceinline__ int perm32(int rho) { const int n = rho >> 4, i = rho & 15; return 8 * (i >> 2) + 4 * n + (i & 3); }

struct Unit { int pm, pn; };
struct Gemm { const bf16_t* A; const bf16_t* Bt; int M, N, K; };

struct StaticOrder {
    int nM, nN, nwg, G, c;
    __host__ __device__ void init(int M, int N, int G_, int c_) { nM = M / BM; nN = N / BM; nwg = nM * nN; G = G_; c = c_; }
    __host__ __device__ bool next(int i, Unit& u) const {
        const long L = (long)i * G + c; if (L >= nwg) return false;
        int wgid = (int)L; { const int q = nwg / NXCD, r = nwg % NXCD, xcd = wgid % NXCD, off = wgid / NXCD; wgid = (xcd < r ? xcd * (q + 1) : r * (q + 1) + (xcd - r) * q) + off; }
        const int nig = WGM * nN, gid = wgid / nig, fm = gid * WGM, gsz = (nM - fm) < WGM ? (nM - fm) : WGM;
        u.pm = fm + ((wgid % nig) % gsz); u.pn = (wgid % nig) / gsz; return true;
    }
    __device__ __forceinline__ void a_ready(const Unit&) const {}
    __device__ __forceinline__ void done(const Unit&) const {}
};

__device__ __forceinline__ unsigned cvt_pk_bf16(float lo, float hi) { unsigned r; asm volatile("v_cvt_pk_bf16_f32 %0, %1, %2" : "=v"(r) : "v"(lo), "v"(hi)); return r; }
typedef float f32x2 __attribute__((ext_vector_type(2)));
constexpr float RMS_EPS_F = 1e-6f;
constexpr float LOG2E_F = 1.4426950408889634f;
constexpr float ATT_C2 = 0.125f * 1.4426950408889634f;
constexpr int MPROMPT = 16384;
__device__ __forceinline__ float sigmoid_f(float x) { return __builtin_amdgcn_rcpf(1.f + __builtin_amdgcn_exp2f(-LOG2E_F * x)); }
__device__ __forceinline__ float silu_f(float x) { return x * sigmoid_f(x); }
__device__ __forceinline__ float softplus_f(float x) { return fmaxf(x, 0.f) + log1pf(expf(-fabsf(x))); }
__device__ __forceinline__ float logsigmoid_f(float x) { return fminf(x, 0.f) - log1pf(expf(-fabsf(x))); }
__device__ __forceinline__ float bf2f(unsigned short b) { return __uint_as_float((unsigned)b << 16); }
__device__ __forceinline__ u32x4 pack8(const f32x4 a, const f32x4 b) { u32x4 w; w.x = cvt_pk_bf16(a[0], a[1]); w.y = cvt_pk_bf16(a[2], a[3]); w.z = cvt_pk_bf16(b[0], b[1]); w.w = cvt_pk_bf16(b[2], b[3]); return w; }
__device__ __forceinline__ void unpack8(const u32x4 w, f32x4& a, f32x4& b) {
    a[0] = __uint_as_float(w.x << 16); a[1] = __uint_as_float(w.x & 0xffff0000u); a[2] = __uint_as_float(w.y << 16); a[3] = __uint_as_float(w.y & 0xffff0000u);
    b[0] = __uint_as_float(w.z << 16); b[1] = __uint_as_float(w.z & 0xffff0000u); b[2] = __uint_as_float(w.w << 16); b[3] = __uint_as_float(w.w & 0xffff0000u); }

constexpr float ACT_F8_SCALE = 4.f, WD_F8_SCALE = 64.f, H2_F8_SCALE = 16.f, WGU_F8_SCALE = 32.f;
__device__ __forceinline__ u32x2 pack8_f8(f32x4 a, f32x4 b, float sc) { int w0 = 0, w1 = 0;
    a = a * sc; b = b * sc;
#pragma unroll
    for (int e = 0; e < 4; ++e) { a[e] = __builtin_amdgcn_fmed3f(a[e], -448.f, 448.f); b[e] = __builtin_amdgcn_fmed3f(b[e], -448.f, 448.f); }
    w0 = __builtin_amdgcn_cvt_pk_fp8_f32(a[0], a[1], w0, false); w0 = __builtin_amdgcn_cvt_pk_fp8_f32(a[2], a[3], w0, true);
    w1 = __builtin_amdgcn_cvt_pk_fp8_f32(b[0], b[1], w1, false); w1 = __builtin_amdgcn_cvt_pk_fp8_f32(b[2], b[3], w1, true);
    u32x2 w; w.x = (unsigned)w0; w.y = (unsigned)w1; return w; }
template <bool F8, bool F8IN = false> struct EpiSwigluT {
    static constexpr bool PERM = true, AFTER_DRAIN = false, FP8 = F8IN;
    bf16_t* O; const ssq_t* ssq; float inv;
    __device__ __forceinline__ void operator()(const f32x4 (&acc)[2][2][4][2], const Unit& u, int wr, int wc, int fr, int fq) const {
        constexpr int ldc = 2816;
        const int row0 = u.pm * BM + wr * 64 + fr, col0 = u.pn * HALF + wc * 32 + 8 * fq;
        const bool f8 = F8 && (u.pm < MPROMPT / BM);
#pragma unroll
        for (int ai = 0; ai < 2; ++ai)
#pragma unroll
            for (int m = 0; m < 4; ++m) { const int row = row0 + ai * HALF + m * 16; const float rs = rsqrtf(ssq_ld(ssq, row) * (1.f / 1024.f) + RMS_EPS_F) * inv;
                f32x4 o[2];
#pragma unroll
                for (int n = 0; n < 2; ++n)
#pragma unroll
                    for (int e = 0; e < 4; ++e) o[n][e] = silu_f(acc[ai][0][m][n][e] * rs) * (acc[ai][1][m][n][e] * rs);
                if (f8) *(u32x2*)((unsigned char*)O + (size_t)row * ldc + col0) = pack8_f8(o[0], o[1], ACT_F8_SCALE);
                else *(u32x4*)(O + (size_t)row * ldc + col0) = pack8(o[0], o[1]); }
    }
};
using EpiSwiglu = EpiSwigluT<false>;
template <bool F8IN, bool OUT8 = false> struct EpiResidT {
    static constexpr bool PERM = true, AFTER_DRAIN = false, FP8 = F8IN;
    const float* resF; const bf16_t* resB; float* outF; bf16_t* outB; ssq_t* ssq; float alpha;
    __device__ __forceinline__ void operator()(const f32x4 (&acc)[2][2][4][2], const Unit& u, int wr, int wc, int fr, int fq) const {
        const int row0 = u.pm * BM + wr * 64 + fr, col0 = u.pn * BM + wc * 32 + 8 * fq;
#pragma unroll
        for (int ai = 0; ai < 2; ++ai)
#pragma unroll
            for (int m = 0; m < 4; ++m) { const size_t row = (size_t)(row0 + ai * HALF + m * 16); float s = 0.f;
#pragma unroll
                for (int bj = 0; bj < 2; ++bj) { const int col = col0 + bj * HALF; f32x4 r0, r1;
                    if (resF) { r0 = *(const f32x4*)(resF + row * 1024 + col); r1 = *(const f32x4*)(resF + row * 1024 + col + 4); } else unpack8(*(const u32x4*)(resB + row * 1024 + col), r0, r1);
                    const f32x4 o0 = r0 + acc[ai][bj][m][0] * alpha, o1 = r1 + acc[ai][bj][m][1] * alpha;
                    if (outF) { *(f32x4*)(outF + row * 1024 + col) = o0; *(f32x4*)(outF + row * 1024 + col + 4) = o1; }
                    if (outB) *(u32x4*)(outB + row * 1024 + col) = pack8(o0, o1);
                    if constexpr (OUT8) *(u32x2*)((unsigned char*)outB + (WS_H2F8 - WS_XB) + row * 1024 + col) = pack8_f8(o0, o1, H2_F8_SCALE);
                    s += (o0[0] * o0[0] + o0[1] * o0[1]) + (o0[2] * o0[2] + o0[3] * o0[3]) + (o1[0] * o1[0] + o1[1] * o1[1]) + (o1[2] * o1[2] + o1[3] * o1[3]); }
                if (ssq) { s += __shfl_xor(s, 16); s += __shfl_xor(s, 32); if (fq == 0) __hip_atomic_fetch_add(ssq + row, ssq_fx(s), __ATOMIC_RELAXED, __HIP_MEMORY_SCOPE_AGENT); } }
    }
};
using EpiResid = EpiResidT<false>;
struct EpiGateMul {
    static constexpr bool PERM = true, AFTER_DRAIN = false, FP8 = false;
    const bf16_t* G; bf16_t* MPb;
    __device__ __forceinline__ void operator()(const f32x4 (&acc)[2][2][4][2], const Unit& u, int wr, int wc, int fr, int fq) const {
        const int row0 = u.pm * BM + wr * 64 + fr, col0 = u.pn * BM + wc * 32 + 8 * fq;
#pragma unroll
        for (int ai = 0; ai < 2; ++ai)
#pragma unroll
            for (int m = 0; m < 4; ++m) { const size_t row = (size_t)(row0 + ai * HALF + m * 16);
#pragma unroll
                for (int bj = 0; bj < 2; ++bj) { const int col = col0 + bj * HALF; f32x4 g0, g1; unpack8(*(const u32x4*)(G + row * 1024 + col), g0, g1);
                    *(u32x4*)(MPb + row * 1024 + col) = pack8(g0 * acc[ai][bj][m][0], g1 * acc[ai][bj][m][1]); } }
    }
};
struct EpiGateAdd {
    static constexpr bool PERM = true, AFTER_DRAIN = false, FP8 = false;
    const bf16_t* G; const bf16_t* MPb; bf16_t* O;
    __device__ __forceinline__ void operator()(const f32x4 (&acc)[2][2][4][2], const Unit& u, int wr, int wc, int fr, int fq) const {
        const int row0 = u.pm * BM + wr * 64 + fr, col0 = u.pn * BM + wc * 32 + 8 * fq;
#pragma unroll
        for (int ai = 0; ai < 2; ++ai)
#pragma unroll
            for (int m = 0; m < 4; ++m) { const size_t row = (size_t)(row0 + ai * HALF + m * 16);
#pragma unroll
                for (int bj = 0; bj < 2; ++bj) { const int col = col0 + bj * HALF; f32x4 g0, g1, p0, p1; unpack8(*(const u32x4*)(G + row * 1024 + col), g0, g1); unpack8(*(const u32x4*)(MPb + row * 1024 + col), p0, p1);
                    *(u32x4*)(O + row * 1024 + col) = pack8(p0 + g0 * acc[ai][bj][m][0], p1 + g1 * acc[ai][bj][m][1]); } }
    }
};
struct EpiWin {
    static constexpr bool PERM = true, AFTER_DRAIN = false, FP8 = false;
    unsigned char* ws; float* dout;
    __device__ __forceinline__ void operator()(const f32x4 (&acc)[2][2][4][2], const Unit& u, int wr, int wc, int fr, int fq) const {
        const ssq_t* ssq = (const ssq_t*)(ws + WS_CTL + CTL_SSQH);
        bf16_t *Z = (bf16_t*)(ws + WS_Z), *XBC = (bf16_t*)(ws + WS_XBC), *Q = (bf16_t*)(ws + WS_Q), *K = (bf16_t*)(ws + WS_K), *V = (bf16_t*)(ws + WS_V), *GS = (bf16_t*)(ws + WS_GS), *GA = (bf16_t*)(ws + WS_GA);
        float *DT = (float*)(ws + WS_DT), *LOGF = (float*)(ws + WS_LOGF);
        float *koP = dout + O_KP, *koS = dout + O_KS, *voP = dout + O_VP, *voS = dout + O_VS, *lfP = dout + O_LFP, *lfS = dout + O_LFS;
        const float *qn = (const float*)(ws + WS_PAR) + PAR_QN, *kn = (const float*)(ws + WS_PAR) + PAR_KN, *dtb = (const float*)(ws + WS_PAR) + PAR_DTB, *bf = (const float*)(ws + WS_PAR) + PAR_BF;
        const int row0 = u.pm * BM + wr * 64 + fr, pn = u.pn;
        if (pn < 20 || (pn >= 25 && pn < 34)) {
            bf16_t* O; int ldc, cb; int mode = 0;
            if (pn < 8) { O = Z; ldc = 2048; cb = pn * BM; } else if (pn < 20) { O = XBC; ldc = 3072; cb = (pn - 8) * BM; }
            else if (pn == 25) { O = V; ldc = 256; cb = 0; mode = 2; } else if (pn < 30) { O = GS; ldc = 1024; cb = (pn - 26) * BM; mode = 1; } else { O = GA; ldc = 1024; cb = (pn - 30) * BM; mode = 1; }
            const int col0 = cb + wc * 32 + 8 * fq;
#pragma unroll
            for (int ai = 0; ai < 2; ++ai)
#pragma unroll
                for (int m = 0; m < 4; ++m) { const int row = row0 + ai * HALF + m * 16; const float rs = rsqrtf(ssq_ld(ssq, row) * (1.f / 1024.f) + RMS_EPS_F);
#pragma unroll
                    for (int bj = 0; bj < 2; ++bj) { f32x4 v0 = acc[ai][bj][m][0] * rs, v1 = acc[ai][bj][m][1] * rs; const int col = col0 + bj * HALF;
                        if (mode == 1) {
#pragma unroll
                            for (int e = 0; e < 4; ++e) { v0[e] = sigmoid_f(v0[e]); v1[e] = sigmoid_f(v1[e]); } }
                        if (mode == 2) { float* vo = (row < MPROMPT) ? voP + (size_t)row * 256 : voS + (size_t)(row - MPROMPT) * 256; *(f32x4*)(vo + col) = v0; *(f32x4*)(vo + col + 4) = v1; }
                        *(u32x4*)(O + (size_t)row * ldc + col) = pack8(v0, v1); } }
        } else if (pn < 25) {
            const bool isk = (pn == 24); const int head = isk ? wc : 4 * (pn - 20) + wc; const float* gw = isk ? kn : qn; const float sc = isk ? 1.f : ATT_C2;
            f32x4 g[2][2]; float nmax = 0.f;
#pragma unroll
            for (int bj = 0; bj < 2; ++bj)
#pragma unroll
                for (int n = 0; n < 2; ++n) g[bj][n] = *(const f32x4*)(gw + 32 * bj + 8 * fq + 4 * n) * sc;
#pragma unroll
            for (int ai = 0; ai < 2; ++ai)
#pragma unroll
                for (int m = 0; m < 4; ++m) { const int row = row0 + ai * HALF + m * 16; const float rs = rsqrtf(ssq_ld(ssq, row) * (1.f / 1024.f) + RMS_EPS_F);
                    f32x4 v[2][2]; float s = 0.f;
#pragma unroll
                    for (int bj = 0; bj < 2; ++bj)
#pragma unroll
                        for (int n = 0; n < 2; ++n) { v[bj][n] = acc[ai][bj][m][n] * rs; s += (v[bj][n][0] * v[bj][n][0] + v[bj][n][1] * v[bj][n][1]) + (v[bj][n][2] * v[bj][n][2] + v[bj][n][3] * v[bj][n][3]); }
                    s += __shfl_xor(s, 16); s += __shfl_xor(s, 32);
                    const float r = rsqrtf(s * (1.f / 64.f) + RMS_EPS_F);
                    float nn = 0.f;
#pragma unroll
                    for (int bj = 0; bj < 2; ++bj) { const f32x4 o0 = v[bj][0] * r * g[bj][0], o1 = v[bj][1] * r * g[bj][1]; const int col = head * 64 + 32 * bj + 8 * fq;
                        { f32x4 q0, q1; unpack8(pack8(o0, o1), q0, q1); nn += (q0[0] * q0[0] + q0[1] * q0[1]) + (q0[2] * q0[2] + q0[3] * q0[3]) + (q1[0] * q1[0] + q1[1] * q1[1]) + (q1[2] * q1[2] + q1[3] * q1[3]); }
                        if (isk) { float* ko = (row < MPROMPT) ? koP + (size_t)row * 256 : koS + (size_t)(row - MPROMPT) * 256; *(f32x4*)(ko + col) = o0; *(f32x4*)(ko + col + 4) = o1;
                                   *(u32x4*)(K + (size_t)row * 256 + col) = pack8(o0, o1); }
                        else *(u32x4*)(Q + (size_t)row * 1024 + col) = pack8(o0, o1); }
                    nn += __shfl_xor(nn, 16); nn += __shfl_xor(nn, 32); nmax = fmaxf(nmax, nn); }
            nmax = fmaxf(nmax, __shfl_xor(nmax, 1)); nmax = fmaxf(nmax, __shfl_xor(nmax, 2)); nmax = fmaxf(nmax, __shfl_xor(nmax, 4)); nmax = fmaxf(nmax, __shfl_xor(nmax, 8));
            if (fr == 0 && fq == 0) __hip_atomic_fetch_max((unsigned*)(ws + WS_CTL) + (isk ? CW_KMAX2 : CW_QMAX2), __float_as_uint(nmax), __ATOMIC_RELAXED, __HIP_MEMORY_SCOPE_AGENT);
        } else {
            if (wc == 0) {
                const f32x4 b0 = *(const f32x4*)(dtb + 8 * fq), b1 = *(const f32x4*)(dtb + 8 * fq + 4);
#pragma unroll
                for (int ai = 0; ai < 2; ++ai)
#pragma unroll
                    for (int m = 0; m < 4; ++m) { const int row = row0 + ai * HALF + m * 16; const float rs = rsqrtf(ssq_ld(ssq, row) * (1.f / 1024.f) + RMS_EPS_F);
                        f32x4 v0 = acc[ai][0][m][0] * rs + b0, v1 = acc[ai][0][m][1] * rs + b1;
#pragma unroll
                        for (int e = 0; e < 4; ++e) { v0[e] = softplus_f(v0[e]); v1[e] = softplus_f(v1[e]); }
                        *(f32x4*)(DT + (size_t)row * 32 + 8 * fq) = v0; *(f32x4*)(DT + (size_t)row * 32 + 8 * fq + 4) = v1; }
            } else if (wc == 1 && fq < 2) {
                const f32x4 b0 = *(const f32x4*)(bf + 8 * fq), b1 = *(const f32x4*)(bf + 8 * fq + 4);
#pragma unroll
                for (int ai = 0; ai < 2; ++ai)
#pragma unroll
                    for (int m = 0; m < 4; ++m) { const int row = row0 + ai * HALF + m * 16; const float rs = rsqrtf(ssq_ld(ssq, row) * (1.f / 1024.f) + RMS_EPS_F);
                        f32x4 v0 = acc[ai][0][m][0] * rs + b0, v1 = acc[ai][0][m][1] * rs + b1;
#pragma unroll
                        for (int e = 0; e < 4; ++e) { v0[e] = logsigmoid_f(v0[e]); v1[e] = logsigmoid_f(v1[e]); }
                        float* lo = (row < MPROMPT) ? lfP + (size_t)row * 16 : lfS + (size_t)(row - MPROMPT) * 16;
                        *(f32x4*)(lo + 8 * fq) = v0; *(f32x4*)(lo + 8 * fq + 4) = v1;
                        *(f32x4*)(LOGF + (size_t)row * 16 + 8 * fq) = v0; *(f32x4*)(LOGF + (size_t)row * 16 + 8 * fq + 4) = v1; }
            }
        }
    }
};
template <class Epi, class Sched, bool ALIGN_EPI = false, bool SP2 = false>
__device__ __forceinline__ void gemm_phase(PG8_LAS unsigned char* lds, const Gemm g, const Sched& S, const Epi& E) {
    const int tid = threadIdx.x, wid = __builtin_amdgcn_readfirstlane(tid >> 6), lane = tid & 63, wr = wid >> 2, wc = wid & 3, fr = lane & 15, fq = lane >> 4;
    const int K = g.K, nt = K / BK;
    unsigned voffA[2], voffB[2];
#pragma unroll
    for (int i = 0; i < 2; ++i) { int R, C; stage_rc(tid * 16 + i * 8192, R, C); const int Rb = Epi::PERM ? ((R & ~31) + perm32(R & 31)) : R;
        voffA[i] = (unsigned)(R * K + C) * 2u; voffB[i] = (unsigned)(Rb * K + C) * 2u; }
    const size_t kstep = (size_t)(BK * 2);
    const size_t hstep = (size_t)HALF * K * 2;
    const size_t tstep = 2 * hstep;
    const unsigned ldsw = (unsigned)wid * 1024u;
    const int aoff = lds_byte(wr * 64 + fr, fq * 8), boff = lds_byte(wc * 32 + fr, fq * 8);
#define PG8_SA(b, h) (((b) * 2 + (h)) * HTB)
#define PG8_SB(b, h) ((4 + (b) * 2 + (h)) * HTB)
#define PG8_STAGE(bufoff, gbase, voff) do { _Pragma("unroll") for (int _i = 0; _i < 2; ++_i) \
        __builtin_amdgcn_global_load_lds((const unsigned*)((const char*)(gbase) + (voff)[_i]), (PG8_LAS unsigned*)(lds + (bufoff) + ldsw + _i * 8192), 16, 0, 0); } while (0)
#define PG8_LDA(dst, b, h) do { _Pragma("unroll") for (int m = 0; m < 4; ++m) { if constexpr (Epi::FP8) dst[m][0] = __builtin_shufflevector(*(const PG8_LAS v4i*)(lds + PG8_SA(b, h) + aoff + m * 2048), *(const PG8_LAS v4i*)(lds + PG8_SA(b, h) + aoff + m * 2048 + 1024), 0, 1, 2, 3, 4, 5, 6, 7); \
        else { _Pragma("unroll") for (int k = 0; k < 2; ++k) dst[m][k] = *(const PG8_LAS bf16x8*)(lds + PG8_SA(b, h) + aoff + m * 2048 + k * 1024); } } } while (0)
#define PG8_LDB(dst, b, h) do { _Pragma("unroll") for (int n = 0; n < 2; ++n) { if constexpr (Epi::FP8) dst[n][0] = __builtin_shufflevector(*(const PG8_LAS v4i*)(lds + PG8_SB(b, h) + boff + n * 2048), *(const PG8_LAS v4i*)(lds + PG8_SB(b, h) + boff + n * 2048 + 1024), 0, 1, 2, 3, 4, 5, 6, 7); \
        else { _Pragma("unroll") for (int k = 0; k < 2; ++k) dst[n][k] = *(const PG8_LAS bf16x8*)(lds + PG8_SB(b, h) + boff + n * 2048 + k * 1024); } } } while (0)
#define PG8_MMA(ai, bj, At, Bt) do { __builtin_amdgcn_s_setprio(1); \
        if constexpr (Epi::FP8) {   \
            _Pragma("unroll") for (int m = 0; m < 4; ++m) _Pragma("unroll") for (int n = 0; n < 2; ++n) \
                asm volatile("v_mfma_f32_16x16x128_f8f6f4 %0, %1, %2, %0" : "+v"(acc[ai][bj][m][n]) : "v"(Bt[n][0]), "v"(At[m][0]));   \
        } else { \
        _Pragma("unroll") for (int m = 0; m < 4; ++m) _Pragma("unroll") for (int n = 0; n < 2; ++n) _Pragma("unroll") for (int k = 0; k < 2; ++k) \
        acc[ai][bj][m][n] = __builtin_amdgcn_mfma_f32_16x16x32_bf16(Bt[n][k], At[m][k], acc[ai][bj][m][n], 0, 0, 0); } __builtin_amdgcn_s_setprio(0); } while (0)
#define PG8_WAIT_V(n) asm volatile("s_waitcnt vmcnt(" #n ")" ::: "memory")
#define PG8_WAIT_L(n) asm volatile("s_waitcnt lgkmcnt(" #n ")" ::: "memory")
#define PG8_BAR __builtin_amdgcn_s_barrier()
#define PG8_SCHED __builtin_amdgcn_sched_barrier(0)
    Unit cur, nxt; int ui = 0;
    if (!S.next(0, cur)) return;
    f32x4 acc[2][2][4][2];
#pragma unroll
    for (int a = 0; a < 2; ++a)
#pragma unroll
        for (int b = 0; b < 2; ++b)
#pragma unroll
            for (int m = 0; m < 4; ++m)
#pragma unroll
                for (int n = 0; n < 2; ++n) acc[a][b][m][n] = (f32x4){0.f, 0.f, 0.f, 0.f};
    typename FragSel<Epi::FP8>::type At[4][Epi::FP8 ? 1 : 2], B0[2][Epi::FP8 ? 1 : 2], B1[2][Epi::FP8 ? 1 : 2];
    const char* cA = (const char*)g.A + (size_t)cur.pm * tstep; const char* cB = (const char*)g.Bt + (size_t)cur.pn * tstep;
    S.a_ready(cur);
    if constexpr (SP2) {
        PG8_STAGE(PG8_SB(0, 0), cB, voffB); PG8_STAGE(PG8_SB(0, 1), cB + hstep, voffB); PG8_STAGE(PG8_SA(0, 0), cA, voffA); PG8_STAGE(PG8_SA(0, 1), cA + hstep, voffA);
        if (wr == 1) PG8_BAR;
        PG8_WAIT_V(2); PG8_BAR;
        PG8_STAGE(PG8_SB(1, 0), cB + kstep, voffB); PG8_STAGE(PG8_SA(1, 0), cA + kstep, voffA); PG8_STAGE(PG8_SB(1, 1), cB + hstep + kstep, voffB);
        PG8_WAIT_V(6); PG8_BAR;
    } else {
        PG8_STAGE(PG8_SB(0, 0), cB, voffB); PG8_STAGE(PG8_SA(0, 0), cA, voffA); PG8_STAGE(PG8_SB(0, 1), cB + hstep, voffB); PG8_STAGE(PG8_SA(0, 1), cA + hstep, voffA);
        if (wr == 1) PG8_BAR;
        PG8_WAIT_V(4); PG8_BAR;
        PG8_STAGE(PG8_SB(1, 0), cB + kstep, voffB); PG8_STAGE(PG8_SA(1, 0), cA + kstep, voffA); PG8_STAGE(PG8_SB(1, 1), cB + hstep + kstep, voffB);
        PG8_WAIT_V(6); PG8_BAR;
    }
    for (;;) {
        const bool has_next = S.next(ui + 1, nxt);
        const char* nA = has_next ? (const char*)g.A + (size_t)nxt.pm * tstep : cA; const char* nB = has_next ? (const char*)g.Bt + (size_t)nxt.pn * tstep : cB;
        for (int t = 0; t < nt; t += 2) {
            const bool last = (t == nt - 2);
            const char* a1 = cA + (size_t)(t + 1) * kstep;
            const char* a2 = last ? nA : cA + (size_t)(t + 2) * kstep; const char* b2 = last ? nB : cB + (size_t)(t + 2) * kstep;
            const char* a3 = a2 + kstep; const char* b3 = b2 + kstep;
            if (last && has_next) S.a_ready(nxt);
            if constexpr (SP2) {
            PG8_LDB(B0, 0, 0); PG8_LDB(B1, 0, 1); PG8_SCHED; PG8_LDA(At, 0, 0); PG8_STAGE(PG8_SA(1, 1), a1 + hstep, voffA);
            PG8_WAIT_V(8); PG8_WAIT_L(0); PG8_BAR; PG8_MMA(0, 0, At, B0); PG8_MMA(0, 1, At, B1); PG8_BAR; PG8_SCHED;
            PG8_LDA(At, 0, 1); PG8_STAGE(PG8_SB(0, 0), b2, voffB); PG8_STAGE(PG8_SB(0, 1), b2 + hstep, voffB); PG8_STAGE(PG8_SA(0, 0), a2, voffA);
            PG8_WAIT_V(8); PG8_WAIT_L(0); PG8_BAR; PG8_MMA(1, 0, At, B0); PG8_MMA(1, 1, At, B1); PG8_BAR; PG8_SCHED;
            PG8_LDB(B0, 1, 0); PG8_LDB(B1, 1, 1); PG8_SCHED; PG8_LDA(At, 1, 0); PG8_STAGE(PG8_SA(0, 1), a2 + hstep, voffA);
            PG8_WAIT_V(8); PG8_WAIT_L(0); PG8_BAR; PG8_MMA(0, 0, At, B0); PG8_MMA(0, 1, At, B1); PG8_BAR; PG8_SCHED;
            PG8_LDA(At, 1, 1); PG8_STAGE(PG8_SB(1, 0), b3, voffB); PG8_STAGE(PG8_SB(1, 1), b3 + hstep, voffB); PG8_STAGE(PG8_SA(1, 0), a3, voffA);
            PG8_WAIT_V(8); PG8_WAIT_L(0); PG8_BAR; PG8_MMA(1, 0, At, B0); PG8_MMA(1, 1, At, B1); PG8_BAR; PG8_SCHED;
            } else {
            PG8_LDB(B0, 0, 0); PG8_SCHED; PG8_LDA(At, 0, 0); PG8_STAGE(PG8_SA(1, 1), a1 + hstep, voffA);
            PG8_WAIT_L(8); PG8_BAR; PG8_WAIT_L(0); PG8_MMA(0, 0, At, B0); PG8_BAR; PG8_SCHED;
            PG8_LDB(B1, 0, 1); PG8_STAGE(PG8_SB(0, 0), b2, voffB);
            PG8_BAR; PG8_WAIT_L(0); PG8_MMA(0, 1, At, B1); PG8_BAR;
            PG8_LDA(At, 0, 1); PG8_STAGE(PG8_SA(0, 0), a2, voffA);
            PG8_BAR; PG8_WAIT_L(0); PG8_MMA(1, 0, At, B0); PG8_BAR; PG8_SCHED;
            PG8_STAGE(PG8_SB(0, 1), b2 + hstep, voffB);
            PG8_WAIT_V(6); PG8_BAR; PG8_MMA(1, 1, At, B1); PG8_BAR;
            PG8_LDB(B0, 1, 0); PG8_SCHED; PG8_LDA(At, 1, 0); PG8_STAGE(PG8_SA(0, 1), a2 + hstep, voffA);
            PG8_WAIT_L(8); PG8_BAR; PG8_WAIT_L(0); PG8_MMA(0, 0, At, B0); PG8_BAR; PG8_SCHED;
            PG8_LDB(B1, 1, 1); PG8_STAGE(PG8_SB(1, 0), b3, voffB);
            PG8_BAR; PG8_WAIT_L(0); PG8_MMA(0, 1, At, B1); PG8_BAR;
            PG8_LDA(At, 1, 1); PG8_STAGE(PG8_SA(1, 0), a3, voffA);
            PG8_BAR; PG8_WAIT_L(0); PG8_MMA(1, 0, At, B0); PG8_BAR; PG8_SCHED;
            PG8_STAGE(PG8_SB(1, 1), b3 + hstep, voffB);
            PG8_WAIT_V(6); PG8_BAR; PG8_MMA(1, 1, At, B1); PG8_BAR;
            }
        }
        if constexpr (ALIGN_EPI) { if (wr == 0) PG8_BAR; }
        if constexpr (Epi::FP8) asm volatile("s_nop 15\n\ts_nop 15" ::: "memory");
        if constexpr (!Epi::AFTER_DRAIN) { E(acc, cur, wr, wc, fr, fq); S.done(cur); }
        if (!has_next) break;
#pragma unroll
        for (int a = 0; a < 2; ++a)
#pragma unroll
            for (int b = 0; b < 2; ++b)
#pragma unroll
                for (int m = 0; m < 4; ++m)
#pragma unroll
                    for (int n = 0; n < 2; ++n) acc[a][b][m][n] = (f32x4){0.f, 0.f, 0.f, 0.f};
        cur = nxt; cA = nA; cB = nB; ++ui;
        if constexpr (ALIGN_EPI) { if (wr == 1) PG8_BAR; }
    }
    PG8_WAIT_V(0);
    if constexpr (!ALIGN_EPI) { if (wr == 0) PG8_BAR; }
    PG8_BAR;
    if constexpr (Epi::AFTER_DRAIN) { E.fused(acc, cur, wr, wc, fr, fq, lds, wid, lane); S.done(cur); }
#undef PG8_SA
#undef PG8_SB
#undef PG8_STAGE
#undef PG8_LDA
#undef PG8_LDB
#undef PG8_MMA
#undef PG8_WAIT_V
#undef PG8_WAIT_L
#undef PG8_BAR
#undef PG8_SCHED
}
}
#define GAS __attribute__((address_space(1)))
#define LAS __attribute__((address_space(3)))
typedef unsigned short bf16;
typedef unsigned v4u __attribute__((ext_vector_type(4)));
typedef unsigned v2u __attribute__((ext_vector_type(2)));
typedef float f32x4 __attribute__((ext_vector_type(4)));
typedef float f32x16 __attribute__((ext_vector_type(16)));
typedef short bf16x8 __attribute__((ext_vector_type(8)));
typedef short s16x4 __attribute__((ext_vector_type(4)));
typedef GAS unsigned gu32;
#define RLX_AGENT __ATOMIC_RELAXED, __HIP_MEMORY_SCOPE_AGENT
#define LDS_WAIT() asm volatile("s_waitcnt lgkmcnt(0)" ::: "memory")
#define VM_WAIT() asm volatile("s_waitcnt vmcnt(0)" ::: "memory")
__device__ __forceinline__ unsigned f2bf(float f) { unsigned u = __builtin_bit_cast(unsigned, f); return (u + 0x7fffu + ((u >> 16) & 1u)) >> 16; }
__device__ __forceinline__ unsigned pk2(float lo, float hi) { unsigned r; asm("v_cvt_pk_bf16_f32 %0, %1, %2" : "=v"(r) : "v"(lo), "v"(hi)); return r; }
__device__ __forceinline__ float bflo(unsigned w) { return __uint_as_float(w << 16); }
__device__ __forceinline__ float bfhi(unsigned w) { return __uint_as_float(w & 0xffff0000u); }
__device__ __forceinline__ float wave_sum(float v) {
#pragma unroll
    for (int o = 1; o < 64; o <<= 1) v += __shfl_xor(v, o);
    return v;
}
#define XB_TMO      128
#define XB_XCNT(j)  (256  + 64 * (j))
#define XB_XSUB(j)  (1280 + 64 * (j))
#define XB_XGEN(j)  (2304 + 64 * (j))
#define XB_TOP      3328
#define XB_TOPGEN   3392
#define XCD_BAR_WORDS 3456
#define XB_SPIN_CAP (1u << 18)

__device__ __forceinline__ unsigned xb_ld(unsigned* p)              { return __hip_atomic_load(p, __ATOMIC_RELAXED, __HIP_MEMORY_SCOPE_AGENT); }
__device__ __forceinline__ unsigned xb_add(unsigned* p, unsigned v) { return __hip_atomic_fetch_add(p, v, __ATOMIC_RELAXED, __HIP_MEMORY_SCOPE_AGENT); }
__device__ __forceinline__ unsigned xb_xcc_id() { return (unsigned)__builtin_amdgcn_s_getreg((3 << 11) | 20) & 0xFu; }
#define XB_SPIN(cond, bar) do { unsigned _sp = 0; while (cond) { __builtin_amdgcn_s_sleep(1); \
    if ((++_sp & 255u) == 0u) { if (xb_ld(&(bar)[XB_TMO])) break; if (_sp > XB_SPIN_CAP) { atomicAdd(&(bar)[XB_TMO], 1u); break; } } } } while (0)

struct XcdBarrier {
    unsigned* bar; unsigned x;
    volatile LAS unsigned* st;
};

__device__ __forceinline__ XcdBarrier xcd_barrier_post(unsigned* bar, volatile LAS unsigned* st) {
    XcdBarrier b; b.bar = bar; b.x = xb_xcc_id(); b.st = st;
    if (threadIdx.x == 0) (void)xb_add(&bar[XB_XCNT(b.x)], 1u);
    return b;
}
__device__ __forceinline__ void xcd_barrier_complete(unsigned* bar, unsigned x, unsigned& nloc, unsigned& nx) {
    const unsigned G = gridDim.x * gridDim.y * gridDim.z;
    unsigned sum, cnt, mine, sp = 0u;
    for (;;) {
        sum = 0u; cnt = 0u; mine = 0u;
#pragma unroll
        for (unsigned j = 0; j < 16; ++j) { const unsigned c = xb_ld(&bar[XB_XCNT(j)]); sum += c; cnt += (c > 0u) ? 1u : 0u; mine = (j == x) ? c : mine; }
        if (sum == G) break;
        __builtin_amdgcn_s_sleep(1);
        if ((++sp & 255u) == 0u) { if (xb_ld(&bar[XB_TMO])) break; if (sp > XB_SPIN_CAP) { atomicAdd(&bar[XB_TMO], 1u); break; } }
    }
    nloc = mine > 0u ? mine : 1u; nx = cnt > 0u ? cnt : 1u;
}

__device__ __forceinline__ void xcd_barrier(const XcdBarrier& b) {
    asm volatile("s_waitcnt vmcnt(0)" ::: "memory");
    __syncthreads();
    if (threadIdx.x == 0) {
        unsigned* bar = b.bar;
        __builtin_amdgcn_s_waitcnt(0);
        unsigned nloc = b.st[0], nx = b.st[1];
        if (nloc == 0u) { xcd_barrier_complete(bar, b.x, nloc, nx); b.st[0] = nloc; b.st[1] = nx; }
        const unsigned old = xb_add(&bar[XB_XSUB(b.x)], 1u);
        const unsigned gen = old / nloc;
        if (old + 1u == (gen + 1u) * nloc) {
            __builtin_amdgcn_fence(__ATOMIC_RELEASE, "agent");
            asm volatile("s_waitcnt vmcnt(0)" ::: "memory");
            const unsigned og = xb_add(&bar[XB_TOP], 1u);
            const unsigned tg = og / nx;
            if (og + 1u == (tg + 1u) * nx) xb_add(&bar[XB_TOPGEN], 1u);
            else XB_SPIN(xb_ld(&bar[XB_TOPGEN]) == tg, bar);
            __builtin_amdgcn_fence(__ATOMIC_ACQUIRE, "agent");
            xb_add(&bar[XB_XGEN(b.x)], 1u);
            asm volatile("s_waitcnt vmcnt(0)" ::: "memory");
        } else {
            XB_SPIN(xb_ld(&bar[XB_XGEN(b.x)]) == gen, bar);
            __builtin_amdgcn_fence(__ATOMIC_ACQUIRE, "agent");
            asm volatile("s_waitcnt vmcnt(0)" ::: "memory");
        }
    }
    __syncthreads();
}
struct MapPlain { const float* W; int N; __device__ __forceinline__ const float* operator()(int n, int& ld) const { ld = N; return W + n; } };
struct MapGU { const float* W; __device__ __forceinline__ const float* operator()(int n, int& ld) const { ld = DFF; const int pn = n >> 8, j = n & 127; return W + 128 * pn + j; } };
struct MapWin { const float* W; __device__ __forceinline__ const float* operator()(int n, int& ld) const { ld = INDIM; const int pn = n >> 8, ct = n & 255; int c;
        if (pn < 20) c = n;
        else if (pn < 25) { const int bj = ct >> 7, wc = (ct >> 5) & 3, j = ct & 31; c = (pn == 24 ? 6176 + 64 * wc : 5152 + 64 * (4 * (pn - 20) + wc)) + 32 * bj + j; }
        else if (pn == 25) c = 6432 + ct;
        else if (pn < 30) c = 6704 + (n - 26 * 256);
        else if (pn < 34) c = 7728 + (n - 30 * 256);
        else c = ct < 32 ? 5120 + ct : (ct < 48 ? 6688 + (ct - 32) : -1);
        return c < 0 ? nullptr : W + c; } };
template <class Map> __device__ __forceinline__ void p0_transpose_item(const Map& mp, const float* ksc, int K, bf16* WT, LAS float* scr, int kb, int nb, int lane, unsigned char* W8 = nullptr, float SC = 1.f) {
    const int k0 = 64 * kb, n0 = 64 * nb; int ld; const float* src = mp(n0 + lane, ld);
    float v[64];
#pragma unroll
    for (int i = 0; i < 64; ++i) v[i] = src ? src[(size_t)(k0 + i) * ld] : 0.f;
    const float sc = ksc ? ksc[k0 + lane] : 1.f;
#pragma unroll
    for (int i = 0; i < 64; ++i) scr[i * 65 + lane] = v[i] * __shfl(sc, i);
    LDS_WAIT(); asm volatile("" ::: "memory");
    const int c = lane & 7;
#pragma unroll
    for (int j = 0; j < 8; ++j) { const int n = (lane >> 3) + 8 * j; const LAS float* s = scr + (8 * c) * 65 + n;
        v4u o; o.x = pk2(s[0 * 65], s[1 * 65]); o.y = pk2(s[2 * 65], s[3 * 65]); o.z = pk2(s[4 * 65], s[5 * 65]); o.w = pk2(s[6 * 65], s[7 * 65]);
        if (WT) *(GAS v4u*)(WT + (size_t)(n0 + n) * K + k0 + 8 * c) = o;
        if (W8) { int w0 = 0, w1 = 0;
            w0 = __builtin_amdgcn_cvt_pk_fp8_f32(s[0 * 65] * SC, s[1 * 65] * SC, w0, false); w0 = __builtin_amdgcn_cvt_pk_fp8_f32(s[2 * 65] * SC, s[3 * 65] * SC, w0, true);
            w1 = __builtin_amdgcn_cvt_pk_fp8_f32(s[4 * 65] * SC, s[5 * 65] * SC, w1, false); w1 = __builtin_amdgcn_cvt_pk_fp8_f32(s[6 * 65] * SC, s[7 * 65] * SC, w1, true);
            v2u o8; o8.x = (unsigned)w0; o8.y = (unsigned)w1; *(GAS v2u*)(W8 + (size_t)(n0 + n) * K + k0 + 8 * c) = o8; } }
    LDS_WAIT(); asm volatile("" ::: "memory");
}
__device__ __forceinline__ void p0_row_to_bf16(const float* xrow, bf16* orow, pg8::ssq_t* ssq, int lane) {
    const GAS f32x4* xr = (const GAS f32x4*)xrow + lane;
    f32x4 v[4]; float s = 0.f;
#pragma unroll
    for (int j = 0; j < 4; ++j) { v[j] = xr[64 * j]; s += (v[j].x * v[j].x + v[j].y * v[j].y) + (v[j].z * v[j].z + v[j].w * v[j].w); }
    s = wave_sum(s);
    GAS unsigned long long* o8 = (GAS unsigned long long*)orow + lane;
#pragma unroll
    for (int j = 0; j < 4; ++j) o8[64 * j] = (unsigned long long)pk2(v[j].x, v[j].y) | ((unsigned long long)pk2(v[j].z, v[j].w) << 32);
    if (lane == 0) *ssq = pg8::ssq_fx(s);
}
__device__ __forceinline__ void p0_rows_to_bf16(const float* xrow, bf16* orow, pg8::ssq_t* ssq, int lane) {
    const GAS f32x4* xr = (const GAS f32x4*)xrow + lane;
    f32x4 v[8]; float s0 = 0.f, s1 = 0.f;
#pragma unroll
    for (int j = 0; j < 8; ++j) v[j] = xr[64 * j];
#pragma unroll
    for (int j = 0; j < 4; ++j) { s0 += (v[j].x * v[j].x + v[j].y * v[j].y) + (v[j].z * v[j].z + v[j].w * v[j].w); s1 += (v[4 + j].x * v[4 + j].x + v[4 + j].y * v[4 + j].y) + (v[4 + j].z * v[4 + j].z + v[4 + j].w * v[4 + j].w); }
    s0 = wave_sum(s0); s1 = wave_sum(s1);
    GAS unsigned long long* o8 = (GAS unsigned long long*)orow + lane;
#pragma unroll
    for (int j = 0; j < 8; ++j) o8[64 * j] = (unsigned long long)pk2(v[j].x, v[j].y) | ((unsigned long long)pk2(v[j].z, v[j].w) << 32);
    if (lane == 0) { ssq[0] = pg8::ssq_fx(s0); ssq[1] = pg8::ssq_fx(s1); }
}
__device__ __forceinline__ f32x16 mfma32(bf16x8 a, bf16x8 b, f32x16 c) { return __builtin_amdgcn_mfma_f32_32x32x16_bf16(a, b, c, 0, 0, 0); }
__device__ __forceinline__ int crow(int r, int hi) { return (r & 3) + 8 * (r >> 2) + 4 * hi; }
typedef short v4i16_t __attribute__((ext_vector_type(4)));
__device__ __forceinline__ s16x4 ds_tr(LAS const unsigned char* p) { return __builtin_bit_cast(s16x4, __builtin_amdgcn_ds_read_tr16_b64_v4i16((LAS v4i16_t*)p)); }
__device__ __forceinline__ bf16x8 tr_frag(LAS const unsigned char* tile, int pitch, int ka, int kb, int cb, int lane) {
    const int i = lane & 15, q = i >> 2, pp = i & 3, c16 = cb + 16 * ((lane >> 4) & 1);
    const s16x4 lo = ds_tr(tile + (ka + q) * pitch + (c16 + 4 * pp) * 2), hi = ds_tr(tile + (kb + q) * pitch + (c16 + 4 * pp) * 2);
    return (bf16x8){lo[0], lo[1], lo[2], lo[3], hi[0], hi[1], hi[2], hi[3]};
}
__device__ __forceinline__ float wave_scan_incl(float v, int lane) {
#pragma unroll
    for (int o = 1; o < 64; o <<= 1) { const float t = __shfl_up(v, o); if (lane >= o) v += t; }
    return v;
}
__device__ __forceinline__ float silu1(float x) { return x * __builtin_amdgcn_rcpf(1.f + __builtin_amdgcn_exp2f(-1.4426950408889634f * x)); }
__device__ __forceinline__ float exp_fast(float x) { return __builtin_amdgcn_exp2f(1.4426950408889634f * x); }
__device__ __forceinline__ void unpk8(const v4u w, float (&f)[8]) { f[0] = bflo(w.x); f[1] = bfhi(w.x); f[2] = bflo(w.y); f[3] = bfhi(w.y); f[4] = bflo(w.z); f[5] = bfhi(w.z); f[6] = bflo(w.w); f[7] = bfhi(w.w); }
__device__ __forceinline__ v4u pk8(const float (&f)[8]) { v4u o; o.x = pk2(f[0], f[1]); o.y = pk2(f[2], f[3]); o.z = pk2(f[4], f[5]); o.w = pk2(f[6], f[7]); return o; }

struct ConvW { float w[4][8]; float b[8]; };
__device__ __forceinline__ void conv_load_w(ConvW& cw, const float* convw, const float* convb, int col) {
#pragma unroll
    for (int j = 0; j < 4; ++j) { const f32x4 a = *(const f32x4*)(convw + (size_t)j * CONVD + col), b = *(const f32x4*)(convw + (size_t)j * CONVD + col + 4);
        cw.w[j][0] = a[0]; cw.w[j][1] = a[1]; cw.w[j][2] = a[2]; cw.w[j][3] = a[3]; cw.w[j][4] = b[0]; cw.w[j][5] = b[1]; cw.w[j][6] = b[2]; cw.w[j][7] = b[3]; }
    const f32x4 a = *(const f32x4*)(convb + col), b = *(const f32x4*)(convb + col + 4);
    cw.b[0] = a[0]; cw.b[1] = a[1]; cw.b[2] = a[2]; cw.b[3] = a[3]; cw.b[4] = b[0]; cw.b[5] = b[1]; cw.b[6] = b[2]; cw.b[7] = b[3];
}
__device__ __forceinline__ void conv_item(unsigned char* ws, const float* convw, const float* convb, int item, int lane) {
    asm volatile("" : "+v"(lane));
    const int cbk = item % 6, rb = item / 6; const int col = 512 * cbk + 8 * lane; const long row0 = 16l * rb; const int tpos0 = (int)(row0 & (SEQ - 1));
    const bf16* XBC = (const bf16*)(ws + WS_XBC); bf16* XC = (bf16*)(ws + WS_XC);
    v4u raw[19];
#pragma unroll
    for (int k = 0; k < 19; ++k) { raw[k] = (v4u){0u, 0u, 0u, 0u}; if (tpos0 - 3 + k >= 0) raw[k] = *(const GAS v4u*)(XBC + (size_t)(row0 - 3 + k) * CONVD + col); }
    ConvW cw; conv_load_w(cw, convw, convb, col);
    float x0[8], x1[8], x2[8], x3[8];
    unpk8(raw[0], x1); unpk8(raw[1], x2); unpk8(raw[2], x3);
#pragma unroll
    for (int k = 3; k < 19; ++k) {
#pragma unroll
        for (int e = 0; e < 8; ++e) { x0[e] = x1[e]; x1[e] = x2[e]; x2[e] = x3[e]; }
        unpk8(raw[k], x3); float y[8];
#pragma unroll
        for (int e = 0; e < 8; ++e) y[e] = silu1(cw.b[e] + cw.w[0][e] * x0[e] + cw.w[1][e] * x1[e] + cw.w[2][e] * x2[e] + cw.w[3][e] * x3[e]);
        *(GAS v4u*)(XC + (size_t)(row0 - 3 + k) * CONVD + col) = pk8(y); }
}

__device__ __forceinline__ void conv_item_q(unsigned char* ws, const float* convw, const float* convb, long row0, int colbase, int lane) {
    asm volatile("" : "+v"(lane));
    const int col = colbase + 8 * (lane & 15); const long r0 = row0 + 16 * (lane >> 4); const int tpos0 = (int)(r0 & (SEQ - 1));
    const bf16* XBC = (const bf16*)(ws + WS_XBC); bf16* XC = (bf16*)(ws + WS_XC);
    v4u raw[19];
#pragma unroll
    for (int k = 0; k < 19; ++k) { raw[k] = (v4u){0u, 0u, 0u, 0u}; if (tpos0 - 3 + k >= 0) raw[k] = *(const GAS v4u*)(XBC + (size_t)(r0 - 3 + k) * CONVD + col); }
    ConvW cw; conv_load_w(cw, convw, convb, col);
    float x0[8], x1[8], x2[8], x3[8];
    unpk8(raw[0], x1); unpk8(raw[1], x2); unpk8(raw[2], x3);
#pragma unroll
    for (int k = 3; k < 19; ++k) {
#pragma unroll
        for (int e = 0; e < 8; ++e) { x0[e] = x1[e]; x1[e] = x2[e]; x2[e] = x3[e]; }
        unpk8(raw[k], x3); float y[8];
#pragma unroll
        for (int e = 0; e < 8; ++e) y[e] = silu1(cw.b[e] + cw.w[0][e] * x0[e] + cw.w[1][e] * x1[e] + cw.w[2][e] * x2[e] + cw.w[3][e] * x3[e]);
        *(GAS v4u*)(XC + (size_t)(r0 - 3 + k) * CONVD + col) = pk8(y); }
}

constexpr int P4_BM = 0, P4_BM_PITCH = 320, P4_X = 40960, P4_X_PITCH = 1088, P4_WGT = P4_X + 64 * P4_X_PITCH;
static_assert(P4_WGT + 4096 <= MISC_OFF, "states LDS map");
__device__ __forceinline__ void p4_unit(unsigned char* ws, const float* convw, const float* convb, LAS unsigned char* lds, int unit, int tid, int lane, int wave) {
    asm volatile("" : "+v"(tid));
    lane = tid & 63;
    const int g = unit & 3, c = (unit >> 2) & 31, b = unit >> 7;
    const size_t row0 = (size_t)b * SEQ + (size_t)c * CHUNK;
    const bf16* XC = (const bf16*)(ws + WS_XC);
    const float* DT = (const float*)(ws + WS_DT); float* ACS = (float*)(ws + WS_ACS); const float* par = (const float*)(ws + WS_PAR);
    LAS float* wgtT = (LAS float*)(lds + P4_WGT);
    conv_item(ws, convw, convb, (int)(((row0 >> 4) + wave) * 6 + g), lane);
    if (wave < 4) conv_item_q(ws, convw, convb, (long)row0 + 64 * (wave & 1), ((wave >> 1) ? 2560 : 2048) + 128 * g, lane);
    __syncthreads();
    v4u braw[4], xraw[8];
#pragma unroll
    for (int i = 0; i < 4; ++i) { const int id = tid + 512 * i, l = id >> 4, ch = id & 15; braw[i] = *(const GAS v4u*)(XC + (row0 + l) * CONVD + 2048 + 128 * g + 8 * ch); }
#pragma unroll
    for (int i = 0; i < 8; ++i) { const int id = tid + 512 * i, l = id >> 6, ch = id & 63; xraw[i] = *(const GAS v4u*)(XC + (row0 + l) * CONVD + 512 * g + 8 * ch); }
    { const int hd = 8 * g + wave; const float Ah = -expf(par[PAR_ALOG + hd]);
      const float d0 = DT[(row0 + 2 * lane) * 32 + hd], d1 = DT[(row0 + 2 * lane + 1) * 32 + hd];
      const float a0 = d0 * Ah, a1 = d1 * Ah; const float inc = wave_scan_incl(a0 + a1, lane);
      const float acs1 = inc, acs0 = inc - a1, last = __shfl(inc, 63);
      wgtT[wave * 128 + 2 * lane] = d0 * exp_fast(last - acs0); wgtT[wave * 128 + 2 * lane + 1] = d1 * exp_fast(last - acs1);
      ACS[(row0 + 2 * lane) * 32 + hd] = acs0; ACS[(row0 + 2 * lane + 1) * 32 + hd] = acs1; }
#pragma unroll
    for (int i = 0; i < 4; ++i) { const int id = tid + 512 * i, l = id >> 4, ch = id & 15; *(LAS v4u*)(lds + P4_BM + l * P4_BM_PITCH + 16 * ch) = braw[i]; }
    f32x16 acc[2][4];
#pragma unroll
    for (int pt = 0; pt < 2; ++pt)
#pragma unroll
        for (int nt = 0; nt < 4; ++nt) acc[pt][nt] = (f32x16){};
#pragma unroll 1
    for (int hf = 0; hf < 2; ++hf) {
#pragma unroll
        for (int i = 0; i < 8; ++i) { const int id = tid + 512 * i, l = id >> 6, ch = id & 63; *(LAS v4u*)(lds + P4_X + l * P4_X_PITCH + 16 * ch) = xraw[i]; }
        __syncthreads();
        if (hf == 0) {
#pragma unroll
            for (int i = 0; i < 8; ++i) { const int id = tid + 512 * i, l = id >> 6, ch = id & 63; xraw[i] = *(const GAS v4u*)(XC + (row0 + 64 + l) * CONVD + 512 * g + 8 * ch); } }
        { LAS const unsigned char* xt = lds + P4_X; LAS const unsigned char* bm = lds + P4_BM; const int h = lane >> 5;
#pragma unroll
          for (int ks = 0; ks < 4; ++ks) { bf16x8 af[2], bfr[4];
              const f32x4 w0 = *(LAS const f32x4*)(wgtT + wave * 128 + 64 * hf + 16 * ks + 8 * h), w1 = *(LAS const f32x4*)(wgtT + wave * 128 + 64 * hf + 16 * ks + 8 * h + 4);
#pragma unroll
              for (int pt = 0; pt < 2; ++pt) { const v4u xr = __builtin_bit_cast(v4u, tr_frag(xt, P4_X_PITCH, 16 * ks + 8 * h, 16 * ks + 8 * h + 4, 64 * wave + 32 * pt, lane));
                  v4u xw; xw.x = pk2(bflo(xr.x) * w0[0], bfhi(xr.x) * w0[1]); xw.y = pk2(bflo(xr.y) * w0[2], bfhi(xr.y) * w0[3]); xw.z = pk2(bflo(xr.z) * w1[0], bfhi(xr.z) * w1[1]); xw.w = pk2(bflo(xr.w) * w1[2], bfhi(xr.w) * w1[3]);
                  af[pt] = __builtin_bit_cast(bf16x8, xw); }
#pragma unroll
              for (int nt = 0; nt < 4; ++nt) bfr[nt] = tr_frag(bm, P4_BM_PITCH, 64 * hf + 16 * ks + 8 * h, 64 * hf + 16 * ks + 8 * h + 4, 32 * nt, lane);
#pragma unroll
              for (int pt = 0; pt < 2; ++pt)
#pragma unroll
                  for (int nt = 0; nt < 4; ++nt) acc[pt][nt] = mfma32(af[pt], bfr[nt], acc[pt][nt]); } }
        __syncthreads();
    }
    { bf16* ST = (bf16*)(ws + WS_ST) + ((size_t)(b * NCHUNK + c) * SH + 8 * g + wave) * (SP * SN); const int h = lane >> 5, r = lane & 31;
#pragma unroll
      for (int pt = 0; pt < 2; ++pt)
#pragma unroll
          for (int nt = 0; nt < 4; ++nt)
#pragma unroll
              for (int q = 0; q < 16; ++q) ST[(32 * pt + crow(q, h)) * SN + 32 * nt + r] = (bf16)f2bf(acc[pt][nt][q]); }
}
constexpr int P4S_WAVE = 12288, P4S_BS = 0, P4S_CS = 4096, P4S_XS = 8192, P4S_YO = 10240;
__device__ __forceinline__ void p4s_item(unsigned char* ws, float* dout, const float* convw, const float* convb, const float* sconv, const float* sssm, LAS unsigned char* wl, int item, int lane) {
    asm volatile("" : "+v"(lane));
    const int hd = item & 31, b = item >> 5, g = hd >> 3; const size_t row0 = (size_t)MP + (size_t)b * DECS;
    const bf16* XBC = (const bf16*)(ws + WS_XBC); const float* DT = (const float*)(ws + WS_DT); const float* par = (const float*)(ws + WS_PAR); float* YRAW = (float*)(ws + WS_YRAW);
    LAS float* Bs = (LAS float*)(wl + P4S_BS); LAS float* Cs = (LAS float*)(wl + P4S_CS); LAS float* xsl = (LAS float*)(wl + P4S_XS); LAS float* yo = (LAS float*)(wl + P4S_YO);
    float xs[8];
#pragma unroll
    for (int part = 0; part < 5; ++part) {
        const int col = part == 0 ? 64 * hd + lane : (part == 1 ? 2048 + 128 * g + lane : (part == 2 ? 2048 + 128 * g + 64 + lane : (part == 3 ? 2560 + 128 * g + lane : 2560 + 128 * g + 64 + lane)));
        float xa[11];
#pragma unroll
        for (int j = 0; j < 3; ++j) xa[j] = sconv[((size_t)b * 3 + j) * CONVD + col];
#pragma unroll
        for (int i = 0; i < 8; ++i) xa[3 + i] = __uint_as_float((unsigned)XBC[(row0 + i) * CONVD + col] << 16);
        const float w0 = convw[col], w1 = convw[CONVD + col], w2 = convw[2 * CONVD + col], w3 = convw[3 * CONVD + col], bb = convb[col];
#pragma unroll
        for (int i = 0; i < 8; ++i) { const float y = silu1(bb + w0 * xa[i] + w1 * xa[i + 1] + w2 * xa[i + 2] + w3 * xa[i + 3]);
            if (part == 0) { xs[i] = y; xsl[i * 64 + lane] = y; } else if (part == 1) Bs[i * 128 + lane] = y; else if (part == 2) Bs[i * 128 + 64 + lane] = y; else if (part == 3) Cs[i * 128 + lane] = y; else Cs[i * 128 + 64 + lane] = y; }
        if (part == 0 || (hd & 7) == 0) {
#pragma unroll
            for (int j = 0; j < 3; ++j) dout[O_CONVS + ((size_t)b * 3 + j) * CONVD + col] = xa[8 + j]; }
    }
    float dt[8], acs[8]; { const float Ah = -expf(par[PAR_ALOG + hd]); float cs = 0.f;
#pragma unroll
      for (int i = 0; i < 8; ++i) { dt[i] = DT[(row0 + i) * 32 + hd]; cs += dt[i] * Ah; acs[i] = cs; } }
    float cb = 0.f; { const int l = lane >> 3, sx = lane & 7;
#pragma unroll 8
      for (int n = 0; n < 128; n += 4) { const f32x4 c = *(LAS const f32x4*)(Cs + l * 128 + n), bv = *(LAS const f32x4*)(Bs + sx * 128 + n); cb += (c[0] * bv[0] + c[1] * bv[1]) + (c[2] * bv[2] + c[3] * bv[3]); } }
    float y[8]; const float Dk = par[PAR_DSKIP + hd];
#pragma unroll
    for (int l = 0; l < 8; ++l) { float a = Dk * xs[l];
#pragma unroll
        for (int s = 0; s <= l; ++s) a += __shfl(cb, 8 * l + s) * exp_fast(acs[l] - acs[s]) * dt[s] * xs[s];
        y[l] = a; }
    const float* h0 = sssm + ((size_t)b * SH + hd) * (SP * SN); float* hout = dout + O_SSMS + ((size_t)b * SH + hd) * (SP * SN);
    float wg[8], ea[8];
#pragma unroll
    for (int l = 0; l < 8; ++l) { wg[l] = dt[l] * exp_fast(acs[7] - acs[l]); ea[l] = exp_fast(acs[l]); }
    const float ed = ea[7]; const int pp = lane >> 3, nc = lane & 7;
#pragma unroll 2
    for (int it = 0; it < 8; ++it) { const int p = 8 * it + pp;
        f32x4 hv[4], nv[4];
#pragma unroll
        for (int j = 0; j < 4; ++j) { hv[j] = *(const f32x4*)(h0 + p * SN + 16 * nc + 4 * j); nv[j] = hv[j] * ed; }
#pragma unroll
        for (int l = 0; l < 8; ++l) { const float xv = xsl[l * 64 + p] * wg[l]; float d = 0.f;
#pragma unroll
            for (int j = 0; j < 4; ++j) { const f32x4 c = *(LAS const f32x4*)(Cs + l * 128 + 16 * nc + 4 * j), bv = *(LAS const f32x4*)(Bs + l * 128 + 16 * nc + 4 * j);
                d += (c[0] * hv[j][0] + c[1] * hv[j][1]) + (c[2] * hv[j][2] + c[3] * hv[j][3]); nv[j] += bv * xv; }
            d += __shfl_xor(d, 1); d += __shfl_xor(d, 2); d += __shfl_xor(d, 4);
            if (nc == l) yo[l * 64 + p] = d; }
#pragma unroll
        for (int j = 0; j < 4; ++j) *(f32x4*)(hout + p * SN + 16 * nc + 4 * j) = nv[j]; }
#pragma unroll
    for (int l = 0; l < 8; ++l) YRAW[(size_t)(8 * b + l) * DSSM + 64 * hd + lane] = y[l] + ea[l] * yo[l * 64 + lane];
}
__device__ __forceinline__ void p4s_norm_item(unsigned char* ws, const float* ssdn, int item, int lane) {
    asm volatile("" : "+v"(lane));
    const int g = item & 3, i = item >> 2; const size_t row = (size_t)MP + i; const int ch0 = 512 * g + 8 * lane;
    const bf16* Zb = (const bf16*)(ws + WS_Z); bf16* YS = (bf16*)(ws + WS_YS); const float* YRAW = (const float*)(ws + WS_YRAW) + (size_t)i * DSSM + ch0;
    float z[8], y[8]; unpk8(*(const GAS v4u*)(Zb + row * DSSM + ch0), z); const f32x4 ya = *(const f32x4*)YRAW, yb = *(const f32x4*)(YRAW + 4); float ss = 0.f;
    y[0] = ya[0]; y[1] = ya[1]; y[2] = ya[2]; y[3] = ya[3]; y[4] = yb[0]; y[5] = yb[1]; y[6] = yb[2]; y[7] = yb[3];
#pragma unroll
    for (int e = 0; e < 8; ++e) { y[e] *= silu1(z[e]); ss += y[e] * y[e]; }
    ss = wave_sum(ss); const float rs = rsqrtf(ss * (1.f / 512.f) + 1e-6f);
#pragma unroll
    for (int e = 0; e < 8; ++e) y[e] = y[e] * rs * ssdn[ch0 + e];
    *(GAS v4u*)(YS + row * DSSM + ch0) = pk8(y);
}

__device__ __forceinline__ void p5_scan(unsigned char* ws, float* dout, int gtid, int gthreads) {
    bf16* ST = (bf16*)(ws + WS_ST); const float* ACS = (const float*)(ws + WS_ACS);
    for (int gid = gtid; gid < NBATCH * SH * SP * (SN / 8); gid += gthreads) {
        const int nch = gid & 15, p = (gid >> 4) & 63, hd = (gid >> 10) & 31, b = gid >> 15;
        float h[8] = {};
#pragma unroll 4
        for (int c = 0; c < NCHUNK; ++c) {
            GAS v4u* slot = (GAS v4u*)(ST + ((size_t)(b * NCHUNK + c) * SH + hd) * (SP * SN) + p * SN + nch * 8);
            const v4u sv = *slot; *slot = pk8(h);
            const float dec = expf(ACS[((size_t)b * SEQ + (size_t)c * CHUNK + CHUNK - 1) * 32 + hd]);
            float s[8]; unpk8(sv, s);
#pragma unroll
            for (int e = 0; e < 8; ++e) h[e] = dec * h[e] + s[e];
        }
        float* o = dout + O_SSMP + ((size_t)(b * SH + hd) * SP + p) * SN + nch * 8;
        *(f32x4*)o = (f32x4){h[0], h[1], h[2], h[3]}; *(f32x4*)(o + 4) = (f32x4){h[4], h[5], h[6], h[7]};
    }
}

constexpr int P6_C = 0, P6_B = 34816, P6_PITCH = 272, P6_X = 69632, P6_X_PITCH = 192, P6_X_WAVE = 32 * 192, P6_ACS = P6_X + 8 * P6_X_WAVE, P6_DT = P6_ACS + 4096, P6_SSQ = P6_DT + 4096;
static_assert(P6_SSQ + 4096 <= MISC_OFF, "phase 6 LDS map");
__device__ __forceinline__ float half_sum32(float v) {
    v += __shfl_xor(v, 1); v += __shfl_xor(v, 2); v += __shfl_xor(v, 4); v += __shfl_xor(v, 8); v += __shfl_xor(v, 16); return v; }
__device__ __forceinline__ void p6_unit(unsigned char* ws, const float* ssdn, LAS unsigned char* lds, int unit, int tid, int lane, int wave) {
    asm volatile("" : "+v"(tid));
    lane = tid & 63;
    const int g = unit & 3, c = (unit >> 2) & 31, b = unit >> 7; const size_t row0 = (size_t)b * SEQ + (size_t)c * CHUNK;
    const bf16* XC = (const bf16*)(ws + WS_XC); const float* DT = (const float*)(ws + WS_DT); const float* ACS = (const float*)(ws + WS_ACS); const float* par = (const float*)(ws + WS_PAR);
    const bf16* Zb = (const bf16*)(ws + WS_Z); bf16* YS = (bf16*)(ws + WS_YS);
    LAS float* acsT = (LAS float*)(lds + P6_ACS); LAS float* dtT = (LAS float*)(lds + P6_DT); LAS float* ssqT = (LAS float*)(lds + P6_SSQ);
    const int h = lane >> 5, r = lane & 31, hdl = wave, hd = 8 * g + wave;
    __syncthreads();
    v4u craw[4], braw[4], xraw[16];
#pragma unroll
    for (int i = 0; i < 4; ++i) { const int id = tid + 512 * i, l = id >> 4, ch = id & 15;
        craw[i] = *(const GAS v4u*)(XC + (row0 + l) * CONVD + 2560 + 128 * g + 8 * ch); braw[i] = *(const GAS v4u*)(XC + (row0 + l) * CONVD + 2048 + 128 * g + 8 * ch); }
#pragma unroll
    for (int i = 0; i < 16; ++i) { const int id = lane + 64 * i, rr = id >> 3, ch = id & 7; xraw[i] = *(const GAS v4u*)(XC + (row0 + rr) * CONVD + 512 * g + 64 * hdl + 8 * ch); }
    float ta[2], td[2];
#pragma unroll
    for (int i = 0; i < 2; ++i) { const int l = lane + 64 * i; ta[i] = ACS[(row0 + l) * 32 + hd]; td[i] = DT[(row0 + l) * 32 + hd]; }
    const float Dk = par[PAR_DSKIP + hd];
    const float gn0 = ssdn[512 * g + 64 * hdl + r], gn1 = ssdn[512 * g + 64 * hdl + 32 + r];
    const bf16* Hc = (const bf16*)(ws + WS_ST) + ((size_t)(b * NCHUNK + c) * SH + hd) * (SP * SN) + r * SN + 8 * h;
#pragma unroll
    for (int i = 0; i < 4; ++i) { const int id = tid + 512 * i, l = id >> 4, ch = id & 15; *(LAS v4u*)(lds + P6_C + l * P6_PITCH + 16 * ch) = craw[i]; *(LAS v4u*)(lds + P6_B + l * P6_PITCH + 16 * ch) = braw[i]; }
#pragma unroll
    for (int i = 0; i < 2; ++i) { acsT[hdl * 128 + lane + 64 * i] = ta[i]; dtT[hdl * 128 + lane + 64 * i] = td[i]; }
    LAS unsigned char* xb = lds + P6_X + wave * P6_X_WAVE;
    bf16x8 xf[4][2][2];
#pragma unroll
    for (int jb = 0; jb < 4; ++jb) {
#pragma unroll
        for (int i = 0; i < 4; ++i) { const int id = lane + 64 * i, rr = id >> 3, ch = id & 7; *(LAS v4u*)(xb + rr * P6_X_PITCH + 16 * ch) = xraw[4 * jb + i]; }
#pragma unroll
        for (int t = 0; t < 2; ++t)
#pragma unroll
            for (int pt = 0; pt < 2; ++pt) xf[jb][t][pt] = tr_frag(xb, P6_X_PITCH, 16 * t + 4 * h, 16 * t + 8 + 4 * h, 32 * pt, lane);
        asm volatile("s_waitcnt lgkmcnt(0)" ::: "memory");
    }
    __syncthreads();
    const bf16* Zw = Zb + (row0 + (lane >> 3)) * DSSM + 512 * g + 64 * hdl + 8 * (lane & 7);
    v4u zraw[4];
#pragma unroll
    for (int i = 0; i < 4; ++i) zraw[i] = *(const GAS v4u*)(Zw + (size_t)(8 * i) * DSSM);
#pragma unroll 1
    for (int lt = 0; lt < 4; ++lt) {
#pragma unroll
        for (int i = 0; i < 4; ++i) *(LAS v4u*)(xb + (8 * i + (lane >> 3)) * P6_X_PITCH + 16 * (lane & 7)) = zraw[i];
        if (lt < 3) {
#pragma unroll
            for (int i = 0; i < 4; ++i) zraw[i] = *(const GAS v4u*)(Zw + (size_t)(32 * (lt + 1) + 8 * i) * DSSM); }
        f32x16 acc[2]; acc[0] = (f32x16){}; acc[1] = (f32x16){};
        { bf16x8 hf[8], hg[8];
#pragma unroll
          for (int i = 0; i < 8; ++i) { hf[i] = *(const bf16x8*)(Hc + 16 * i); hg[i] = *(const bf16x8*)(Hc + 32 * SN + 16 * i); }
          bf16x8 cfr[8];
#pragma unroll
          for (int ks = 0; ks < 8; ++ks) cfr[ks] = *(LAS const bf16x8*)(lds + P6_C + (32 * lt + r) * P6_PITCH + (16 * ks + 8 * h) * 2);
          __builtin_amdgcn_sched_barrier(0);
#pragma unroll
          for (int ks = 0; ks < 8; ++ks) { acc[0] = mfma32(cfr[ks], hf[ks], acc[0]); acc[1] = mfma32(cfr[ks], hg[ks], acc[1]); }
          __builtin_amdgcn_sched_barrier(0); }
#pragma unroll
        for (int a = 0; a < 4; ++a) { const f32x4 av = *(LAS const f32x4*)(acsT + hdl * 128 + 32 * lt + 8 * a + 4 * h);
#pragma unroll
            for (int k = 0; k < 4; ++k) { const float ea = exp_fast(av[k]); acc[0][4 * a + k] *= ea; acc[1][4 * a + k] *= ea; } }
        const float al = acsT[hdl * 128 + 32 * lt + r];
#pragma unroll
        for (int jb = 0; jb < 4; ++jb) if (jb <= lt) {
            f32x16 X = (f32x16){};
            { bf16x8 bfr[8], cfr[8];
#pragma unroll
              for (int ks = 0; ks < 8; ++ks) { bfr[ks] = *(LAS const bf16x8*)(lds + P6_B + (32 * jb + r) * P6_PITCH + (16 * ks + 8 * h) * 2); cfr[ks] = *(LAS const bf16x8*)(lds + P6_C + (32 * lt + r) * P6_PITCH + (16 * ks + 8 * h) * 2); }
              __builtin_amdgcn_sched_barrier(0);
#pragma unroll
              for (int ks = 0; ks < 8; ++ks) X = mfma32(bfr[ks], cfr[ks], X);
              __builtin_amdgcn_sched_barrier(0); }
            unsigned gp[8];
#pragma unroll
            for (int a = 0; a < 4; ++a) { const f32x4 av = *(LAS const f32x4*)(acsT + hdl * 128 + 32 * jb + 8 * a + 4 * h), dv = *(LAS const f32x4*)(dtT + hdl * 128 + 32 * jb + 8 * a + 4 * h);
                float v[4];
#pragma unroll
                for (int k = 0; k < 4; ++k) { const int sl = 8 * a + 4 * h + k;
                    float gv = X[4 * a + k] * exp_fast(fminf(al - av[k], 0.f)) * dv[k];
                    if (jb == lt) { gv = (sl <= r) ? gv : 0.f; if (sl == r) gv += Dk; }
                    v[k] = gv; }
                gp[2 * a] = pk2(v[0], v[1]); gp[2 * a + 1] = pk2(v[2], v[3]); }
            const bf16x8 g0 = __builtin_bit_cast(bf16x8, (v4u){gp[0], gp[1], gp[2], gp[3]}), g1 = __builtin_bit_cast(bf16x8, (v4u){gp[4], gp[5], gp[6], gp[7]});
#pragma unroll
            for (int pt = 0; pt < 2; ++pt) { acc[pt] = mfma32(g0, xf[jb][0][pt], acc[pt]); acc[pt] = mfma32(g1, xf[jb][1][pt], acc[pt]); }
            __builtin_amdgcn_sched_barrier(0);
        }
        { const int i15 = lane & 15, qq = i15 >> 2, pp = i15 & 3, g16 = (lane >> 4) & 1;
#pragma unroll
          for (int a = 0; a < 4; ++a) { s16x4 zv[2];
#pragma unroll
              for (int pt = 0; pt < 2; ++pt) zv[pt] = ds_tr(xb + (8 * a + 4 * h + qq) * P6_X_PITCH + (32 * pt + 16 * g16 + 4 * pp) * 2);
#pragma unroll
              for (int k = 0; k < 4; ++k) { const int q = 4 * a + k, l = 32 * lt + crow(q, h);
                  const float y0 = acc[0][q] * silu1(__uint_as_float((unsigned)(unsigned short)zv[0][k] << 16)), y1 = acc[1][q] * silu1(__uint_as_float((unsigned)(unsigned short)zv[1][k] << 16)); acc[0][q] = y0; acc[1][q] = y1;
                  const float ss = half_sum32(y0 * y0 + y1 * y1); if (r == 0) ssqT[l * 8 + hdl] = ss; } } }
        __syncthreads();
#pragma unroll
        for (int q = 0; q < 16; ++q) { const int ll = crow(q, h), l = 32 * lt + ll;
            const f32x4 sa = *(LAS const f32x4*)(ssqT + l * 8), sb = *(LAS const f32x4*)(ssqT + l * 8 + 4);
            const float rs = rsqrtf(((sa[0] + sa[1]) + (sa[2] + sa[3]) + (sb[0] + sb[1]) + (sb[2] + sb[3])) * (1.f / 512.f) + 1e-6f);
            *(LAS bf16*)(xb + ll * 144 + r * 2) = (bf16)f2bf(acc[0][q] * rs * gn0); *(LAS bf16*)(xb + ll * 144 + (32 + r) * 2) = (bf16)f2bf(acc[1][q] * rs * gn1); }
#pragma unroll
        for (int i = 0; i < 4; ++i) { const int l2 = 8 * i + (lane >> 3), ch = lane & 7;
            *(GAS v4u*)(YS + (row0 + 32 * lt + l2) * DSSM + 512 * g + 64 * hdl + 8 * ch) = *(LAS const v4u*)(xb + l2 * 144 + 16 * ch); }
    }
}
__device__ __forceinline__ void ptot_item(unsigned char* ws, const float* clogf, const int* ptab, int item, int lane) {
    asm volatile("" : "+v"(lane));
    const int b = item >> 7, pg = item & 127; const int pid = ptab[b * NPAGES + pg];
    const float* src = clogf + (size_t)pid * PAGE * AH; const int h = lane & 15, rg = lane >> 4; float s = 0.f;
#pragma unroll
    for (int i = 0; i < 32; ++i) s += src[(32 * rg + i) * AH + h];
    s += __shfl_xor(s, 16); s += __shfl_xor(s, 32);
    if (lane < 16) ((float*)(ws + WS_PTOT))[(size_t)item * AH + h] = s;
}
__device__ __forceinline__ void cpl_item(unsigned char* ws, const float* clogf, const int* ptab, int item, int lane) {
    asm volatile("" : "+v"(lane));
    const int b = item >> 7, pg = item & 127; const int pid = ptab[b * NPAGES + pg];
    const float* src = clogf + (size_t)pid * PAGE * AH; const float* ptot = (const float*)(ws + WS_PTOT) + (size_t)b * NPAGES * AH;
    const int h = lane & 15, rg = lane >> 4; float off = 0.f;
#pragma unroll 8
    for (int p = rg; p < pg; p += 4) off += ptot[p * AH + h];
    off += __shfl_xor(off, 16); off += __shfl_xor(off, 32);
    float v[32], s = 0.f;
#pragma unroll
    for (int i = 0; i < 32; ++i) { s += src[(32 * rg + i) * AH + h]; v[i] = s; }
    const float t0 = __shfl(s, h), t1 = __shfl(s, 16 + h), t2 = __shfl(s, 32 + h);
    off += (rg > 0 ? t0 : 0.f) + (rg > 1 ? t1 : 0.f) + (rg > 2 ? t2 : 0.f);
    float* dst = (float*)(ws + WS_CPL) + ((size_t)b * PAST + (size_t)pg * PAGE) * AH;
#pragma unroll
    for (int i = 0; i < 32; ++i) dst[(32 * rg + i) * AH + h] = (off + v[i]) * 1.4426950408889634f;
}
__device__ __forceinline__ void ck_item(unsigned char* ws, int item, int lane) {
    asm volatile("" : "+v"(lane));
    const int h = item & 15, b = item >> 4;
    const float* LOGF = (const float*)(ws + WS_LOGF) + ((size_t)b * SEQ + 64 * lane) * AH + h; float* CK = (float*)(ws + WS_CK) + ((size_t)b * AH + h) * SEQ + 64 * lane;
    float v[64], s = 0.f;
#pragma unroll
    for (int i = 0; i < 64; ++i) v[i] = LOGF[(size_t)i * AH];
#pragma unroll
    for (int i = 0; i < 64; ++i) { s += v[i]; v[i] = s; }
    const float off = wave_scan_incl(s, lane) - s;
#pragma unroll
    for (int i = 0; i < 64; i += 4) *(f32x4*)(CK + i) = (f32x4){(off + v[i]) * 1.4426950408889634f, (off + v[i + 1]) * 1.4426950408889634f, (off + v[i + 2]) * 1.4426950408889634f, (off + v[i + 3]) * 1.4426950408889634f};
}
#include <hip/hip_bf16.h>
#include <cmath>
namespace attn_body {
using bf16=__hip_bfloat16;
using bf16x8=__attribute__((ext_vector_type(8)))short;
using s16x4=__attribute__((ext_vector_type(4)))short;
using f32x16=__attribute__((ext_vector_type(16)))float;
using u32x4=__attribute__((ext_vector_type(4)))unsigned;
constexpr int BATCH=4,NHEAD=16,SEQ=4096,D=64,DM=NHEAD*D,KP=256;
constexpr int NW=8,QBLK=32,QB=QBLK*NW,KVBLK=64,NQB=SEQ/QB;
constexpr int ATTN_PITCH=DM, ATTN_UNIT_ROWS=QB;
__device__ __forceinline__ int crow(int r,int hi){return (r&3)+8*(r>>2)+4*hi;}
#define SBAR() __builtin_amdgcn_sched_barrier(0)
__device__ __forceinline__ void cmask(f32x16&p0,f32x16&p1,int jb,int qrel,int hi){
  const float NEG=-INFINITY; int kb=64*jb+4*hi;
  #pragma unroll
  for(int r=0;r<16;++r){int kv=kb+(r&3)+8*(r>>2); if(kv>qrel)p0[r]=NEG; if(kv+32>qrel)p1[r]=NEG;}
}

constexpr int NSLOT=3, SLOTB=8192;
constexpr int LDS_K=0, LDS_V=NSLOT*SLOTB, LDS_WS=2*NSLOT*SLOTB, LDS_OST=LDS_WS+NW*64*4, LDS_CK=LDS_OST+NW*4096, LDS_BYTES=LDS_CK+SEQ*4;
constexpr float C2=0.125f*1.4426950408889634f;
__device__ __forceinline__ void glds16(const void*gsrc,unsigned lds_dst){unsigned keep;
  asm volatile("s_mov_b32 %0, m0\n\ts_mov_b32 m0, %2\n\ts_nop 0\n\tglobal_load_lds_dwordx4 %1, off\n\ts_mov_b32 m0, %0":"=&s"(keep):"v"(gsrc),"s"(lds_dst):"memory");}
__device__ __forceinline__ float max3f(float a,float b,float c){float r;asm("v_max3_f32 %0, %1, %2, %3":"=v"(r):"v"(a),"v"(b),"v"(c));return r;}
__device__ __forceinline__ float max2f(float a,float b){float r;asm("v_max_f32_e32 %0, %1, %2":"=v"(r):"v"(a),"v"(b));return r;}
__device__ __forceinline__ float fadd_s(float a,float b){float r;asm("v_add_f32_e32 %0, %1, %2":"=v"(r):"v"(a),"v"(b));return r;}
__device__ __forceinline__ float fsub_s(float a,float b){float r;asm("v_sub_f32_e32 %0, %1, %2":"=v"(r):"v"(a),"v"(b));return r;}
typedef float f32x2_t __attribute__((ext_vector_type(2))); typedef float f32x4_t __attribute__((ext_vector_type(4))); typedef __bf16 bf16x2_t __attribute__((ext_vector_type(2)));
__device__ __forceinline__ unsigned cvtpk_s(float lo,float hi){f32x2_t v={lo,hi};bf16x2_t b=__builtin_convertvector(v,bf16x2_t);return __builtin_bit_cast(unsigned,b);}
#define WAIT_BAR(N) asm volatile("s_waitcnt vmcnt(" #N ") lgkmcnt(0)\n\ts_barrier":::"memory")

__device__ __forceinline__ void qkt(f32x16&p0,f32x16&p1,const char*Kslot,const bf16x8*qr,int r32,int hi){
  const char*kb=Kslot+hi*1024+r32*16;
  #pragma unroll
  for(int d0=0;d0<4;++d0){
    const bf16x8 b0=*reinterpret_cast<const bf16x8*>(kb+d0*2048);
    const bf16x8 b1=*reinterpret_cast<const bf16x8*>(kb+d0*2048+512);
    {p0=__builtin_amdgcn_mfma_f32_32x32x16_bf16(b0,qr[d0],p0,0,0,0);p1=__builtin_amdgcn_mfma_f32_32x32x16_bf16(b1,qr[d0],p1,0,0,0);}}
}
typedef __attribute__((address_space(3))) char* lds_cptr;
typedef short v4i16_t __attribute__((ext_vector_type(4)));
__device__ __forceinline__ void kload8(bf16x8*kf,lds_cptr kp){
  kf[0]=*(const __attribute__((address_space(3))) bf16x8*)(kp);      kf[1]=*(const __attribute__((address_space(3))) bf16x8*)(kp+512);
  kf[2]=*(const __attribute__((address_space(3))) bf16x8*)(kp+2048); kf[3]=*(const __attribute__((address_space(3))) bf16x8*)(kp+2560);
  kf[4]=*(const __attribute__((address_space(3))) bf16x8*)(kp+4096); kf[5]=*(const __attribute__((address_space(3))) bf16x8*)(kp+4608);
  kf[6]=*(const __attribute__((address_space(3))) bf16x8*)(kp+6144); kf[7]=*(const __attribute__((address_space(3))) bf16x8*)(kp+6656);
}
__device__ __forceinline__ void kload2(bf16x8*kf,lds_cptr kp,int j){ kf[2*j]=*(const __attribute__((address_space(3))) bf16x8*)(kp+j*2048); kf[2*j+1]=*(const __attribute__((address_space(3))) bf16x8*)(kp+j*2048+512); }
__device__ __forceinline__ s16x4 vtr(lds_cptr p){ return __builtin_bit_cast(s16x4,__builtin_amdgcn_ds_read_tr16_b64_v4i16((__attribute__((address_space(3))) v4i16_t*)p)); }
__device__ __forceinline__ float rowmax(const f32x16&p0,const f32x16&p1){
  float a=max3f(p0[0],p0[1],p1[0]),b=max3f(p0[2],p0[3],p1[1]);a=max3f(a,p1[2],p1[3]);
  #pragma unroll
  for(int r=4;r<16;r+=4){a=max3f(a,p0[r],p0[r+1]);b=max3f(b,p0[r+2],p0[r+3]);a=max3f(a,p1[r],p1[r+1]);b=max3f(b,p1[r+2],p1[r+3]);}
  const float m=max2f(a,b);
  auto rr=__builtin_amdgcn_permlane32_swap(__float_as_uint(m),__float_as_uint(m),false,false);
  return max2f(__uint_as_float(rr[0]),__uint_as_float(rr[1]));
}
__device__ __forceinline__ void pv(f32x16*o,int vb,bf16x8 pa0,bf16x8 pa1,bf16x8 pa2,bf16x8 pa3){
  #pragma unroll
  for(int d0=0;d0<2;++d0){s16x4 lo[4],hi[4];
    #pragma unroll
    for(int ks=0;ks<4;++ks){
      asm volatile("ds_read_b64_tr_b16 %0,%1 offset:%c2":"=&v"(lo[ks]):"v"(vb),"i"(d0*4096+ks*1024):"memory");
      asm volatile("ds_read_b64_tr_b16 %0,%1 offset:%c2":"=&v"(hi[ks]):"v"(vb),"i"(d0*4096+ks*1024+512):"memory");}
    asm volatile("s_waitcnt lgkmcnt(0)":::"memory");SBAR();
    #define PK(k) (bf16x8){lo[k][0],lo[k][1],lo[k][2],lo[k][3],hi[k][0],hi[k][1],hi[k][2],hi[k][3]}
    o[d0]=__builtin_amdgcn_mfma_f32_32x32x16_bf16(pa0,PK(0),o[d0],0,0,0);
    o[d0]=__builtin_amdgcn_mfma_f32_32x32x16_bf16(pa1,PK(1),o[d0],0,0,0);
    o[d0]=__builtin_amdgcn_mfma_f32_32x32x16_bf16(pa2,PK(2),o[d0],0,0,0);
    o[d0]=__builtin_amdgcn_mfma_f32_32x32x16_bf16(pa3,PK(3),o[d0],0,0,0);
    #undef PK
  }
}

#ifndef ATTN_STORE16
#define ATTN_STORE16(p,v) (*(u32x4*)(p)=(v))
#endif
template<int THRL> __device__ __forceinline__ void attn_unit(int b,int h,int qb,const bf16*Q,const bf16*__restrict__ K,const bf16*__restrict__ V,bf16*O,const float*__restrict__ CKT,float skip_thr,char*shm){
  int tid_=threadIdx.x; asm volatile("":"+v"(tid_));
  const int tid=tid_,lane=tid&63,r32=lane&31,hi=lane>>5; const int wid=__builtin_amdgcn_readfirstlane(tid>>6);
  const long rowbase=(long)b*SEQ; const int q0=qb*QB;
  const bf16*Qw=Q+(rowbase+q0+wid*QBLK)*DM+h*D;
  const bf16*Kh=K+rowbase*KP+(h>>2)*D,*Vh=V+rowbase*KP+(h>>2)*D;
  const unsigned lds0=(unsigned)(uintptr_t)shm;
  float*wsf=(float*)(shm+LDS_WS)+wid*64;
  const bf16*ksrc=Kh+(long)lane*KP+wid*8;
  const bf16*vsrc=Vh+(long)(16*(wid&3)+(lane>>2))*KP+(wid>>2)*32+(lane&3)*8;
  const unsigned kdst=lds0+LDS_K+wid*1024, vdst=lds0+LDS_V+wid*1024;
  #define DMA_K(t,slot) glds16(ksrc+(long)((t)+t0)*KVBLK*KP,(unsigned)__builtin_amdgcn_readfirstlane(kdst+(slot)))
  #define DMA_V(t,slot) glds16(vsrc+(long)((t)+t0)*KVBLK*KP,(unsigned)__builtin_amdgcn_readfirstlane(vdst+(slot)))
  const int vb0=(int)(lds0+LDS_V)+((lane>>4)&1)*32+(lane&3)*8+(4*hi+((lane&15)>>2))*64;
  const char*Kbase=shm+LDS_K; bf16x8 kf[8];
  const lds_cptr shm3=(lds_cptr)shm; const lds_cptr kp0=shm3+LDS_K+hi*1024+r32*16; const lds_cptr vp0=shm3+LDS_V+((lane>>4)&1)*32+(lane&3)*8+(4*hi+((lane&15)>>2))*64;
  int NT=(q0+QB)/KVBLK;
  { __attribute__((address_space(3))) float*ckt=(__attribute__((address_space(3))) float*)(shm3+LDS_CK); const float*src=CKT+((long)b*NHEAD+h)*SEQ; for(int i=tid;i<q0+QB;i+=NW*64)ckt[i]=-src[i]; }
  asm volatile("s_waitcnt lgkmcnt(0)\n\ts_barrier":::"memory");
  int t0=0; { const __attribute__((address_space(3))) float*ck0=(const __attribute__((address_space(3))) float*)(shm3+LDS_CK); const float cq=ck0[q0];
    int lo=0,hi=NT-4;
    while(lo<hi){ const int mid=(lo+hi)>>1; if(cq-ck0[64*mid+63]>skip_thr)lo=mid+1; else hi=mid; }
    t0=lo&~1; }
  NT-=t0;
  const __attribute__((address_space(3))) float*ckt3=(const __attribute__((address_space(3))) float*)(shm3+LDS_CK)+64*t0;
  #define LDBIAS(C0,C1,t) do{ const __attribute__((address_space(3))) float*cp_=ckt3+64*(t)+4*hi; \
    _Pragma("unroll") for(int a_=0;a_<4;++a_){ const f32x4_t v0_=*(const __attribute__((address_space(3))) f32x4_t*)(cp_+8*a_), v1_=*(const __attribute__((address_space(3))) f32x4_t*)(cp_+32+8*a_); \
      _Pragma("unroll") for(int b_=0;b_<4;++b_){ C0[4*a_+b_]=v0_[b_]; C1[4*a_+b_]=v1_[b_]; } } }while(0)
  DMA_K(0,0);DMA_V(0,0);DMA_K(1,SLOTB);
  bf16x8 qr[4];
  #pragma unroll
  for(int d0=0;d0<4;++d0)qr[d0]=*reinterpret_cast<const bf16x8*>(&Qw[(long)r32*DM+d0*16+hi*8]);
  float mhat=0.f,l_reg=0.f;f32x16 o[2];o[0]=f32x16{};o[1]=f32x16{};
  const int qrel=wid*QBLK+r32;
  #define CMASK(P0,P1,t) do{int jb_=(t)-(NT-4); if(jb_>=0)cmask(P0,P1,jb_,qrel,hi);}while(0)
  bool resc=false;
  #define START(P0,P1) do{ const float rm=rowmax(P0,P1); resc=false; \
    { const float dl=rm; mhat=fadd_s(mhat,dl); \
      _Pragma("unroll") for(int r=0;r<16;++r){P0[r]=fsub_s(P0[r],dl);P1[r]=fsub_s(P1[r],dl);} \
      } \
    _Pragma("unroll") for(int r=0;r<16;++r)P0[r]=__builtin_amdgcn_exp2f(P0[r]); }while(0)
  #define RESC() do{ if(resc){ asm volatile("s_waitcnt lgkmcnt(0)":::"memory"); \
      _Pragma("unroll") for(int d_=0;d_<2;++d_) _Pragma("unroll") for(int r=0;r<16;++r)o[d_][r]*=wsf[crow(r,hi)]; } }while(0)
  f32x16 pA0,pA1,pB0,pB1;
  int sl_prev=0,sl_cur=0,sl_next=SLOTB;
  #define ROT() do{sl_prev=sl_cur;sl_cur=sl_next;sl_next=(sl_next==(NSLOT-1)*SLOTB)?0:sl_next+SLOTB;}while(0)
  DMA_K(2,2*SLOTB);
  WAIT_BAR(3);
  LDBIAS(pA0,pA1,0); qkt(pA0,pA1,Kbase,qr,r32,hi);asm volatile("s_nop 15\n\ts_nop 7":"+v"(pA0),"+v"(pA1));CMASK(pA0,pA1,0);
  START(pA0,pA1);
  _Pragma("unroll") for(int r=0;r<16;++r)pA1[r]=__builtin_amdgcn_exp2f(pA1[r]);
  LDBIAS(pB0,pB1,1);
  WAIT_BAR(0);
  DMA_K(3,0);DMA_V(1,SLOTB);
  ROT();
  kload8(kf,kp0+sl_cur);
  WAIT_BAR(2);
  s16x4 vlo[8],vhi[8]; u32x4 pw0,pw1,pw2,pw3;
  #define PKW(P,B) cvtpk_s(P[B],P[B+1])
  #define PAF(k) __builtin_bit_cast(bf16x8,pw##k)
  #define VFR(i) (bf16x8){vlo[i][0],vlo[i][1],vlo[i][2],vlo[i][3],vhi[i][0],vhi[i][1],vhi[i][2],vhi[i][3]}
  #define PIN(x) asm volatile("":"+v"(x))
  #define MX3(a,b,c) __builtin_fmaxf(__builtin_fmaxf((a),(b)),(c))
  #define GAPA(MF,A0,A1,A2,A3,W0,W1,PW) do{ MF; sacc+=A0; sacc+=A1; sacc+=A2; sacc+=A3; PIN(sacc); W0; W1; PIN(PW); SBAR(); }while(0)
  #define EX(v) __builtin_amdgcn_exp2f(v)
  #define GAPB(MF,X,B) do{ MF; X[B]=EX(X[B]-mh_); X[B+1]=EX(X[B+1]-mh_); X[B+2]=EX(X[B+2]-mh_); X[B+3]=EX(X[B+3]-mh_); PIN(X); SBAR(); }while(0)
  #define VRD(i) do{ vlo[i]=vtr(vp_+(((i)>>2)*4096+((i)&3)*1024)); vhi[i]=vtr(vp_+(((i)>>2)*4096+((i)&3)*1024+512)); }while(0)
  #define KRD(G,j) do{ if(G){ kload2(kf,kp0+sl_next,j); SBAR(); } }while(0)
  #define STEP(C0,C1,P0,P1,t,GK,GV,GL) do{ SBAR(); \
    const lds_cptr vp_=vp0+sl_prev; \
    VRD(0); SBAR(); float sacc=(P0[0]+P0[1]); \
    GAPA(C0=__builtin_amdgcn_mfma_f32_32x32x16_bf16(kf[0],qr[0],C0,0,0,0), P0[2],P0[3],P0[4],P0[5],     pw0[0]=PKW(P0,0), pw0[1]=PKW(P0,2), pw0); \
    VRD(4); SBAR(); GAPA(C1=__builtin_amdgcn_mfma_f32_32x32x16_bf16(kf[1],qr[0],C1,0,0,0), P0[6],P0[7],P0[8],P0[9],     pw0[2]=PKW(P0,4), pw0[3]=PKW(P0,6), pw0); \
    VRD(1); SBAR(); GAPA(C0=__builtin_amdgcn_mfma_f32_32x32x16_bf16(kf[2],qr[1],C0,0,0,0),   P0[10],P0[11],P0[12],P0[13], pw1[0]=PKW(P0,8), pw1[1]=PKW(P0,10), pw1); \
    VRD(5); SBAR(); GAPA(C1=__builtin_amdgcn_mfma_f32_32x32x16_bf16(kf[3],qr[1],C1,0,0,0),   P0[14],P0[15],P1[0],P1[1],   pw1[2]=PKW(P0,12),pw1[3]=PKW(P0,14), pw1); \
    VRD(2); SBAR(); GAPA(C0=__builtin_amdgcn_mfma_f32_32x32x16_bf16(kf[4],qr[2],C0,0,0,0),   P1[2],P1[3],P1[4],P1[5],     pw2[0]=PKW(P1,0), pw2[1]=PKW(P1,2), pw2); \
    VRD(6); SBAR(); GAPA(C1=__builtin_amdgcn_mfma_f32_32x32x16_bf16(kf[5],qr[2],C1,0,0,0),   P1[6],P1[7],P1[8],P1[9],     pw2[2]=PKW(P1,4), pw2[3]=PKW(P1,6), pw2); \
    VRD(3); SBAR(); GAPA(C0=__builtin_amdgcn_mfma_f32_32x32x16_bf16(kf[6],qr[3],C0,0,0,0),   P1[10],P1[11],P1[12],P1[13], pw3[0]=PKW(P1,8), pw3[1]=PKW(P1,10), pw3); \
    VRD(7); SBAR(); GAPA(C1=__builtin_amdgcn_mfma_f32_32x32x16_bf16(kf[7],qr[3],C1,0,0,0),   P1[14],P1[15],0.f,0.f,       pw3[2]=PKW(P1,12),pw3[3]=PKW(P1,14), pw3); \
    l_reg+=sacc; \
    if(GK){DMA_K((t)+3,sl_cur);} if(GV){DMA_V((t)+1,sl_next);} \
    CMASK(C0,C1,t); \
    { float a=MX3(C0[0],C0[1],C1[0]),b=MX3(C0[2],C0[3],C1[1]); a=MX3(a,C1[2],C1[3]); \
      _Pragma("unroll") for(int r=4;r<16;r+=4){a=MX3(a,C0[r],C0[r+1]);b=MX3(b,C0[r+2],C0[r+3]);a=MX3(a,C1[r],C1[r+1]);b=MX3(b,C1[r+2],C1[r+3]);} \
      float rm=__builtin_fmaxf(a,b); { auto rr=__builtin_amdgcn_permlane32_swap(__float_as_uint(rm),__float_as_uint(rm),false,false); rm=__builtin_fmaxf(__uint_as_float(rr[0]),__uint_as_float(rr[1])); } \
      resc=false; \
      rm-=mhat; \
      if(__builtin_expect(__any(rm>(float)THRL),0)){ const float dl=__builtin_fmaxf(rm,0.f); mhat+=dl; \
        const float f=__builtin_amdgcn_exp2f(-dl); l_reg*=f; if(hi==0)wsf[r32]=f; resc=true; } } \
    const float mh_=mhat; if(GL){ LDBIAS(P0,P1,(t)+1); } SBAR(); \
    GAPB(o[0]=__builtin_amdgcn_mfma_f32_32x32x16_bf16(PAF(0),VFR(0),o[0],0,0,0), C0,0); \
    GAPB(o[1]=__builtin_amdgcn_mfma_f32_32x32x16_bf16(PAF(0),VFR(4),o[1],0,0,0), C0,4); \
    KRD(GL,0); GAPB(o[0]=__builtin_amdgcn_mfma_f32_32x32x16_bf16(PAF(1),VFR(1),o[0],0,0,0), C0,8); \
    KRD(GL,1); GAPB(o[1]=__builtin_amdgcn_mfma_f32_32x32x16_bf16(PAF(1),VFR(5),o[1],0,0,0), C0,12); \
    KRD(GL,2); GAPB(o[0]=__builtin_amdgcn_mfma_f32_32x32x16_bf16(PAF(2),VFR(2),o[0],0,0,0), C1,0); \
    KRD(GL,3); GAPB(o[1]=__builtin_amdgcn_mfma_f32_32x32x16_bf16(PAF(2),VFR(6),o[1],0,0,0), C1,4); \
    GAPB(o[0]=__builtin_amdgcn_mfma_f32_32x32x16_bf16(PAF(3),VFR(3),o[0],0,0,0), C1,8); \
    GAPB(o[1]=__builtin_amdgcn_mfma_f32_32x32x16_bf16(PAF(3),VFR(7),o[1],0,0,0), C1,12); \
    }while(0)
  int t=1;
  #undef CMASK
  #define CMASK(P0,P1,t) do{}while(0)
  for(;t+5<NT;t+=2){
    STEP(pB0,pB1,pA0,pA1,t,true,true,true);     WAIT_BAR(2); RESC(); ROT();
    STEP(pA0,pA1,pB0,pB1,t+1,true,true,true);   WAIT_BAR(2); RESC(); ROT();
  }
  #undef CMASK
  #define CMASK(P0,P1,t) do{int jb_=(t)-(NT-4); if(jb_>=0)cmask(P0,P1,jb_,qrel,hi);}while(0)
  #define ENDW(tt) do{ if((tt)+3<NT){WAIT_BAR(2);} else if((tt)+2<NT){WAIT_BAR(1);} else {WAIT_BAR(0);} }while(0)
  for(;t+1<NT;t+=2){
    STEP(pB0,pB1,pA0,pA1,t,(t+3<NT),(t+1<NT),(t+1<NT));       ENDW(t);   RESC(); ROT();
    STEP(pA0,pA1,pB0,pB1,t+1,(t+4<NT),(t+2<NT),(t+2<NT));     ENDW(t+1); RESC(); ROT();
  }
  STEP(pB0,pB1,pA0,pA1,NT-1,false,false,false); RESC();
  { float sacc=pB0[0]+pB0[1]; _Pragma("unroll") for(int r=2;r<16;++r)sacc+=pB0[r]; _Pragma("unroll") for(int r=0;r<16;++r)sacc+=pB1[r]; l_reg+=sacc;
    pw0=(u32x4){PKW(pB0,0),PKW(pB0,2),PKW(pB0,4),PKW(pB0,6)};pw1=(u32x4){PKW(pB0,8),PKW(pB0,10),PKW(pB0,12),PKW(pB0,14)};pw2=(u32x4){PKW(pB1,0),PKW(pB1,2),PKW(pB1,4),PKW(pB1,6)};pw3=(u32x4){PKW(pB1,8),PKW(pB1,10),PKW(pB1,12),PKW(pB1,14)};
    SBAR(); pv(o,vb0+sl_cur,PAF(0),PAF(1),PAF(2),PAF(3)); }
  #undef PKW
  #undef PAF
  #undef VFR
  #undef PIN
  #undef MX3
  #undef GAPA
  #undef GAPB
  #undef EX
  #undef VRD
  #undef KRD
  #undef STEP
  #undef ENDW
  {auto rr=__builtin_amdgcn_permlane32_swap(__float_as_uint(l_reg),__float_as_uint(l_reg),false,false);l_reg=__uint_as_float(rr[0])+__uint_as_float(rr[1]);}
  if(hi==0)wsf[32+r32]=l_reg;asm volatile("s_waitcnt lgkmcnt(0)":::"memory");
  float rli[16];
  #pragma unroll
  for(int r=0;r<16;++r)rli[r]=__builtin_amdgcn_rcpf(wsf[32+crow(r,hi)]);
  bf16*Ow=O+(rowbase+q0+wid*QBLK)*DM+h*D;
  { bf16*stg=(bf16*)(shm+LDS_OST)+wid*2048;
    #pragma unroll
    for(int r=0;r<16;++r){const int orow=crow(r,hi);
      #pragma unroll
      for(int d0=0;d0<2;++d0)stg[orow*64+d0*32+r32]=__float2bfloat16(o[d0][r]*rli[r]);}
    asm volatile("s_waitcnt lgkmcnt(0)":::"memory");
    #pragma unroll
    for(int i=0;i<4;++i){const int row=i*8+(lane>>3),ch=lane&7; const u32x4 v=*(const u32x4*)(stg+row*64+ch*8); ATTN_STORE16(Ow+(long)row*DM+ch*8,v);} }
  asm volatile("s_waitcnt lgkmcnt(0)\n\ts_barrier":::"memory");
  #undef DMA_K
  #undef DMA_V
  #undef CMASK
  #undef START
  #undef RESC
  #undef ROT
}
constexpr int ATTN_LDS_BYTES=LDS_BYTES;
struct AttnTensors { const bf16* Q; const bf16* K; const bf16* V; bf16* O; const float* CKT; };
template<int THRL=8> __device__ __forceinline__ void attn_phase(char*lds,const AttnTensors&T,float skip_thr,int vcu,int G,int i_lo,int i_hi){
  for(int cl=vcu;cl<BATCH*NHEAD*4;cl+=G){ const int s=cl&3,bh=cl>>2;
    #pragma unroll 1
    for(int i=i_lo;i<i_hi;++i){ const int qb=(i==0)?s:(i==1)?7-s:(i==2)?8+s:15-s; attn_unit<THRL>(bh/NHEAD,bh%NHEAD,qb,T.Q,T.K,T.V,T.O,T.CKT,skip_thr,lds); } }
}
#undef SBAR
#undef WAIT_BAR
}
constexpr int DK_OFF = 0, DK_PITCH = 144, DK_HEAD = 64 * 144, DV_OFF = 4 * DK_HEAD, DV_PITCH = 192, DV_HEAD = 64 * 192, DC_OFF = DV_OFF + 4 * DV_HEAD, DW_OFF = DC_OFF + 4096;
constexpr int DPART_STRIDE = 32 + 32 + 32 * 64;
static_assert(DW_OFF + 2048 <= MISC_OFF, "decode LDS map");
__device__ __forceinline__ void dec_unit(unsigned char* ws, const float* ck, const float* cv, const int* ptab, LAS unsigned char* lds, int unit, int tid, int lane, int wave) {
    asm volatile("" : "+v"(tid));
    lane = tid & 63;
    const int b = unit & 31, sp = unit >> 5; const int kvh = wave >> 1, kh = wave & 1, h = lane >> 5, r = lane & 31, g = r >> 3, qi = r & 7, hq = 4 * kvh + g;
    const int tile0 = sp < 4 ? 35 * sp : (sp == 4 ? 140 : (sp == 5 ? 176 : (sp == 6 ? 212 : 238))), ntile = sp < 4 ? 35 : (sp < 6 ? 36 : (sp == 6 ? 26 : 18));
    const bf16* Qb = (const bf16*)(ws + WS_Q); const float* CPL = (const float*)(ws + WS_CPL) + ((size_t)b * PAST + (size_t)tile0 * 64) * AH;
    bf16x8 qf[4];
#pragma unroll
    for (int ks = 0; ks < 4; ++ks) qf[ks] = *(const bf16x8*)(Qb + ((size_t)MP + 8 * b + qi) * 1024 + hq * 64 + 16 * ks + 8 * h);
    float m;
    { const bf16* Kb = (const bf16*)(ws + WS_K) + ((size_t)MP + 8 * b + qi) * 256 + kvh * 64; const bf16* Qr = Qb + ((size_t)MP + 8 * b + qi) * 1024 + hq * 64; float d = 0.f;
#pragma unroll
      for (int k = 0; k < 8; ++k) { float qa[8], ka[8]; unpk8(*(const GAS v4u*)(Qr + 8 * k), qa); unpk8(*(const GAS v4u*)(Kb + 8 * k), ka);
#pragma unroll
          for (int e = 0; e < 8; ++e) d += qa[e] * ka[e]; }
      const float* LOGF = (const float*)(ws + WS_LOGF) + ((size_t)MP + 8 * b) * AH + hq; float cum = ((const float*)(ws + WS_CPL))[((size_t)b * PAST + PAST - 1) * AH + hq];
      for (int k = 0; k <= qi; ++k) cum += LOGF[k * AH] * 1.4426950408889634f;
      m = d - cum; }
    float l = 0.f; f32x16 o[2]; o[0] = (f32x16){}; o[1] = (f32x16){};
    LAS float* wsf = (LAS float*)(lds + DW_OFF) + wave * 64; LAS unsigned* flg = (LAS unsigned*)(lds + DW_OFF + 2048 - 16);
    f32x4 kr[8], vr[8], cr;
    __syncthreads();
    if (tid == 0) { flg[0] = 0u; flg[1] = 0u; }
    { const int ta = tile0 + ntile - 1; const int pid = ptab[b * NPAGES + (ta >> 1)]; const float* kb = ck + ((size_t)pid * PAGE + 64 * (ta & 1)) * 256;
#pragma unroll
      for (int i = 0; i < 8; ++i) kr[i] = *(const GAS f32x4*)(kb + 4 * (tid + 512 * i));
      if (tid < 256) cr = *(const GAS f32x4*)(CPL + (size_t)(ntile - 1) * 64 * AH + 4 * tid); }
    bool vhave = false;
#pragma unroll 1
    for (int tt = ntile - 1; tt >= 0; --tt) {
#pragma unroll
        for (int i = 0; i < 8; ++i) { const int idx = tid + 512 * i, tok = idx >> 6, w = idx & 63, hh = w >> 4, d = (w & 15) * 4;
            *(LAS v2u*)(lds + DK_OFF + hh * DK_HEAD + tok * DK_PITCH + d * 2) = (v2u){pk2(kr[i][0], kr[i][1]), pk2(kr[i][2], kr[i][3])}; }
        if (vhave) {
#pragma unroll
            for (int i = 0; i < 8; ++i) { const int idx = tid + 512 * i, tok = idx >> 6, w = idx & 63, hh = w >> 4, d = (w & 15) * 4;
                *(LAS v2u*)(lds + DV_OFF + hh * DV_HEAD + tok * DV_PITCH + d * 2) = (v2u){pk2(vr[i][0], vr[i][1]), pk2(vr[i][2], vr[i][3])}; } }
        if (tid < 256) *(LAS f32x4*)(lds + DC_OFF + 16 * tid) = cr;
        if (tid == 0) flg[(tt + 1) & 1] = 0u;
        __syncthreads();
        if (tt > 0) { const int t1 = tt - 1, ta = tile0 + t1; const int pid = ptab[b * NPAGES + (ta >> 1)]; const float* kb = ck + ((size_t)pid * PAGE + 64 * (ta & 1)) * 256;
#pragma unroll
            for (int i = 0; i < 8; ++i) kr[i] = *(const GAS f32x4*)(kb + 4 * (tid + 512 * i));
            if (tid < 256) cr = *(const GAS f32x4*)(CPL + (size_t)t1 * 64 * AH + 4 * tid); }
        f32x16 s; const LAS float* cp = (const LAS float*)(lds + DC_OFF);
#pragma unroll
        for (int q = 0; q < 16; ++q) s[q] = -cp[(32 * kh + crow(q, h)) * AH + hq];
#pragma unroll
        for (int ks = 0; ks < 4; ++ks) { const bf16x8 kf = *(LAS const bf16x8*)(lds + DK_OFF + kvh * DK_HEAD + (32 * kh + r) * DK_PITCH + (16 * ks + 8 * h) * 2); s = mfma32(kf, qf[ks], s); }
        float tm = s[0];
#pragma unroll
        for (int q = 1; q < 16; ++q) tm = fmaxf(tm, s[q]);
        { auto rr = __builtin_amdgcn_permlane32_swap(__float_as_uint(tm), __float_as_uint(tm), false, false); tm = fmaxf(__uint_as_float(rr[0]), __uint_as_float(rr[1])); }
        const bool need = __any(tm - m >= -152.f);
        if (need && lane == 0) flg[tt & 1] = 1u;
        __syncthreads();
        const bool need_any = (flg[tt & 1] != 0u);
        if (need_any) {
            if (!vhave) {
                const int ta = tile0 + tt; const int pid = ptab[b * NPAGES + (ta >> 1)]; const float* vb = cv + ((size_t)pid * PAGE + 64 * (ta & 1)) * 256;
#pragma unroll
                for (int i = 0; i < 8; ++i) vr[i] = *(const GAS f32x4*)(vb + 4 * (tid + 512 * i));
#pragma unroll
                for (int i = 0; i < 8; ++i) { const int idx = tid + 512 * i, tok = idx >> 6, w = idx & 63, hh = w >> 4, d = (w & 15) * 4;
                    *(LAS v2u*)(lds + DV_OFF + hh * DV_HEAD + tok * DV_PITCH + d * 2) = (v2u){pk2(vr[i][0], vr[i][1]), pk2(vr[i][2], vr[i][3])}; }
                __syncthreads();
            }
            if (tt > 0) { const int ta = tile0 + tt - 1; const int pid = ptab[b * NPAGES + (ta >> 1)]; const float* vb = cv + ((size_t)pid * PAGE + 64 * (ta & 1)) * 256;
#pragma unroll
                for (int i = 0; i < 8; ++i) vr[i] = *(const GAS f32x4*)(vb + 4 * (tid + 512 * i)); }
            if (need) {
                const float mn = fmaxf(m, tm), alpha = __builtin_amdgcn_exp2f(m - mn); m = mn;
                float ps = 0.f;
#pragma unroll
                for (int q = 0; q < 16; ++q) { s[q] = __builtin_amdgcn_exp2f(s[q] - mn); ps += s[q]; }
                l = l * alpha + ps;
                if (h == 0) wsf[r] = alpha;
                unsigned pp[8];
#pragma unroll
                for (int q = 0; q < 16; q += 2) pp[q >> 1] = pk2(s[q], s[q + 1]);
                const bf16x8 p0 = __builtin_bit_cast(bf16x8, (v4u){pp[0], pp[1], pp[2], pp[3]}), p1 = __builtin_bit_cast(bf16x8, (v4u){pp[4], pp[5], pp[6], pp[7]});
#pragma unroll
                for (int q = 0; q < 16; ++q) { const float a = wsf[crow(q, h)]; o[0][q] *= a; o[1][q] *= a; }
                LAS const unsigned char* vt = lds + DV_OFF + kvh * DV_HEAD;
#pragma unroll
                for (int dt = 0; dt < 2; ++dt) { const bf16x8 v0 = tr_frag(vt, DV_PITCH, 32 * kh + 4 * h, 32 * kh + 8 + 4 * h, 32 * dt, lane), v1 = tr_frag(vt, DV_PITCH, 32 * kh + 16 + 4 * h, 32 * kh + 24 + 4 * h, 32 * dt, lane);
                    o[dt] = mfma32(p0, v0, o[dt]); o[dt] = mfma32(p1, v1, o[dt]); }
            }
        }
        vhave = need_any && tt > 0;
        __syncthreads();
    }
    { auto rr = __builtin_amdgcn_permlane32_swap(__float_as_uint(l), __float_as_uint(l), false, false); l = __uint_as_float(rr[0]) + __uint_as_float(rr[1]); }
    float* part = (float*)(ws + WS_DPART) + ((size_t)(b * KVH + kvh) * 16 + 2 * sp + kh) * DPART_STRIDE;
    if (h == 0) { part[r] = m; part[32 + r] = l; }
#pragma unroll
    for (int dt = 0; dt < 2; ++dt)
#pragma unroll
        for (int q = 0; q < 16; ++q) part[64 + crow(q, h) * 64 + 32 * dt + r] = o[dt][q];
}

__device__ __forceinline__ void dec_combine(unsigned char* ws, int unit, int tid) {
    asm volatile("" : "+v"(tid));
    const int b = unit >> 2, kvh = unit & 3, j = tid >> 4, dq = tid & 15, g = j >> 3, qi = j & 7, hq = 4 * kvh + g;
    const bf16* Qb = (const bf16*)(ws + WS_Q); const bf16* Kb = (const bf16*)(ws + WS_K); const bf16* Vb = (const bf16*)(ws + WS_V); bf16* YA = (bf16*)(ws + WS_YA);
    const float* LOGF = (const float*)(ws + WS_LOGF); const float* CPL = (const float*)(ws + WS_CPL);
    const float* part = (const float*)(ws + WS_DPART) + (size_t)(b * KVH + kvh) * 16 * DPART_STRIDE;
    const size_t rq = (size_t)MP + 8 * b + qi;
    const v2u qw = *(const GAS v2u*)(Qb + rq * 1024 + hq * 64 + 4 * dq); const float q0 = bflo(qw.x), q1 = bfhi(qw.x), q2 = bflo(qw.y), q3 = bfhi(qw.y);
    float sn[8]; float cum = CPL[((size_t)b * PAST + PAST - 1) * AH + hq];
#pragma unroll
    for (int jj = 0; jj < 8; ++jj) { const size_t rk = (size_t)MP + 8 * b + jj; cum += LOGF[rk * AH + hq] * 1.4426950408889634f;
        const v2u kw = *(const GAS v2u*)(Kb + rk * 256 + kvh * 64 + 4 * dq); float d = q0 * bflo(kw.x) + q1 * bfhi(kw.x) + q2 * bflo(kw.y) + q3 * bfhi(kw.y);
        d += __shfl_xor(d, 1); d += __shfl_xor(d, 2); d += __shfl_xor(d, 4); d += __shfl_xor(d, 8);
        sn[jj] = (jj <= qi) ? d - cum : -1e30f; }
    float mp[16], M = -1e30f;
#pragma unroll
    for (int n = 0; n < 16; ++n) { mp[n] = part[(size_t)n * DPART_STRIDE + j]; M = fmaxf(M, mp[n]); }
#pragma unroll
    for (int jj = 0; jj < 8; ++jj) M = fmaxf(M, sn[jj]);
    float L = 0.f; f32x4 O = (f32x4){0.f, 0.f, 0.f, 0.f};
#pragma unroll
    for (int n = 0; n < 16; ++n) { const float w = __builtin_amdgcn_exp2f(mp[n] - M); L += w * part[(size_t)n * DPART_STRIDE + 32 + j];
        O += *(const f32x4*)(part + (size_t)n * DPART_STRIDE + 64 + j * 64 + 4 * dq) * w; }
#pragma unroll
    for (int jj = 0; jj < 8; ++jj) { const float w = __builtin_amdgcn_exp2f(sn[jj] - M); L += w; const size_t rk = (size_t)MP + 8 * b + jj;
        const v2u vw = *(const GAS v2u*)(Vb + rk * 256 + kvh * 64 + 4 * dq); O += (f32x4){bflo(vw.x), bfhi(vw.x), bflo(vw.y), bfhi(vw.y)} * w; }
    const float il = 1.f / L;
    *(GAS v2u*)(YA + rq * 1024 + hq * 64 + 4 * dq) = (v2u){pk2(O[0] * il, O[1] * il), pk2(O[2] * il, O[3] * il)};
}
template <bool OUT8 = false> struct SResidT {
    const float* resF; const bf16* resB; float* outF; bf16* outB; pg8::ssq_t* ssq; float alpha;
    __device__ __forceinline__ void operator()(int row, int col, f32x4 v, int t) const {
        f32x4 rr; if (resF) rr = *(const f32x4*)(resF + (size_t)row * 1024 + col); else { const v2u w = *(const GAS v2u*)(resB + (size_t)row * 1024 + col); rr = (f32x4){bflo(w.x), bfhi(w.x), bflo(w.y), bfhi(w.y)}; }
        const f32x4 o = rr + v * alpha;
        if (outF) *(f32x4*)(outF + (size_t)row * 1024 + col) = o;
        if (outB) *(GAS v2u*)(outB + (size_t)row * 1024 + col) = (v2u){pk2(o[0], o[1]), pk2(o[2], o[3])};
        if constexpr (OUT8) { int w = 0; const f32x4 q = o * pg8::H2_F8_SCALE; w = __builtin_amdgcn_cvt_pk_fp8_f32(__builtin_amdgcn_fmed3f(q[0], -448.f, 448.f), __builtin_amdgcn_fmed3f(q[1], -448.f, 448.f), w, false);
            w = __builtin_amdgcn_cvt_pk_fp8_f32(__builtin_amdgcn_fmed3f(q[2], -448.f, 448.f), __builtin_amdgcn_fmed3f(q[3], -448.f, 448.f), w, true);
            *(GAS unsigned*)((unsigned char*)outB + ((WS_H2F8 + (size_t)MP * 1024) - (WS_XB + (size_t)MP * 2048)) + (size_t)row * 1024 + col) = (unsigned)w; }
        if (ssq) { float s = (o[0] * o[0] + o[1] * o[1]) + (o[2] * o[2] + o[3] * o[3]); s += __shfl_xor(s, 1); s += __shfl_xor(s, 2); s += __shfl_xor(s, 4);
            if ((t & 7) == 0) __hip_atomic_fetch_add(ssq + row, pg8::ssq_fx(s), __ATOMIC_RELAXED, __HIP_MEMORY_SCOPE_AGENT); } }
};
using SResid = SResidT<false>;
struct SGateMul { const bf16* G; bf16* MPo;
    __device__ __forceinline__ void operator()(int row, int col, f32x4 v, int) const { const v2u g = *(const GAS v2u*)(G + (size_t)row * 1024 + col);
        const f32x4 o = (f32x4){bflo(g.x), bfhi(g.x), bflo(g.y), bfhi(g.y)} * v; *(GAS v2u*)(MPo + (size_t)row * 1024 + col) = (v2u){pk2(o[0], o[1]), pk2(o[2], o[3])}; } };
struct SGateAdd { const bf16* G; const bf16* MPi; bf16* O;
    __device__ __forceinline__ void operator()(int row, int col, f32x4 v, int) const { const v2u g = *(const GAS v2u*)(G + (size_t)row * 1024 + col), m = *(const GAS v2u*)(MPi + (size_t)row * 1024 + col);
        const f32x4 o = (f32x4){bflo(m.x), bfhi(m.x), bflo(m.y), bfhi(m.y)} + (f32x4){bflo(g.x), bfhi(g.x), bflo(g.y), bfhi(g.y)} * v;
        *(GAS v2u*)(O + (size_t)row * 1024 + col) = (v2u){pk2(o[0], o[1]), pk2(o[2], o[3])}; } };
template <int K, class Epi> __device__ __forceinline__ void smallm_phase(const bf16* A, const bf16* Bt, LAS unsigned char* lds, const Epi& E, int G) {
    int tid = threadIdx.x; asm volatile("" : "+v"(tid));
    const int lane = tid & 63, wave = __builtin_amdgcn_readfirstlane(tid >> 6), r = lane & 31, h = lane >> 5;
    constexpr int KW = K / 8, NS = KW / 16;
    LAS float* red = (LAS float*)lds;
    for (int tile = (int)blockIdx.x; tile < 256; tile += G) {
        const int tm = tile >> 5, tn = tile & 31;
        const bf16* ap = A + (size_t)(32 * tm + r) * K + wave * KW + 8 * h; const bf16* bp = Bt + (size_t)(32 * tn + r) * K + wave * KW + 8 * h;
        f32x16 acc = (f32x16){};
        constexpr int UN = (NS % 11 == 0) ? 11 : 8;
#pragma unroll 1
        for (int k0 = 0; k0 < NS; k0 += UN) { bf16x8 a[UN], b[UN];
#pragma unroll
            for (int k = 0; k < UN; ++k) { a[k] = *(const bf16x8*)(ap + 16 * (k0 + k)); b[k] = *(const bf16x8*)(bp + 16 * (k0 + k)); }
#pragma unroll
            for (int k = 0; k < UN; ++k) acc = mfma32(a[k], b[k], acc); }
        __syncthreads();
#pragma unroll
        for (int q = 0; q < 16; ++q) red[(wave * 32 + crow(q, h)) * 33 + r] = acc[q];
        __syncthreads();
        if (tid < 256) { const int row = tid >> 3, c4 = (tid & 7) * 4; f32x4 v = (f32x4){0.f, 0.f, 0.f, 0.f};
#pragma unroll
            for (int w = 0; w < 8; ++w) { const LAS float* p = red + (w * 32 + row) * 33 + c4; v += (f32x4){p[0], p[1], p[2], p[3]}; }
            E(32 * tm + row, 32 * tn + c4, v, tid); }
    }
    __syncthreads();
}
constexpr int NPHASE = 11;
struct Args { const float* in[30]; const int* page_table; float* out; unsigned char* ws; int ph_lo, ph_hi; };
static_assert(sizeof(Args) == 30 * 8 + 8 + 8 + 8 + 8, "Args has no padding bytes");
enum { I_XP = 0, I_XS, I_CK, I_CV, I_CLF, I_SSM, I_SCONV, I_PT, I_F1N, I_F1G, I_F1U, I_F1D, I_MIXN, I_WIN, I_CONVW, I_CONVB, I_DTB, I_ALOG, I_DSKIP, I_SSDN, I_QN, I_KN, I_BF,
       I_WSP, I_WAP, I_WO, I_F2N, I_F2G, I_F2U, I_F2D };

__global__ void __launch_bounds__(NWAVES * 64, 2) mega_fwd(Args args) {
    extern __shared__ __attribute__((aligned(16))) unsigned char lds_raw[];
    LAS unsigned char* lds = (LAS unsigned char*)lds_raw;
    volatile LAS unsigned* MISC = (volatile LAS unsigned*)(lds + MISC_OFF);
    const int tid = threadIdx.x, lane = tid & 63, wave = __builtin_amdgcn_readfirstlane(tid >> 6);
    const int G = gridDim.x; const int vcu = (G % 8 == 0) ? ((int)blockIdx.x % 8) * (G / 8) + (int)blockIdx.x / 8 : (int)blockIdx.x;
    unsigned char* ws = args.ws; float* dout = args.out;
    gu32* ctl = (gu32*)(ws + WS_CTL);
    for (int u = tid; u < 64; u += NWAVES * 64) MISC[u] = 0u;
    __syncthreads();
    XcdBarrier bar = xcd_barrier_post((unsigned*)ctl + CW_BAR, MISC + 8);
    const int lo = args.ph_lo, hi = args.ph_hi;
#define IN(k) (lo <= (k) && (k) < hi)
#define SEAM(k) do { if (IN(k) && IN((k) + 1)) xcd_barrier(bar); } while (0)
    const int gw = vcu * NWAVES + wave, NGW = G * NWAVES;
    pg8::ssq_t* ssqX = (pg8::ssq_t*)(ws + WS_SSQX); pg8::ssq_t* ssqH = (pg8::ssq_t*)(ws + WS_CTL + CTL_SSQH); pg8::ssq_t* ssqH2 = (pg8::ssq_t*)(ws + WS_CTL + CTL_SSQH2);
    bf16 *Wgu1 = (bf16*)(ws + WS_WGU1), *Wd1 = (bf16*)(ws + WS_WD1), *Win = (bf16*)(ws + WS_WIN), *Wsp = (bf16*)(ws + WS_WSP), *Wap = (bf16*)(ws + WS_WAP), *Wo = (bf16*)(ws + WS_WO),
         *Wgu2 = (bf16*)(ws + WS_WGU2), *Wd2 = (bf16*)(ws + WS_WD2);
    bf16 *XB = (bf16*)(ws + WS_XB), *ACT = (bf16*)(ws + WS_ACT), *HB = (bf16*)(ws + WS_HB), *Zb = (bf16*)(ws + WS_Z), *XBC = (bf16*)(ws + WS_XBC), *Qb = (bf16*)(ws + WS_Q), *Kb = (bf16*)(ws + WS_K),
         *Vb = (bf16*)(ws + WS_V), *GSb = (bf16*)(ws + WS_GS), *GAb = (bf16*)(ws + WS_GA);
    float *DTf = (float*)(ws + WS_DT), *LOGFf = (float*)(ws + WS_LOGF);

    constexpr int I_GU = (5632 / 64) * (1024 / 64), I_D = (1024 / 64) * (2816 / 64), I_W = (NWIN / 64) * (1024 / 64), I_SP = (1024 / 64) * (2048 / 64), I_SQ = (1024 / 64) * (1024 / 64);
    constexpr int T_GU1 = I_GU, T_D1 = T_GU1 + I_D, T_WIN = T_D1 + I_W, T_SP = T_WIN + I_SP, T_AP = T_SP + I_SQ, T_WO = T_AP + I_SQ, T_GU2 = T_WO + I_GU, T_END = T_GU2 + I_D;
#define TRANSPOSE_RANGE(LO, HI, IDX, NIDX) do { LAS float* scr = (LAS float*)(lds + RING_OFF + wave * 16640);     \
        for (int it = (LO) + (IDX); it < (HI); it += (NIDX)) { int r = it; \
            if (r < T_GU1) { if ((r % 88) & 2) p0_transpose_item(MapGU{args.in[I_F1U]}, args.in[I_F1N], 1024, Wgu1, scr, r / 88, r % 88, lane); else p0_transpose_item(MapGU{args.in[I_F1G]}, args.in[I_F1N], 1024, Wgu1, scr, r / 88, r % 88, lane); continue; } r -= T_GU1; \
            if (r < I_D) { p0_transpose_item(MapPlain{args.in[I_F1D], 1024}, nullptr, 2816, Wd1, scr, r / 16, r % 16, lane); continue; } r -= I_D; \
            if (r < I_W) { p0_transpose_item(MapWin{args.in[I_WIN]}, args.in[I_MIXN], 1024, Win, scr, r / 140, r % 140, lane); continue; } r -= I_W; \
            if (r < I_SP) { p0_transpose_item(MapPlain{args.in[I_WSP], 1024}, nullptr, 2048, Wsp, scr, r / 16, r % 16, lane); continue; } r -= I_SP; \
            if (r < I_SQ) { p0_transpose_item(MapPlain{args.in[I_WAP], 1024}, nullptr, 1024, Wap, scr, r / 16, r % 16, lane); continue; } r -= I_SQ; \
            if (r < I_SQ) { p0_transpose_item(MapPlain{args.in[I_WO], 1024}, nullptr, 1024, Wo, scr, r / 16, r % 16, lane); continue; } r -= I_SQ; \
            if (r < I_GU) { if ((r % 88) & 2) p0_transpose_item(MapGU{args.in[I_F2U]}, args.in[I_F2N], 1024, (bf16*)nullptr, scr, r / 88, r % 88, lane, ws + WS_WGU2F8, pg8::WGU_F8_SCALE); else p0_transpose_item(MapGU{args.in[I_F2G]}, args.in[I_F2N], 1024, (bf16*)nullptr, scr, r / 88, r % 88, lane, ws + WS_WGU2F8, pg8::WGU_F8_SCALE); continue; } r -= I_GU; \
            p0_transpose_item(MapPlain{args.in[I_F2D], 1024}, nullptr, 2816, Wd2, scr, r / 16, r % 16, lane, ws + WS_WD2F8, pg8::WD_F8_SCALE); } } while (0)
    if (IN(0)) {
        if (G == 256) { TRANSPOSE_RANGE(0, T_GU1, gw, NGW); } else { TRANSPOSE_RANGE(0, T_END, gw, NGW); }
        for (int m = 2 * gw; m < MT; m += 2 * NGW) { const float* xr = (m < MP) ? args.in[I_XP] + (size_t)m * 1024 : args.in[I_XS] + (size_t)(m - MP) * 1024; p0_rows_to_bf16(xr, XB + (size_t)m * 1024, ssqX + m, lane); }
        if (blockIdx.x == 0 && tid < 256) { float* par = (float*)(ws + WS_PAR); float v;
            if (tid < 64) v = args.in[I_QN][tid]; else if (tid < 128) v = args.in[I_KN][tid - 64]; else if (tid < 160) v = args.in[I_DTB][tid - 128]; else if (tid < 176) v = args.in[I_BF][tid - 160];
            else if (tid < 192) v = 0.f; else if (tid < 224) v = args.in[I_ALOG][tid - 192]; else v = args.in[I_DSKIP][tid - 224];
            par[tid] = v; }
        if (G != 256) { for (int it = gw; it < DECB * NPAGES; it += NGW) ptot_item(ws, args.in[I_CLF], args.page_table, it, lane); }
    }
    SEAM(0);
    if (IN(1)) {
        if (G == 256 && blockIdx.x >= 150) { TRANSPOSE_RANGE(T_GU1, T_WIN, ((int)blockIdx.x - 150) * NWAVES + wave, 106 * NWAVES);
            for (int it = ((int)blockIdx.x - 150) * NWAVES + wave; it < DECB * NPAGES; it += 106 * NWAVES) ptot_item(ws, args.in[I_CLF], args.page_table, it, lane);
            __syncthreads(); }
        pg8::Gemm g{XB, Wgu1, MT, 5632, 1024}; pg8::StaticOrder S; S.init(MT, 5632, G, (int)blockIdx.x);
        pg8::EpiSwiglu E{ACT, ssqX, 1.f};
        pg8::gemm_phase<pg8::EpiSwiglu, pg8::StaticOrder, true, true>(lds + RING_OFF, g, S, E);
    }
    SEAM(1);
    if (IN(2)) {
        pg8::Gemm g{ACT, Wd1, MP, 1024, DFF}; pg8::StaticOrder S; S.init(MP, 1024, G, (int)blockIdx.x);
        pg8::EpiResid E{args.in[I_XP], nullptr, nullptr, HB, ssqH, 0.5f};
        pg8::gemm_phase<pg8::EpiResid, pg8::StaticOrder, true, true>(lds + RING_OFF, g, S, E);
        smallm_phase<DFF>(ACT + (size_t)MP * DFF, Wd1, lds, SResid{args.in[I_XS], nullptr, nullptr, HB + (size_t)MP * 1024, ssqH + MP, 0.5f}, G);
    }
    SEAM(2);
    if (IN(3)) {
        if (G == 256 && ((blockIdx.x >> 3) & 1)) { TRANSPOSE_RANGE(T_WIN, T_END, ((int)blockIdx.x >> 4) * 8 * NWAVES + ((int)blockIdx.x & 7) * NWAVES + wave, 128 * NWAVES); __syncthreads(); }
        pg8::Gemm g{HB, Win, MT, NWIN, 1024}; pg8::StaticOrder S; S.init(MT, NWIN, G, (int)blockIdx.x);
        pg8::EpiWin E{ws, dout};
        pg8::gemm_phase<pg8::EpiWin, pg8::StaticOrder, true, true>(lds + RING_OFF, g, S, E);
    }
    SEAM(3);
    if (IN(4)) {
        { LAS unsigned char* wl = lds + wave * P4S_WAVE;
          if (NGW == 2048) { const int half = vcu * 4 + (wave >> 1);
              if ((wave & 1) == 0) p4s_item(ws, dout, args.in[I_CONVW], args.in[I_CONVB], args.in[I_SCONV], args.in[I_SSM], wl, half, lane);
              else if (half < NBATCH * AH) ck_item(ws, half, lane);
          } else {
              for (int it = gw; it < NBATCH * AH; it += NGW) ck_item(ws, it, lane);
              for (int it = gw; it < DECB * SH; it += NGW) p4s_item(ws, dout, args.in[I_CONVW], args.in[I_CONVB], args.in[I_SCONV], args.in[I_SSM], wl, it, lane);
          }
          for (int it = gw; it < DECB * NPAGES; it += NGW) cpl_item(ws, args.in[I_CLF], args.page_table, it, lane); }
        for (int i = (int)blockIdx.x * 512 + tid; i < NBATCH * 3 * CONVD; i += G * 512) { const int bb = i / (3 * CONVD), rem = i % (3 * CONVD), j = rem / CONVD, col = rem % CONVD;
            dout[O_CONVP + i] = __uint_as_float((unsigned)XBC[((size_t)bb * SEQ + SEQ - 3 + j) * CONVD + col] << 16); }
        for (int u = (int)blockIdx.x; u < 512; u += G) p4_unit(ws, args.in[I_CONVW], args.in[I_CONVB], lds, u, tid, lane, wave);
        __syncthreads();
    }
    SEAM(4);
    if (IN(5)) {
        for (int it = gw; it < MS * SG; it += NGW) p4s_norm_item(ws, args.in[I_SSDN], it, lane);
        p5_scan(ws, dout, (int)blockIdx.x * 512 + tid, G * 512);
        const attn_body::AttnTensors AT{(const attn_body::bf16*)Qb, (const attn_body::bf16*)Kb, (const attn_body::bf16*)Vb, (attn_body::bf16*)(ws + WS_YA), (const float*)(ws + WS_CK)};
        const float skip_thr = 153.f + 2.f * sqrtf(__uint_as_float(__hip_atomic_load((unsigned*)ctl + CW_QMAX2, RLX_AGENT)) * __uint_as_float(__hip_atomic_load((unsigned*)ctl + CW_KMAX2, RLX_AGENT))) * 1.0001f;
        const int nbefore = ((blockIdx.x >> 3) & 1) ? 0 : 4;
        attn_body::attn_phase<8>((char*)lds_raw, AT, skip_thr, vcu, G, 0, nbefore);
        __syncthreads();
        for (int u = (int)blockIdx.x; u < DECB * 8; u += G) dec_unit(ws, args.in[I_CK], args.in[I_CV], args.page_table, lds, u, tid, lane, wave);
        __syncthreads();
        attn_body::attn_phase<8>((char*)lds_raw, AT, skip_thr, vcu, G, nbefore, 4);
    }
    SEAM(5);
    if (IN(6)) { for (int u = (int)blockIdx.x; u < DECB * KVH; u += G) dec_combine(ws, u, tid);
        for (int u = (int)blockIdx.x; u < 512; u += G) p6_unit(ws, args.in[I_SSDN], lds, u, tid, lane, wave); __syncthreads(); }
    SEAM(6);
    if (IN(7)) {
        { pg8::Gemm g{(const bf16*)(ws + WS_YS), Wsp, MP, 1024, DSSM}; pg8::StaticOrder S; S.init(MP, 1024, G, (int)blockIdx.x);
          pg8::EpiGateMul E{GSb, (bf16*)(ws + WS_MP)};
          pg8::gemm_phase<pg8::EpiGateMul, pg8::StaticOrder, true, true>(lds + RING_OFF, g, S, E); }
        { pg8::Gemm g{(const bf16*)(ws + WS_YA), Wap, MP, 1024, 1024}; pg8::StaticOrder S; S.init(MP, 1024, G, (int)blockIdx.x);
          pg8::EpiGateAdd E{GAb, (const bf16*)(ws + WS_MP), (bf16*)(ws + WS_MG)};
          pg8::gemm_phase<pg8::EpiGateAdd, pg8::StaticOrder, true, true>(lds + RING_OFF, g, S, E); }
        smallm_phase<DSSM>((const bf16*)(ws + WS_YS) + (size_t)MP * DSSM, Wsp, lds, SGateMul{GSb + (size_t)MP * 1024, (bf16*)(ws + WS_MP) + (size_t)MP * 1024}, G);
        smallm_phase<1024>((const bf16*)(ws + WS_YA) + (size_t)MP * 1024, Wap, lds, SGateAdd{GAb + (size_t)MP * 1024, (const bf16*)(ws + WS_MP) + (size_t)MP * 1024, (bf16*)(ws + WS_MG) + (size_t)MP * 1024}, G);
    }
    SEAM(7);
    if (IN(8)) {
        pg8::Gemm g{(const bf16*)(ws + WS_MG), Wo, MP, 1024, 1024}; pg8::StaticOrder S; S.init(MP, 1024, G, (int)blockIdx.x);
        pg8::EpiResidT<false, true> E{nullptr, HB, nullptr, XB, ssqH2, 1.0f};
        pg8::gemm_phase<pg8::EpiResidT<false, true>, pg8::StaticOrder, true, true>(lds + RING_OFF, g, S, E);
        smallm_phase<1024>((const bf16*)(ws + WS_MG) + (size_t)MP * 1024, Wo, lds, SResidT<true>{nullptr, HB + (size_t)MP * 1024, nullptr, XB + (size_t)MP * 1024, ssqH2 + MP, 1.0f}, G);
    }
    SEAM(8);
    if (IN(9)) {
        pg8::Gemm g{(const bf16*)(ws + WS_H2F8), (const bf16*)(ws + WS_WGU2F8), MT, 5632, 512}; pg8::StaticOrder S; S.init(MT, 5632, G, (int)blockIdx.x);
        pg8::EpiSwigluT<true, true> E{ACT, ssqH2, 1.f / (pg8::H2_F8_SCALE * pg8::WGU_F8_SCALE)};
        pg8::gemm_phase<pg8::EpiSwigluT<true, true>, pg8::StaticOrder, true, true>(lds + RING_OFF, g, S, E);
    }
    SEAM(9);
    if (IN(10)) {
        pg8::Gemm g{ACT, (const bf16*)(ws + WS_WD2F8), MP, 1024, DFF / 2}; pg8::StaticOrder S; S.init(MP, 1024, G, (int)blockIdx.x);
        pg8::EpiResidT<true> E{nullptr, XB, dout, nullptr, nullptr, 0.5f / (pg8::ACT_F8_SCALE * pg8::WD_F8_SCALE)};
        pg8::gemm_phase<pg8::EpiResidT<true>, pg8::StaticOrder, true, true>(lds + RING_OFF, g, S, E);
        smallm_phase<DFF>(ACT + (size_t)MP * DFF, Wd2, lds, SResid{nullptr, XB + (size_t)MP * 1024, dout + (size_t)MP * 1024, nullptr, nullptr, 0.5f}, G);
    }
#undef IN
#undef SEAM
}

extern "C" void kernel_launch(void* const* d_in, const int* in_sizes, int n_in, void* d_out, int out_size, void* d_ws, size_t ws_size, hipStream_t stream) {
    static int grid = 0;
    if (grid == 0) {
        if (n_in != 30 || (size_t)out_size != O_END || ws_size < WS_END) { fprintf(stderr, "kernel_launch: unexpected problem (n_in %d, out %d, ws %zu)\n", n_in, out_size, ws_size); grid = -1; return; }
        int dev = 0, cus = 0, per_cu = 0;
        if (hipGetDevice(&dev) != hipSuccess || hipDeviceGetAttribute(&cus, hipDeviceAttributeMultiprocessorCount, dev) != hipSuccess) { grid = -1; return; }
        if (hipFuncSetAttribute((const void*)mega_fwd, hipFuncAttributeMaxDynamicSharedMemorySize, LDS_BYTES) != hipSuccess) { fprintf(stderr, "kernel_launch: hipFuncSetAttribute failed\n"); grid = -1; return; }
        if (hipOccupancyMaxActiveBlocksPerMultiprocessor(&per_cu, (const void*)mega_fwd, NWAVES * 64, LDS_BYTES) != hipSuccess || per_cu < 1) { fprintf(stderr, "kernel_launch: occupancy query reports %d\n", per_cu); }
        (void)hipGetLastError();
        grid = cus;
    }
    if (grid < 0) return;
    if (hipMemsetAsync((char*)d_ws + WS_CTL, 0, CTL_ZERO_BYTES, stream) != hipSuccess) return;
    Args a{};
    for (int i = 0; i < 30; ++i) a.in[i] = (const float*)d_in[i];
    a.page_table = (const int*)d_in[I_PT]; a.out = (float*)d_out; a.ws = (unsigned char*)d_ws; a.ph_lo = 0; a.ph_hi = NPHASE;
    hipLaunchKernelGGL(mega_fwd, dim3(grid), dim3(NWAVES * 64), LDS_BYTES, stream, a);
}
```

```cpp
#include <hip/hip_runtime.h>
#include <cstdio>
#include <cstdint>
constexpr int NWAVES = 8;
constexpr int DMODEL = 1024, NBATCH = 4, SEQ = 4096, MP = NBATCH * SEQ, DECB = 32, DECS = 8, MS = DECB * DECS, MT = MP + MS;
constexpr int DFF = 2816, DSSM = 2048, SH = 32, SP = 64, SG = 4, SN = 128, CONVD = 3072, CHUNK = 128, NCHUNK = SEQ / CHUNK;
constexpr int AH = 16, KVH = 4, HD = 64, KVD = 256, INDIM = 8752, NWIN = 35 * 256;
constexpr int PAST = 16384, PAGE = 128, NPAGES = 128;
constexpr size_t O_YP = 0, O_YS = O_YP + (size_t)MP * 1024, O_KP = O_YS + (size_t)MS * 1024, O_VP = O_KP + (size_t)MP * 256, O_LFP = O_VP + (size_t)MP * 256,
    O_SSMP = O_LFP + (size_t)MP * 16, O_CONVP = O_SSMP + (size_t)NBATCH * SH * SP * SN, O_KS = O_CONVP + (size_t)NBATCH * 3 * CONVD, O_VS = O_KS + (size_t)MS * 256,
    O_LFS = O_VS + (size_t)MS * 256, O_SSMS = O_LFS + (size_t)MS * 16, O_CONVS = O_SSMS + (size_t)DECB * SH * SP * SN, O_END = O_CONVS + (size_t)DECB * 3 * CONVD;
static_assert(O_END == 35594240, "d_out map");
constexpr size_t al256(size_t x) { return (x + 255) & ~(size_t)255; }
constexpr size_t WS_CTL = 0, CTL_ZERO_BYTES = 1u << 20;
constexpr int CW_BAR = 4096, CW_Q4 = 8192, CW_QMAX2 = 8256, CW_KMAX2 = 8320;
constexpr size_t CTL_SSQH = 256 * 1024, CTL_SSQH2 = 512 * 1024;
constexpr size_t WS_PAR = al256(WS_CTL + CTL_ZERO_BYTES);
constexpr int PAR_QN = 0, PAR_KN = 64, PAR_DTB = 128, PAR_BF = 160, PAR_ALOG = 192, PAR_DSKIP = 224, PAR_END = 256;
constexpr size_t WS_SSQX = al256(WS_PAR + 4096);
constexpr size_t WS_WGU1 = al256(WS_SSQX + (size_t)MT * 8);
constexpr size_t WS_WD1 = al256(WS_WGU1 + (size_t)5632 * 1024 * 2);
constexpr size_t WS_WIN = al256(WS_WD1 + (size_t)1024 * 2816 * 2);
constexpr size_t WS_WSP = al256(WS_WIN + (size_t)NWIN * 1024 * 2);
constexpr size_t WS_WAP = al256(WS_WSP + (size_t)1024 * 2048 * 2);
constexpr size_t WS_WO = al256(WS_WAP + (size_t)1024 * 1024 * 2);
constexpr size_t WS_WGU2 = al256(WS_WO + (size_t)1024 * 1024 * 2);
constexpr size_t WS_WD2 = al256(WS_WGU2 + (size_t)5632 * 1024 * 2);
constexpr size_t WS_XB = al256(WS_WD2 + (size_t)1024 * 2816 * 2);
constexpr size_t WS_ACT = al256(WS_XB + (size_t)MT * 1024 * 2);
constexpr size_t WS_HB = al256(WS_ACT + (size_t)MT * 2816 * 2);
constexpr size_t WS_Z = al256(WS_HB + (size_t)MT * 1024 * 2);
constexpr size_t WS_XBC = al256(WS_Z + (size_t)MT * 2048 * 2);
constexpr size_t WS_Q = al256(WS_XBC + (size_t)MT * 3072 * 2);
constexpr size_t WS_K = al256(WS_Q + (size_t)MT * 1024 * 2);
constexpr size_t WS_V = al256(WS_K + (size_t)MT * 256 * 2);
constexpr size_t WS_GS = al256(WS_V + (size_t)MT * 256 * 2);
constexpr size_t WS_GA = al256(WS_GS + (size_t)MT * 1024 * 2);
constexpr size_t WS_DT = al256(WS_GA + (size_t)MT * 1024 * 2);
constexpr size_t WS_LOGF = al256(WS_DT + (size_t)MT * 32 * 4);
constexpr size_t WS_XC = al256(WS_LOGF + (size_t)MT * 16 * 4);
constexpr size_t WS_YS = al256(WS_XC + (size_t)MT * 3072 * 2);
constexpr size_t WS_YA = al256(WS_YS + (size_t)MT * 2048 * 2);
constexpr size_t WS_MP = al256(WS_YA + (size_t)MT * 1024 * 2);
constexpr size_t WS_ST = al256(WS_MP + (size_t)MT * 1024 * 4);
constexpr size_t WS_ACS = al256(WS_ST + (size_t)NBATCH * NCHUNK * SH * SP * SN * 2);
constexpr size_t WS_CK = al256(WS_ACS + (size_t)MP * 32 * 4);
constexpr size_t WS_PTOT = al256(WS_CK + (size_t)MP * 16 * 4);
constexpr size_t WS_CPL = al256(WS_PTOT + (size_t)DECB * NPAGES * 16 * 4);
constexpr size_t WS_DPART = al256(WS_CPL + (size_t)DECB * PAST * 16 * 4);
constexpr size_t WS_YRAW = al256(WS_DPART + (size_t)64 * 1024 * 1024);
constexpr size_t WS_MG = al256(WS_YRAW + (size_t)MS * DSSM * 4);
constexpr size_t WS_HS = al256(WS_MG + (size_t)MT * 1024 * 2);
constexpr size_t WS_WD1F8 = al256(WS_HS + (size_t)NBATCH * NCHUNK * SH * SP * SN * 2);
constexpr size_t WS_WD2F8 = al256(WS_WD1F8 + (size_t)1024 * 2816);
constexpr size_t WS_WGU2F8 = al256(WS_WD2F8 + (size_t)1024 * 2816);
constexpr size_t WS_H2F8 = al256(WS_WGU2F8 + (size_t)5632 * 1024);
constexpr size_t WS_END = al256(WS_H2F8 + (size_t)MT * 1024);
constexpr int RING_OFF = 0, RING_BYTES = 131072;
constexpr int LDS_BYTES = 160 * 1024;
constexpr int MISC_OFF = LDS_BYTES - 256;
namespace pg8 {
#define PG8_LAS __attribute__((address_space(3)))
typedef unsigned short bf16_t;
typedef short bf16x8 __attribute__((ext_vector_type(8)));
typedef float f32x4 __attribute__((ext_vector_type(4)));
typedef unsigned u32x4 __attribute__((ext_vector_type(4)));
typedef int v4i __attribute__((ext_vector_type(4)));
typedef unsigned u32x2 __attribute__((ext_vector_type(2)));
typedef int v8i __attribute__((ext_vector_type(8)));
typedef unsigned long long ssq_t;
constexpr float SSQ_ONE = 1048576.f;
__device__ __forceinline__ float ssq_ld(const ssq_t* p, size_t row) { return (float)p[row] * (1.f / SSQ_ONE); }
__device__ __forceinline__ ssq_t ssq_fx(float s) { return (ssq_t)(s * SSQ_ONE + 0.5f); }
template <bool F8> struct FragSel { typedef bf16x8 type; };
template <> struct FragSel<true> { typedef v8i type; };
constexpr int BM = 256, BK = 64, HALF = 128, HTB = HALF * BK * 2  , STAGE_BYTES = 8 * HTB, NXCD = 8, WGM = 8;

__host__ __device__ __forceinline__ int lds_byte(int r, int c) { const int st = (r >> 4) * 2 + (c >> 5), rr = r & 15, cc = c & 31, ob = rr * 64 + cc * 2; return st * 1024 + (ob ^ (((ob >> 9) & 1) << 5)); }
__host__ __device__ __forceinline__ void stage_rc(int b, int& R, int& C) { const int st = b / 1024, sb = b % 1024, swz = sb ^ (((sb >> 9) & 1) << 5); R = (st >> 1) * 16 + swz / 64; C = (st & 1) * 32 + (swz % 64) / 2; }
__host__ __device__ __forceinline__ int perm32(int rho) { const int n = rho >> 4, i = rho & 15; return 8 * (i >> 2) + 4 * n + (i & 3); }

struct Unit { int pm, pn; };
struct Gemm { const bf16_t* A; const bf16_t* Bt; int M, N, K; };

struct StaticOrder {
    int nM, nN, nwg, G, c;
    __host__ __device__ void init(int M, int N, int G_, int c_) { nM = M / BM; nN = N / BM; nwg = nM * nN; G = G_; c = c_; }
    __host__ __device__ bool next(int i, Unit& u) const {
        const long L = (long)i * G + c; if (L >= nwg) return false;
        int wgid = (int)L; { const int q = nwg / NXCD, r = nwg % NXCD, xcd = wgid % NXCD, off = wgid / NXCD; wgid = (xcd < r ? xcd * (q + 1) : r * (q + 1) + (xcd - r) * q) + off; }
        const int nig = WGM * nN, gid = wgid / nig, fm = gid * WGM, gsz = (nM - fm) < WGM ? (nM - fm) : WGM;
        u.pm = fm + ((wgid % nig) % gsz); u.pn = (wgid % nig) / gsz; return true;
    }
    __device__ __forceinline__ void a_ready(const Unit&) const {}
    __device__ __forceinline__ void done(const Unit&) const {}
};

__device__ __forceinline__ unsigned cvt_pk_bf16(float lo, float hi) { unsigned r; asm volatile("v_cvt_pk_bf16_f32 %0, %1, %2" : "=v"(r) : "v"(lo), "v"(hi)); return r; }
typedef float f32x2 __attribute__((ext_vector_type(2)));
constexpr float RMS_EPS_F = 1e-6f;
constexpr float LOG2E_F = 1.4426950408889634f;
constexpr float ATT_C2 = 0.125f * 1.4426950408889634f;
constexpr int MPROMPT = 16384;
__device__ __forceinline__ float sigmoid_f(float x) { return __builtin_amdgcn_rcpf(1.f + __builtin_amdgcn_exp2f(-LOG2E_F * x)); }
__device__ __forceinline__ float silu_f(float x) { return x * sigmoid_f(x); }
__device__ __forceinline__ float softplus_f(float x) { return fmaxf(x, 0.f) + log1pf(expf(-fabsf(x))); }
__device__ __forceinline__ float logsigmoid_f(float x) { return fminf(x, 0.f) - log1pf(expf(-fabsf(x))); }
__device__ __forceinline__ float bf2f(unsigned short b) { return __uint_as_float((unsigned)b << 16); }
__device__ __forceinline__ u32x4 pack8(const f32x4 a, const f32x4 b) { u32x4 w; w.x = cvt_pk_bf16(a[0], a[1]); w.y = cvt_pk_bf16(a[2], a[3]); w.z = cvt_pk_bf16(b[0], b[1]); w.w = cvt_pk_bf16(b[2], b[3]); return w; }
__device__ __forceinline__ void unpack8(const u32x4 w, f32x4& a, f32x4& b) {
    a[0] = __uint_as_float(w.x << 16); a[1] = __uint_as_float(w.x & 0xffff0000u); a[2] = __uint_as_float(w.y << 16); a[3] = __uint_as_float(w.y & 0xffff0000u);
    b[0] = __uint_as_float(w.z << 16); b[1] = __uint_as_float(w.z & 0xffff0000u); b[2] = __uint_as_float(w.w << 16); b[3] = __uint_as_float(w.w & 0xffff0000u); }

__device__ __forceinline__ void cx8(const u32x4 w0, const u32x4 w1, int lane, u32x4& oA, u32x4& oB) {
    const int p = lane & 7, r8 = lane >> 3, srcA = (16 * (p & 3) + r8) * 4, srcB = srcA + 32; const bool hi = p >= 4;
#pragma unroll
    for (int d = 0; d < 4; ++d) {
        const unsigned a0 = (unsigned)__builtin_amdgcn_ds_bpermute(srcA, (int)w0[d]), a1 = (unsigned)__builtin_amdgcn_ds_bpermute(srcA, (int)w1[d]);
        const unsigned b0 = (unsigned)__builtin_amdgcn_ds_bpermute(srcB, (int)w0[d]), b1 = (unsigned)__builtin_amdgcn_ds_bpermute(srcB, (int)w1[d]);
        oA[d] = hi ? a1 : a0; oB[d] = hi ? b1 : b0; }
}
constexpr float ACT_F8_SCALE = 4.f, WD_F8_SCALE = 64.f, H2_F8_SCALE = 16.f, WGU_F8_SCALE = 32.f;
__device__ __forceinline__ u32x2 pack8_f8(f32x4 a, f32x4 b, float sc) { int w0 = 0, w1 = 0;
    a = a * sc; b = b * sc;
#pragma unroll
    for (int e = 0; e < 4; ++e) { a[e] = __builtin_amdgcn_fmed3f(a[e], -448.f, 448.f); b[e] = __builtin_amdgcn_fmed3f(b[e], -448.f, 448.f); }
    w0 = __builtin_amdgcn_cvt_pk_fp8_f32(a[0], a[1], w0, false); w0 = __builtin_amdgcn_cvt_pk_fp8_f32(a[2], a[3], w0, true);
    w1 = __builtin_amdgcn_cvt_pk_fp8_f32(b[0], b[1], w1, false); w1 = __builtin_amdgcn_cvt_pk_fp8_f32(b[2], b[3], w1, true);
    u32x2 w; w.x = (unsigned)w0; w.y = (unsigned)w1; return w; }
template <bool F8, bool F8IN = false> struct EpiSwigluT {
    static constexpr bool PERM = true, AFTER_DRAIN = false, FP8 = F8IN, PROBE_TWICE = false;
    bf16_t* O; const ssq_t* ssq; float inv;
    __device__ __forceinline__ void operator()(const f32x4 (&acc)[2][2][4][2], const Unit& u, int wr, int wc, int fr, int fq) const {
        constexpr int ldc = 2816;
        asm volatile("" : "+v"(fr), "+v"(fq));
        const int row0 = u.pm * BM + wr * 64 + fr, col0 = u.pn * HALF + wc * 32 + 8 * fq;
        const bool f8 = F8 && (u.pm < MPROMPT / BM);
        float rsv[2][4];
#pragma unroll
        for (int ai = 0; ai < 2; ++ai)
#pragma unroll
            for (int m = 0; m < 4; ++m) rsv[ai][m] = rsqrtf(ssq_ld(ssq, row0 + ai * HALF + m * 16) * (1.f / 1024.f) + RMS_EPS_F) * inv;
#pragma unroll
        for (int ai = 0; ai < 2; ++ai)
#pragma unroll
            for (int m = 0; m < 4; ++m) { const int row = row0 + ai * HALF + m * 16; const float rs = rsv[ai][m];
                f32x4 o[2];
#pragma unroll
                for (int n = 0; n < 2; ++n)
#pragma unroll
                    for (int e = 0; e < 4; ++e) o[n][e] = silu_f(acc[ai][0][m][n][e] * rs) * (acc[ai][1][m][n][e] * rs);
                if (f8) *(u32x2*)((unsigned char*)O + (size_t)row * ldc + col0) = pack8_f8(o[0], o[1], ACT_F8_SCALE);
                else *(u32x4*)(O + (size_t)row * ldc + col0) = pack8(o[0], o[1]); }
    }
};
using EpiSwiglu = EpiSwigluT<false>;
template <bool F8IN, bool OUT8 = false> struct EpiResidT {
    static constexpr bool PERM = true, AFTER_DRAIN = false, PROBE_TWICE = false, FP8 = F8IN;
    const float* resF; const bf16_t* resB; float* outF; bf16_t* outB; ssq_t* ssq; float alpha;
    __device__ __forceinline__ void operator()(const f32x4 (&acc)[2][2][4][2], const Unit& u, int wr, int wc, int fr, int fq) const {
        const int row0 = u.pm * BM + wr * 64 + fr, col0 = u.pn * BM + wc * 32 + 8 * fq;
        if (resF) {
#pragma unroll
            for (int am = 0; am < 4; ++am) { const int ai = am >> 1; f32x4 rr[4][2][2];
#pragma unroll
                for (int m = 2 * (am & 1); m < 2 * (am & 1) + 2; ++m)
#pragma unroll
                    for (int bj = 0; bj < 2; ++bj) { const float* rp = resF + (size_t)(row0 + ai * HALF + m * 16) * 1024 + col0 + bj * HALF; rr[m][bj][0] = *(const f32x4*)rp; rr[m][bj][1] = *(const f32x4*)(rp + 4); }
#pragma unroll
                for (int m = 2 * (am & 1); m < 2 * (am & 1) + 2; ++m) { const size_t row = (size_t)(row0 + ai * HALF + m * 16); float s = 0.f;
#pragma unroll
                    for (int bj = 0; bj < 2; ++bj) { const int col = col0 + bj * HALF;
                        const f32x4 o0 = rr[m][bj][0] + acc[ai][bj][m][0] * alpha, o1 = rr[m][bj][1] + acc[ai][bj][m][1] * alpha;
                        if (outF) { *(f32x4*)(outF + row * 1024 + col) = o0; *(f32x4*)(outF + row * 1024 + col + 4) = o1; }
                        if (outB) *(u32x4*)(outB + row * 1024 + col) = pack8(o0, o1);
                        if constexpr (OUT8) *(u32x2*)((unsigned char*)outB + (WS_H2F8 - WS_XB) + row * 1024 + col) = pack8_f8(o0, o1, H2_F8_SCALE);
                        s += (o0[0] * o0[0] + o0[1] * o0[1]) + (o0[2] * o0[2] + o0[3] * o0[3]) + (o1[0] * o1[0] + o1[1] * o1[1]) + (o1[2] * o1[2] + o1[3] * o1[3]); }
                    if (ssq) { s += __shfl_xor(s, 16); s += __shfl_xor(s, 32); if (fq == 0) __hip_atomic_fetch_add(ssq + row, ssq_fx(s), __ATOMIC_RELAXED, __HIP_MEMORY_SCOPE_AGENT); } } }
        } else {
#pragma unroll
            for (int ai = 0; ai < 2; ++ai) { u32x4 rw[2][4][2];
#pragma unroll
                for (int m = 0; m < 4; ++m)
#pragma unroll
                    for (int bj = 0; bj < 2; ++bj) rw[ai][m][bj] = *(const u32x4*)(resB + (size_t)(row0 + ai * HALF + m * 16) * 1024 + col0 + bj * HALF);
#pragma unroll
                for (int m = 0; m < 4; ++m) { const size_t row = (size_t)(row0 + ai * HALF + m * 16); float s = 0.f;
#pragma unroll
                    for (int bj = 0; bj < 2; ++bj) { const int col = col0 + bj * HALF; f32x4 r0, r1; unpack8(rw[ai][m][bj], r0, r1);
                        const f32x4 o0 = r0 + acc[ai][bj][m][0] * alpha, o1 = r1 + acc[ai][bj][m][1] * alpha;
                        if (outF) { *(f32x4*)(outF + row * 1024 + col) = o0; *(f32x4*)(outF + row * 1024 + col + 4) = o1; }
                        if (outB) *(u32x4*)(outB + row * 1024 + col) = pack8(o0, o1);
                        if constexpr (OUT8) *(u32x2*)((unsigned char*)outB + (WS_H2F8 - WS_XB) + row * 1024 + col) = pack8_f8(o0, o1, H2_F8_SCALE);
                        s += (o0[0] * o0[0] + o0[1] * o0[1]) + (o0[2] * o0[2] + o0[3] * o0[3]) + (o1[0] * o1[0] + o1[1] * o1[1]) + (o1[2] * o1[2] + o1[3] * o1[3]); }
                    if (ssq) { s += __shfl_xor(s, 16); s += __shfl_xor(s, 32); if (fq == 0) __hip_atomic_fetch_add(ssq + row, ssq_fx(s), __ATOMIC_RELAXED, __HIP_MEMORY_SCOPE_AGENT); } } }
        }
    }
};
using EpiResid = EpiResidT<false>;
struct EpiGateMul {
    static constexpr bool PERM = true, AFTER_DRAIN = false, FP8 = false, PROBE_TWICE = false;
    const bf16_t* G; bf16_t* MPb;
    __device__ __forceinline__ void operator()(const f32x4 (&acc)[2][2][4][2], const Unit& u, int wr, int wc, int fr, int fq) const {
        const int row0 = u.pm * BM + wr * 64 + fr, col0 = u.pn * BM + wc * 32 + 8 * fq;
        u32x4 gw[2][4][2];
#pragma unroll
        for (int ai = 0; ai < 2; ++ai)
#pragma unroll
            for (int m = 0; m < 4; ++m)
#pragma unroll
                for (int bj = 0; bj < 2; ++bj) gw[ai][m][bj] = *(const u32x4*)(G + (size_t)(row0 + ai * HALF + m * 16) * 1024 + col0 + bj * HALF);
#pragma unroll
        for (int ai = 0; ai < 2; ++ai)
#pragma unroll
            for (int m = 0; m < 4; ++m) { const size_t row = (size_t)(row0 + ai * HALF + m * 16);
#pragma unroll
                for (int bj = 0; bj < 2; ++bj) { const int col = col0 + bj * HALF; f32x4 g0, g1; unpack8(gw[ai][m][bj], g0, g1);
                    *(u32x4*)(MPb + row * 1024 + col) = pack8(g0 * acc[ai][bj][m][0], g1 * acc[ai][bj][m][1]); } }
    }
};
struct EpiGateAdd {
    static constexpr bool PERM = true, AFTER_DRAIN = false, FP8 = false, PROBE_TWICE = false;
    const bf16_t* G; const bf16_t* MPb; bf16_t* O;
    __device__ __forceinline__ void operator()(const f32x4 (&acc)[2][2][4][2], const Unit& u, int wr, int wc, int fr, int fq) const {
        const int row0 = u.pm * BM + wr * 64 + fr, col0 = u.pn * BM + wc * 32 + 8 * fq;
#pragma unroll
        for (int ai = 0; ai < 2; ++ai) { u32x4 gw[4][2], pw[4][2];
#pragma unroll
            for (int m = 0; m < 4; ++m)
#pragma unroll
                for (int bj = 0; bj < 2; ++bj) { const size_t off = (size_t)(row0 + ai * HALF + m * 16) * 1024 + col0 + bj * HALF; gw[m][bj] = *(const u32x4*)(G + off); pw[m][bj] = *(const u32x4*)(MPb + off); }
#pragma unroll
            for (int m = 0; m < 4; ++m) { const size_t row = (size_t)(row0 + ai * HALF + m * 16);
#pragma unroll
                for (int bj = 0; bj < 2; ++bj) { const int col = col0 + bj * HALF; f32x4 g0, g1, p0, p1; unpack8(gw[m][bj], g0, g1); unpack8(pw[m][bj], p0, p1);
                    *(u32x4*)(O + row * 1024 + col) = pack8(p0 + g0 * acc[ai][bj][m][0], p1 + g1 * acc[ai][bj][m][1]); } } }
    }
};
struct EpiWin {
    static constexpr bool PERM = true, AFTER_DRAIN = false, FP8 = false, PROBE_TWICE = false;
    unsigned char* ws; float* dout;
    __device__ __forceinline__ void operator()(const f32x4 (&acc)[2][2][4][2], const Unit& u, int wr, int wc, int fr, int fq) const {
        asm volatile("" : "+v"(fr), "+v"(fq));
        const ssq_t* ssq = (const ssq_t*)(ws + WS_CTL + CTL_SSQH);
        bf16_t *Z = (bf16_t*)(ws + WS_Z), *XBC = (bf16_t*)(ws + WS_XBC), *Q = (bf16_t*)(ws + WS_Q), *K = (bf16_t*)(ws + WS_K), *V = (bf16_t*)(ws + WS_V), *GS = (bf16_t*)(ws + WS_GS), *GA = (bf16_t*)(ws + WS_GA);
        float *DT = (float*)(ws + WS_DT), *LOGF = (float*)(ws + WS_LOGF);
        float *koP = dout + O_KP, *koS = dout + O_KS, *voP = dout + O_VP, *voS = dout + O_VS, *lfP = dout + O_LFP, *lfS = dout + O_LFS;
        const float *qn = (const float*)(ws + WS_PAR) + PAR_QN, *kn = (const float*)(ws + WS_PAR) + PAR_KN, *dtb = (const float*)(ws + WS_PAR) + PAR_DTB, *bf = (const float*)(ws + WS_PAR) + PAR_BF;
        const int row0 = u.pm * BM + wr * 64 + fr, pn = u.pn;
        float rsv[2][4];
#pragma unroll
        for (int ai = 0; ai < 2; ++ai)
#pragma unroll
            for (int m = 0; m < 4; ++m) rsv[ai][m] = rsqrtf(ssq_ld(ssq, row0 + ai * HALF + m * 16) * (1.f / 1024.f) + RMS_EPS_F);
        if (pn < 20 || (pn >= 25 && pn < 34)) {
            bf16_t* O; int ldc, cb; int mode = 0;
            if (pn < 8) { O = Z; ldc = 2048; cb = pn * BM; } else if (pn < 20) { O = XBC; ldc = 3072; cb = (pn - 8) * BM; }
            else if (pn == 25) { O = V; ldc = 256; cb = 0; mode = 2; } else if (pn < 30) { O = GS; ldc = 1024; cb = (pn - 26) * BM; mode = 1; } else { O = GA; ldc = 1024; cb = (pn - 30) * BM; mode = 1; }
            const int col0 = cb + wc * 64 + 8 * fq;
            const int lane = 16 * fq + fr, colx = cb + wc * 64 + 8 * (lane & 7), rowx = u.pm * BM + wr * 64 + (lane >> 3);
#pragma unroll
            for (int ai = 0; ai < 2; ++ai)
#pragma unroll
                for (int m = 0; m < 4; ++m) { const int row = row0 + ai * HALF + m * 16; const float rs = rsv[ai][m];
                    u32x4 w[2];
#pragma unroll
                    for (int bj = 0; bj < 2; ++bj) { f32x4 v0 = acc[ai][bj][m][0] * rs, v1 = acc[ai][bj][m][1] * rs; const int col = col0 + bj * 32;
                        if (mode == 1) {
#pragma unroll
                            for (int e = 0; e < 4; ++e) { v0[e] = sigmoid_f(v0[e]); v1[e] = sigmoid_f(v1[e]); } }
                        if (mode == 2) { float* vo = (row < MPROMPT) ? voP + (size_t)row * 256 : voS + (size_t)(row - MPROMPT) * 256; *(f32x4*)(vo + col) = v0; *(f32x4*)(vo + col + 4) = v1; }
                        w[bj] = pack8(v0, v1); }
                    u32x4 oA, oB; cx8(w[0], w[1], lane, oA, oB);
                    const size_t ra = (size_t)(rowx + ai * HALF + m * 16);
                    *(u32x4*)(O + ra * ldc + colx) = oA; *(u32x4*)(O + (ra + 8) * ldc + colx) = oB; }
        } else if (pn < 25) {
            const bool isk = (pn == 24); const int head = isk ? wc : 4 * (pn - 20) + wc; const float* gw = isk ? kn : qn; const float sc = isk ? 1.f : ATT_C2;
            f32x4 g[2][2]; float nmax = 0.f;
#pragma unroll
            for (int bj = 0; bj < 2; ++bj)
#pragma unroll
                for (int n = 0; n < 2; ++n) g[bj][n] = *(const f32x4*)(gw + 32 * bj + 8 * fq + 4 * n) * sc;
#pragma unroll
            for (int ai = 0; ai < 2; ++ai)
#pragma unroll
                for (int m = 0; m < 4; ++m) { const int row = row0 + ai * HALF + m * 16; const float rs = rsv[ai][m];
                    f32x4 v[2][2]; float s = 0.f;
#pragma unroll
                    for (int bj = 0; bj < 2; ++bj)
#pragma unroll
                        for (int n = 0; n < 2; ++n) { v[bj][n] = acc[ai][bj][m][n] * rs; s += (v[bj][n][0] * v[bj][n][0] + v[bj][n][1] * v[bj][n][1]) + (v[bj][n][2] * v[bj][n][2] + v[bj][n][3] * v[bj][n][3]); }
                    s += __shfl_xor(s, 16); s += __shfl_xor(s, 32);
                    const float r = rsqrtf(s * (1.f / 64.f) + RMS_EPS_F);
                    float nn = 0.f;
#pragma unroll
                    for (int bj = 0; bj < 2; ++bj) { const f32x4 o0 = v[bj][0] * r * g[bj][0], o1 = v[bj][1] * r * g[bj][1]; const int col = head * 64 + 32 * bj + 8 * fq;
                        { f32x4 q0, q1; unpack8(pack8(o0, o1), q0, q1); nn += (q0[0] * q0[0] + q0[1] * q0[1]) + (q0[2] * q0[2] + q0[3] * q0[3]) + (q1[0] * q1[0] + q1[1] * q1[1]) + (q1[2] * q1[2] + q1[3] * q1[3]); }
                        if (isk) { float* ko = (row < MPROMPT) ? koP + (size_t)row * 256 : koS + (size_t)(row - MPROMPT) * 256; *(f32x4*)(ko + col) = o0; *(f32x4*)(ko + col + 4) = o1;
                                   *(u32x4*)(K + (size_t)row * 256 + col) = pack8(o0, o1); }
                        else *(u32x4*)(Q + (size_t)row * 1024 + col) = pack8(o0, o1); }
                    nn += __shfl_xor(nn, 16); nn += __shfl_xor(nn, 32); nmax = fmaxf(nmax, nn); }
            nmax = fmaxf(nmax, __shfl_xor(nmax, 1)); nmax = fmaxf(nmax, __shfl_xor(nmax, 2)); nmax = fmaxf(nmax, __shfl_xor(nmax, 4)); nmax = fmaxf(nmax, __shfl_xor(nmax, 8));
            if (fr == 0 && fq == 0) __hip_atomic_fetch_max((unsigned*)(ws + WS_CTL) + (isk ? CW_KMAX2 : CW_QMAX2), __float_as_uint(nmax), __ATOMIC_RELAXED, __HIP_MEMORY_SCOPE_AGENT);
        } else {
            if (wc == 0) {
                const f32x4 b0 = *(const f32x4*)(dtb + 8 * fq), b1 = *(const f32x4*)(dtb + 8 * fq + 4);
#pragma unroll
                for (int ai = 0; ai < 2; ++ai)
#pragma unroll
                    for (int m = 0; m < 4; ++m) { const int row = row0 + ai * HALF + m * 16; const float rs = rsv[ai][m];
                        f32x4 v0 = acc[ai][0][m][0] * rs + b0, v1 = acc[ai][0][m][1] * rs + b1;
#pragma unroll
                        for (int e = 0; e < 4; ++e) { v0[e] = softplus_f(v0[e]); v1[e] = softplus_f(v1[e]); }
                        *(f32x4*)(DT + (size_t)row * 32 + 8 * fq) = v0; *(f32x4*)(DT + (size_t)row * 32 + 8 * fq + 4) = v1; }
            } else if (wc == 1 && fq < 2) {
                const f32x4 b0 = *(const f32x4*)(bf + 8 * fq), b1 = *(const f32x4*)(bf + 8 * fq + 4);
#pragma unroll
                for (int ai = 0; ai < 2; ++ai)
#pragma unroll
                    for (int m = 0; m < 4; ++m) { const int row = row0 + ai * HALF + m * 16; const float rs = rsv[ai][m];
                        f32x4 v0 = acc[ai][0][m][0] * rs + b0, v1 = acc[ai][0][m][1] * rs + b1;
#pragma unroll
                        for (int e = 0; e < 4; ++e) { v0[e] = logsigmoid_f(v0[e]); v1[e] = logsigmoid_f(v1[e]); }
                        float* lo = (row < MPROMPT) ? lfP + (size_t)row * 16 : lfS + (size_t)(row - MPROMPT) * 16;
                        *(f32x4*)(lo + 8 * fq) = v0; *(f32x4*)(lo + 8 * fq + 4) = v1;
                        *(f32x4*)(LOGF + (size_t)row * 16 + 8 * fq) = v0; *(f32x4*)(LOGF + (size_t)row * 16 + 8 * fq + 4) = v1; }
            }
        }
    }
};
template <class Epi, class Sched, bool ALIGN_EPI = false, bool SP2 = false>
__device__ __forceinline__ void gemm_phase(PG8_LAS unsigned char* lds, const Gemm g, const Sched& S, const Epi& E) {
    const int tid = threadIdx.x, wid = __builtin_amdgcn_readfirstlane(tid >> 6), lane = tid & 63, wr = wid >> 2, wc = wid & 3, fr = lane & 15, fq = lane >> 4;
    const int K = g.K, nt = K / BK;
    unsigned voffA[2], voffB[2];
#pragma unroll
    for (int i = 0; i < 2; ++i) { int R, C; stage_rc(tid * 16 + i * 8192, R, C); const int Rb = Epi::PERM ? ((R & ~31) + perm32(R & 31)) : R;
        voffA[i] = (unsigned)(R * K + C) * 2u; voffB[i] = (unsigned)(Rb * K + C) * 2u; }
    const size_t kstep = (size_t)(BK * 2);
    const size_t hstep = (size_t)HALF * K * 2;
    const size_t tstep = 2 * hstep;
    const unsigned ldsw = (unsigned)wid * 1024u;
    const int aoff = lds_byte(wr * 64 + fr, fq * 8), boff = lds_byte(wc * 32 + fr, fq * 8);
#define PG8_SA(b, h) (((b) * 2 + (h)) * HTB)
#define PG8_SB(b, h) ((4 + (b) * 2 + (h)) * HTB)
#define PG8_STAGE(bufoff, gbase, voff) do { _Pragma("unroll") for (int _i = 0; _i < 2; ++_i) \
        __builtin_amdgcn_global_load_lds((const unsigned*)((const char*)(gbase) + (voff)[_i]), (PG8_LAS unsigned*)(lds + (bufoff) + ldsw + _i * 8192), 16, 0, 0); } while (0)
#define PG8_LDA(dst, b, h) do { _Pragma("unroll") for (int m = 0; m < 4; ++m) { if constexpr (Epi::FP8) dst[m][0] = __builtin_shufflevector(*(const PG8_LAS v4i*)(lds + PG8_SA(b, h) + aoff + m * 2048), *(const PG8_LAS v4i*)(lds + PG8_SA(b, h) + aoff + m * 2048 + 1024), 0, 1, 2, 3, 4, 5, 6, 7); \
        else { _Pragma("unroll") for (int k = 0; k < 2; ++k) dst[m][k] = *(const PG8_LAS bf16x8*)(lds + PG8_SA(b, h) + aoff + m * 2048 + k * 1024); } } } while (0)
#define PG8_LDB(dst, b, h) do { _Pragma("unroll") for (int n = 0; n < 2; ++n) { if constexpr (Epi::FP8) dst[n][0] = __builtin_shufflevector(*(const PG8_LAS v4i*)(lds + PG8_SB(b, h) + boff + n * 2048), *(const PG8_LAS v4i*)(lds + PG8_SB(b, h) + boff + n * 2048 + 1024), 0, 1, 2, 3, 4, 5, 6, 7); \
        else { _Pragma("unroll") for (int k = 0; k < 2; ++k) dst[n][k] = *(const PG8_LAS bf16x8*)(lds + PG8_SB(b, h) + boff + n * 2048 + k * 1024); } } } while (0)
#define PG8_MMA(ai, bj, At, Bt) do { __builtin_amdgcn_s_setprio(1); \
        if constexpr (Epi::FP8) {   \
            _Pragma("unroll") for (int m = 0; m < 4; ++m) _Pragma("unroll") for (int n = 0; n < 2; ++n) \
                asm volatile("v_mfma_f32_16x16x128_f8f6f4 %0, %1, %2, %0" : "+v"(acc[ai][bj][m][n]) : "v"(Bt[n][0]), "v"(At[m][0]));   \
        } else { \
        _Pragma("unroll") for (int m = 0; m < 4; ++m) _Pragma("unroll") for (int n = 0; n < 2; ++n) _Pragma("unroll") for (int k = 0; k < 2; ++k) \
        acc[ai][bj][m][n] = __builtin_amdgcn_mfma_f32_16x16x32_bf16(Bt[n][k], At[m][k], acc[ai][bj][m][n], 0, 0, 0); } __builtin_amdgcn_s_setprio(0); } while (0)
#define PG8_WAIT_V(n) asm volatile("s_waitcnt vmcnt(" #n ")" ::: "memory")
#define PG8_WAIT_L(n) asm volatile("s_waitcnt lgkmcnt(" #n ")" ::: "memory")
#define PG8_BAR __builtin_amdgcn_s_barrier()
#define PG8_SCHED __builtin_amdgcn_sched_barrier(0)
    Unit cur, nxt; int ui = 0;
    if (!S.next(0, cur)) return;
    f32x4 acc[2][2][4][2];
#pragma unroll
    for (int a = 0; a < 2; ++a)
#pragma unroll
        for (int b = 0; b < 2; ++b)
#pragma unroll
            for (int m = 0; m < 4; ++m)
#pragma unroll
                for (int n = 0; n < 2; ++n) acc[a][b][m][n] = (f32x4){0.f, 0.f, 0.f, 0.f};
    typename FragSel<Epi::FP8>::type At[4][Epi::FP8 ? 1 : 2], B0[2][Epi::FP8 ? 1 : 2], B1[2][Epi::FP8 ? 1 : 2];
    const char* cA = (const char*)g.A + (size_t)cur.pm * tstep; const char* cB = (const char*)g.Bt + (size_t)cur.pn * tstep;
    S.a_ready(cur);
    if constexpr (SP2) {
        PG8_STAGE(PG8_SB(0, 0), cB, voffB); PG8_STAGE(PG8_SB(0, 1), cB + hstep, voffB); PG8_STAGE(PG8_SA(0, 0), cA, voffA); PG8_STAGE(PG8_SA(0, 1), cA + hstep, voffA);
        if (wr == 1) PG8_BAR;
        PG8_WAIT_V(2); PG8_BAR;
        PG8_STAGE(PG8_SB(1, 0), cB + kstep, voffB); PG8_STAGE(PG8_SA(1, 0), cA + kstep, voffA); PG8_STAGE(PG8_SB(1, 1), cB + hstep + kstep, voffB);
        PG8_WAIT_V(6); PG8_BAR;
    } else {
        PG8_STAGE(PG8_SB(0, 0), cB, voffB); PG8_STAGE(PG8_SA(0, 0), cA, voffA); PG8_STAGE(PG8_SB(0, 1), cB + hstep, voffB); PG8_STAGE(PG8_SA(0, 1), cA + hstep, voffA);
        if (wr == 1) PG8_BAR;
        PG8_WAIT_V(4); PG8_BAR;
        PG8_STAGE(PG8_SB(1, 0), cB + kstep, voffB); PG8_STAGE(PG8_SA(1, 0), cA + kstep, voffA); PG8_STAGE(PG8_SB(1, 1), cB + hstep + kstep, voffB);
        PG8_WAIT_V(6); PG8_BAR;
    }
    for (;;) {
        const bool has_next = S.next(ui + 1, nxt);
        const char* nA = has_next ? (const char*)g.A + (size_t)nxt.pm * tstep : cA; const char* nB = has_next ? (const char*)g.Bt + (size_t)nxt.pn * tstep : cB;
        for (int t = 0; t < nt; t += 2) {
            const bool last = (t == nt - 2);
            const char* a1 = cA + (size_t)(t + 1) * kstep;
            const char* a2 = last ? nA : cA + (size_t)(t + 2) * kstep; const char* b2 = last ? nB : cB + (size_t)(t + 2) * kstep;
            const char* a3 = a2 + kstep; const char* b3 = b2 + kstep;
            if (last && has_next) S.a_ready(nxt);
            if constexpr (SP2) {
            PG8_LDB(B0, 0, 0); PG8_LDB(B1, 0, 1); PG8_SCHED; PG8_LDA(At, 0, 0); PG8_STAGE(PG8_SA(1, 1), a1 + hstep, voffA);
            PG8_WAIT_V(8); PG8_WAIT_L(0); PG8_BAR; PG8_MMA(0, 0, At, B0); PG8_MMA(0, 1, At, B1); PG8_BAR; PG8_SCHED;
            PG8_LDA(At, 0, 1); PG8_STAGE(PG8_SB(0, 0), b2, voffB); PG8_STAGE(PG8_SB(0, 1), b2 + hstep, voffB); PG8_STAGE(PG8_SA(0, 0), a2, voffA);
            PG8_WAIT_V(8); PG8_WAIT_L(0); PG8_BAR; PG8_MMA(1, 0, At, B0); PG8_MMA(1, 1, At, B1); PG8_BAR; PG8_SCHED;
            PG8_LDB(B0, 1, 0); PG8_LDB(B1, 1, 1); PG8_SCHED; PG8_LDA(At, 1, 0); PG8_STAGE(PG8_SA(0, 1), a2 + hstep, voffA);
            PG8_WAIT_V(8); PG8_WAIT_L(0); PG8_BAR; PG8_MMA(0, 0, At, B0); PG8_MMA(0, 1, At, B1); PG8_BAR; PG8_SCHED;
            PG8_LDA(At, 1, 1); PG8_STAGE(PG8_SB(1, 0), b3, voffB); PG8_STAGE(PG8_SB(1, 1), b3 + hstep, voffB); PG8_STAGE(PG8_SA(1, 0), a3, voffA);
            PG8_WAIT_V(8); PG8_WAIT_L(0); PG8_BAR; PG8_MMA(1, 0, At, B0); PG8_MMA(1, 1, At, B1); PG8_BAR; PG8_SCHED;
            } else {
            PG8_LDB(B0, 0, 0); PG8_SCHED; PG8_LDA(At, 0, 0); PG8_STAGE(PG8_SA(1, 1), a1 + hstep, voffA);
            PG8_WAIT_L(8); PG8_BAR; PG8_WAIT_L(0); PG8_MMA(0, 0, At, B0); PG8_BAR; PG8_SCHED;
            PG8_LDB(B1, 0, 1); PG8_STAGE(PG8_SB(0, 0), b2, voffB);
            PG8_BAR; PG8_WAIT_L(0); PG8_MMA(0, 1, At, B1); PG8_BAR;
            PG8_LDA(At, 0, 1); PG8_STAGE(PG8_SA(0, 0), a2, voffA);
            PG8_BAR; PG8_WAIT_L(0); PG8_MMA(1, 0, At, B0); PG8_BAR; PG8_SCHED;
            PG8_STAGE(PG8_SB(0, 1), b2 + hstep, voffB);
            PG8_WAIT_V(6); PG8_BAR; PG8_MMA(1, 1, At, B1); PG8_BAR;
            PG8_LDB(B0, 1, 0); PG8_SCHED; PG8_LDA(At, 1, 0); PG8_STAGE(PG8_SA(0, 1), a2 + hstep, voffA);
            PG8_WAIT_L(8); PG8_BAR; PG8_WAIT_L(0); PG8_MMA(0, 0, At, B0); PG8_BAR; PG8_SCHED;
            PG8_LDB(B1, 1, 1); PG8_STAGE(PG8_SB(1, 0), b3, voffB);
            PG8_BAR; PG8_WAIT_L(0); PG8_MMA(0, 1, At, B1); PG8_BAR;
            PG8_LDA(At, 1, 1); PG8_STAGE(PG8_SA(1, 0), a3, voffA);
            PG8_BAR; PG8_WAIT_L(0); PG8_MMA(1, 0, At, B0); PG8_BAR; PG8_SCHED;
            PG8_STAGE(PG8_SB(1, 1), b3 + hstep, voffB);
            PG8_WAIT_V(6); PG8_BAR; PG8_MMA(1, 1, At, B1); PG8_BAR;
            }
        }
        if constexpr (ALIGN_EPI) { if (wr == 0) PG8_BAR; }
        if constexpr (Epi::FP8) asm volatile("s_nop 15\n\ts_nop 15" ::: "memory");
        if constexpr (!Epi::AFTER_DRAIN) { E(acc, cur, wr, wc, fr, fq); if constexpr (Epi::PROBE_TWICE) { asm volatile("" ::: "memory"); E(acc, cur, wr, wc, fr, fq); } S.done(cur); }
        if (!has_next) break;
#pragma unroll
        for (int a = 0; a < 2; ++a)
#pragma unroll
            for (int b = 0; b < 2; ++b)
#pragma unroll
                for (int m = 0; m < 4; ++m)
#pragma unroll
                    for (int n = 0; n < 2; ++n) acc[a][b][m][n] = (f32x4){0.f, 0.f, 0.f, 0.f};
        cur = nxt; cA = nA; cB = nB; ++ui;
        if constexpr (ALIGN_EPI) { if (wr == 1) PG8_BAR; }
    }
    PG8_WAIT_V(0);
    if constexpr (!ALIGN_EPI) { if (wr == 0) PG8_BAR; }
    PG8_BAR;
    if constexpr (Epi::AFTER_DRAIN) { E.fused(acc, cur, wr, wc, fr, fq, lds, wid, lane); S.done(cur); }
#undef PG8_SA
#undef PG8_SB
#undef PG8_STAGE
#undef PG8_LDA
#undef PG8_LDB
#undef PG8_MMA
#undef PG8_WAIT_V
#undef PG8_WAIT_L
#undef PG8_BAR
#undef PG8_SCHED
}
}
#define GAS __attribute__((address_space(1)))
#define LAS __attribute__((address_space(3)))
typedef unsigned short bf16;
typedef unsigned v4u __attribute__((ext_vector_type(4)));
typedef unsigned v2u __attribute__((ext_vector_type(2)));
typedef float f32x4 __attribute__((ext_vector_type(4)));
typedef float f32x16 __attribute__((ext_vector_type(16)));
typedef short bf16x8 __attribute__((ext_vector_type(8)));
typedef short s16x4 __attribute__((ext_vector_type(4)));
typedef GAS unsigned gu32;
#define RLX_AGENT __ATOMIC_RELAXED, __HIP_MEMORY_SCOPE_AGENT
#define LDS_WAIT() asm volatile("s_waitcnt lgkmcnt(0)" ::: "memory")
#define VM_WAIT() asm volatile("s_waitcnt vmcnt(0)" ::: "memory")
__device__ __forceinline__ unsigned f2bf(float f) { unsigned u = __builtin_bit_cast(unsigned, f); return (u + 0x7fffu + ((u >> 16) & 1u)) >> 16; }
__device__ __forceinline__ unsigned pk2(float lo, float hi) { unsigned r; asm("v_cvt_pk_bf16_f32 %0, %1, %2" : "=v"(r) : "v"(lo), "v"(hi)); return r; }
__device__ __forceinline__ float bflo(unsigned w) { return __uint_as_float(w << 16); }
__device__ __forceinline__ float bfhi(unsigned w) { return __uint_as_float(w & 0xffff0000u); }
__device__ __forceinline__ float wave_sum(float v) {
#pragma unroll
    for (int o = 1; o < 64; o <<= 1) v += __shfl_xor(v, o);
    return v;
}
#define XB_TMO      128
#define XB_XCNT(j)  (256  + 64 * (j))
#define XB_XSUB(j)  (1280 + 64 * (j))
#define XB_XGEN(j)  (2304 + 64 * (j))
#define XB_TOP      3328
#define XB_TOPGEN   3392
#define XCD_BAR_WORDS 3456
#define XB_SPIN_CAP (1u << 18)

__device__ __forceinline__ unsigned xb_ld(unsigned* p)              { return __hip_atomic_load(p, __ATOMIC_RELAXED, __HIP_MEMORY_SCOPE_AGENT); }
__device__ __forceinline__ unsigned xb_add(unsigned* p, unsigned v) { return __hip_atomic_fetch_add(p, v, __ATOMIC_RELAXED, __HIP_MEMORY_SCOPE_AGENT); }
__device__ __forceinline__ unsigned xb_xcc_id() { return (unsigned)__builtin_amdgcn_s_getreg((3 << 11) | 20) & 0xFu; }
#define XB_SPIN(cond, bar) do { unsigned _sp = 0; while (cond) { __builtin_amdgcn_s_sleep(1); \
    if ((++_sp & 255u) == 0u) { if (xb_ld(&(bar)[XB_TMO])) break; if (_sp > XB_SPIN_CAP) { atomicAdd(&(bar)[XB_TMO], 1u); break; } } } } while (0)

struct XcdBarrier {
    unsigned* bar; unsigned x;
    volatile LAS unsigned* st;
};

__device__ __forceinline__ XcdBarrier xcd_barrier_post(unsigned* bar, volatile LAS unsigned* st) {
    XcdBarrier b; b.bar = bar; b.x = xb_xcc_id(); b.st = st;
    if (threadIdx.x == 0) (void)xb_add(&bar[XB_XCNT(b.x)], 1u);
    return b;
}
__device__ __forceinline__ void xcd_barrier_complete(unsigned* bar, unsigned x, unsigned& nloc, unsigned& nx) {
    const unsigned G = gridDim.x * gridDim.y * gridDim.z;
    unsigned sum, cnt, mine, sp = 0u;
    for (;;) {
        sum = 0u; cnt = 0u; mine = 0u;
#pragma unroll
        for (unsigned j = 0; j < 16; ++j) { const unsigned c = xb_ld(&bar[XB_XCNT(j)]); sum += c; cnt += (c > 0u) ? 1u : 0u; mine = (j == x) ? c : mine; }
        if (sum == G) break;
        __builtin_amdgcn_s_sleep(1);
        if ((++sp & 255u) == 0u) { if (xb_ld(&bar[XB_TMO])) break; if (sp > XB_SPIN_CAP) { atomicAdd(&bar[XB_TMO], 1u); break; } }
    }
    nloc = mine > 0u ? mine : 1u; nx = cnt > 0u ? cnt : 1u;
}

__device__ __forceinline__ void xcd_barrier(const XcdBarrier& b) {
    asm volatile("s_waitcnt vmcnt(0)" ::: "memory");
    __syncthreads();
    if (threadIdx.x == 0) {
        unsigned* bar = b.bar;
        __builtin_amdgcn_s_waitcnt(0);
        unsigned nloc = b.st[0], nx = b.st[1];
        if (nloc == 0u) { xcd_barrier_complete(bar, b.x, nloc, nx); b.st[0] = nloc; b.st[1] = nx; }
        const unsigned old = xb_add(&bar[XB_XSUB(b.x)], 1u);
        const unsigned gen = old / nloc;
        if (old + 1u == (gen + 1u) * nloc) {
            __builtin_amdgcn_fence(__ATOMIC_RELEASE, "agent");
            asm volatile("s_waitcnt vmcnt(0)" ::: "memory");
            const unsigned og = xb_add(&bar[XB_TOP], 1u);
            const unsigned tg = og / nx;
            if (og + 1u == (tg + 1u) * nx) xb_add(&bar[XB_TOPGEN], 1u);
            else XB_SPIN(xb_ld(&bar[XB_TOPGEN]) == tg, bar);
            __builtin_amdgcn_fence(__ATOMIC_ACQUIRE, "agent");
            xb_add(&bar[XB_XGEN(b.x)], 1u);
            asm volatile("s_waitcnt vmcnt(0)" ::: "memory");
        } else {
            XB_SPIN(xb_ld(&bar[XB_XGEN(b.x)]) == gen, bar);
            __builtin_amdgcn_fence(__ATOMIC_ACQUIRE, "agent");
            asm volatile("s_waitcnt vmcnt(0)" ::: "memory");
        }
    }
    __syncthreads();
}
struct MapPlain { const float* W; int N; __device__ __forceinline__ const float* operator()(int n, int& ld) const { ld = N; return W + n; } };
struct MapGU { const float* W; __device__ __forceinline__ const float* operator()(int n, int& ld) const { ld = DFF; const int pn = n >> 8, j = n & 127; return W + 128 * pn + j; } };
struct MapWin { const float* W; __device__ __forceinline__ const float* operator()(int n, int& ld) const { ld = INDIM; const int pn = n >> 8, ct = n & 255; int c;
        const int pl = 64 * ((ct >> 5) & 3) + 32 * (ct >> 7) + (ct & 31);
        if (pn < 20) c = 256 * pn + pl;
        else if (pn < 25) { const int bj = ct >> 7, wc = (ct >> 5) & 3, j = ct & 31; c = (pn == 24 ? 6176 + 64 * wc : 5152 + 64 * (4 * (pn - 20) + wc)) + 32 * bj + j; }
        else if (pn == 25) c = 6432 + pl;
        else if (pn < 30) c = 6704 + 256 * (pn - 26) + pl;
        else if (pn < 34) c = 7728 + 256 * (pn - 30) + pl;
        else c = ct < 32 ? 5120 + ct : (ct < 48 ? 6688 + (ct - 32) : -1);
        return c < 0 ? nullptr : W + c; } };
template <class Map> __device__ __forceinline__ void p0_transpose_item(const Map& mp, const float* ksc, int K, bf16* WT, LAS float* scr, int kb, int nb, int lane, unsigned char* W8 = nullptr, float SC = 1.f) {
    const int k0 = 64 * kb, n0 = 64 * nb; int ld; const float* src = mp(n0 + lane, ld);
    float v[64];
#pragma unroll
    for (int i = 0; i < 64; ++i) v[i] = src ? src[(size_t)(k0 + i) * ld] : 0.f;
    const float sc = ksc ? ksc[k0 + lane] : 1.f;
#pragma unroll
    for (int i = 0; i < 64; ++i) scr[i * 65 + lane] = v[i] * __shfl(sc, i);
    LDS_WAIT(); asm volatile("" ::: "memory");
    const int c = lane & 7;
#pragma unroll
    for (int j = 0; j < 8; ++j) { const int n = (lane >> 3) + 8 * j; const LAS float* s = scr + (8 * c) * 65 + n;
        v4u o; o.x = pk2(s[0 * 65], s[1 * 65]); o.y = pk2(s[2 * 65], s[3 * 65]); o.z = pk2(s[4 * 65], s[5 * 65]); o.w = pk2(s[6 * 65], s[7 * 65]);
        if (WT) *(GAS v4u*)(WT + (size_t)(n0 + n) * K + k0 + 8 * c) = o;
        if (W8) { int w0 = 0, w1 = 0;
            w0 = __builtin_amdgcn_cvt_pk_fp8_f32(s[0 * 65] * SC, s[1 * 65] * SC, w0, false); w0 = __builtin_amdgcn_cvt_pk_fp8_f32(s[2 * 65] * SC, s[3 * 65] * SC, w0, true);
            w1 = __builtin_amdgcn_cvt_pk_fp8_f32(s[4 * 65] * SC, s[5 * 65] * SC, w1, false); w1 = __builtin_amdgcn_cvt_pk_fp8_f32(s[6 * 65] * SC, s[7 * 65] * SC, w1, true);
            v2u o8; o8.x = (unsigned)w0; o8.y = (unsigned)w1; *(GAS v2u*)(W8 + (size_t)(n0 + n) * K + k0 + 8 * c) = o8; } }
    LDS_WAIT(); asm volatile("" ::: "memory");
}
__device__ __forceinline__ void p0_row_to_bf16(const float* xrow, bf16* orow, pg8::ssq_t* ssq, int lane) {
    const GAS f32x4* xr = (const GAS f32x4*)xrow + lane;
    f32x4 v[4]; float s = 0.f;
#pragma unroll
    for (int j = 0; j < 4; ++j) { v[j] = xr[64 * j]; s += (v[j].x * v[j].x + v[j].y * v[j].y) + (v[j].z * v[j].z + v[j].w * v[j].w); }
    s = wave_sum(s);
    GAS unsigned long long* o8 = (GAS unsigned long long*)orow + lane;
#pragma unroll
    for (int j = 0; j < 4; ++j) o8[64 * j] = (unsigned long long)pk2(v[j].x, v[j].y) | ((unsigned long long)pk2(v[j].z, v[j].w) << 32);
    if (lane == 0) *ssq = pg8::ssq_fx(s);
}
__device__ __forceinline__ void p0_rows_to_bf16(const float* xrow, bf16* orow, pg8::ssq_t* ssq, int lane) {
    const GAS f32x4* xr = (const GAS f32x4*)xrow + lane;
    f32x4 v[8]; float s0 = 0.f, s1 = 0.f;
#pragma unroll
    for (int j = 0; j < 8; ++j) v[j] = xr[64 * j];
#pragma unroll
    for (int j = 0; j < 4; ++j) { s0 += (v[j].x * v[j].x + v[j].y * v[j].y) + (v[j].z * v[j].z + v[j].w * v[j].w); s1 += (v[4 + j].x * v[4 + j].x + v[4 + j].y * v[4 + j].y) + (v[4 + j].z * v[4 + j].z + v[4 + j].w * v[4 + j].w); }
    s0 = wave_sum(s0); s1 = wave_sum(s1);
    GAS unsigned long long* o8 = (GAS unsigned long long*)orow + lane;
#pragma unroll
    for (int j = 0; j < 8; ++j) o8[64 * j] = (unsigned long long)pk2(v[j].x, v[j].y) | ((unsigned long long)pk2(v[j].z, v[j].w) << 32);
    if (lane == 0) { ssq[0] = pg8::ssq_fx(s0); ssq[1] = pg8::ssq_fx(s1); }
}
__device__ __forceinline__ f32x16 mfma32(bf16x8 a, bf16x8 b, f32x16 c) { return __builtin_amdgcn_mfma_f32_32x32x16_bf16(a, b, c, 0, 0, 0); }
__device__ __forceinline__ int crow(int r, int hi) { return (r & 3) + 8 * (r >> 2) + 4 * hi; }
typedef short v4i16_t __attribute__((ext_vector_type(4)));
__device__ __forceinline__ s16x4 ds_tr(LAS const unsigned char* p) { return __builtin_bit_cast(s16x4, __builtin_amdgcn_ds_read_tr16_b64_v4i16((LAS v4i16_t*)p)); }
__device__ __forceinline__ bf16x8 tr_frag(LAS const unsigned char* tile, int pitch, int ka, int kb, int cb, int lane) {
    const int i = lane & 15, q = i >> 2, pp = i & 3, c16 = cb + 16 * ((lane >> 4) & 1);
    const s16x4 lo = ds_tr(tile + (ka + q) * pitch + (c16 + 4 * pp) * 2), hi = ds_tr(tile + (kb + q) * pitch + (c16 + 4 * pp) * 2);
    return (bf16x8){lo[0], lo[1], lo[2], lo[3], hi[0], hi[1], hi[2], hi[3]};
}
__device__ __forceinline__ float wave_scan_incl(float v, int lane) {
#pragma unroll
    for (int o = 1; o < 64; o <<= 1) { const float t = __shfl_up(v, o); if (lane >= o) v += t; }
    return v;
}
__device__ __forceinline__ float silu1(float x) { return x * __builtin_amdgcn_rcpf(1.f + __builtin_amdgcn_exp2f(-1.4426950408889634f * x)); }
__device__ __forceinline__ float exp_fast(float x) { return __builtin_amdgcn_exp2f(1.4426950408889634f * x); }
__device__ __forceinline__ void unpk8(const v4u w, float (&f)[8]) { f[0] = bflo(w.x); f[1] = bfhi(w.x); f[2] = bflo(w.y); f[3] = bfhi(w.y); f[4] = bflo(w.z); f[5] = bfhi(w.z); f[6] = bflo(w.w); f[7] = bfhi(w.w); }
__device__ __forceinline__ v4u pk8(const float (&f)[8]) { v4u o; o.x = pk2(f[0], f[1]); o.y = pk2(f[2], f[3]); o.z = pk2(f[4], f[5]); o.w = pk2(f[6], f[7]); return o; }

struct ConvW { float w[4][8]; float b[8]; };
__device__ __forceinline__ void conv_load_w(ConvW& cw, const float* convw, const float* convb, int col) {
#pragma unroll
    for (int j = 0; j < 4; ++j) { const f32x4 a = *(const f32x4*)(convw + (size_t)j * CONVD + col), b = *(const f32x4*)(convw + (size_t)j * CONVD + col + 4);
        cw.w[j][0] = a[0]; cw.w[j][1] = a[1]; cw.w[j][2] = a[2]; cw.w[j][3] = a[3]; cw.w[j][4] = b[0]; cw.w[j][5] = b[1]; cw.w[j][6] = b[2]; cw.w[j][7] = b[3]; }
    const f32x4 a = *(const f32x4*)(convb + col), b = *(const f32x4*)(convb + col + 4);
    cw.b[0] = a[0]; cw.b[1] = a[1]; cw.b[2] = a[2]; cw.b[3] = a[3]; cw.b[4] = b[0]; cw.b[5] = b[1]; cw.b[6] = b[2]; cw.b[7] = b[3];
}
__device__ __forceinline__ void conv_item(unsigned char* ws, const float* convw, const float* convb, int item, int lane) {
    asm volatile("" : "+v"(lane));
    const int cbk = item % 6, rb = item / 6; const int col = 512 * cbk + 8 * lane; const long row0 = 16l * rb; const int tpos0 = (int)(row0 & (SEQ - 1));
    const bf16* XBC = (const bf16*)(ws + WS_XBC); bf16* XC = (bf16*)(ws + WS_XC);
    v4u raw[19];
#pragma unroll
    for (int k = 0; k < 19; ++k) { raw[k] = (v4u){0u, 0u, 0u, 0u}; if (tpos0 - 3 + k >= 0) raw[k] = *(const GAS v4u*)(XBC + (size_t)(row0 - 3 + k) * CONVD + col); }
    ConvW cw; conv_load_w(cw, convw, convb, col);
    float x0[8], x1[8], x2[8], x3[8];
    unpk8(raw[0], x1); unpk8(raw[1], x2); unpk8(raw[2], x3);
#pragma unroll
    for (int k = 3; k < 19; ++k) {
#pragma unroll
        for (int e = 0; e < 8; ++e) { x0[e] = x1[e]; x1[e] = x2[e]; x2[e] = x3[e]; }
        unpk8(raw[k], x3); float y[8];
#pragma unroll
        for (int e = 0; e < 8; ++e) y[e] = silu1(cw.b[e] + cw.w[0][e] * x0[e] + cw.w[1][e] * x1[e] + cw.w[2][e] * x2[e] + cw.w[3][e] * x3[e]);
        *(GAS v4u*)(XC + (size_t)(row0 - 3 + k) * CONVD + col) = pk8(y); }
}

__device__ __forceinline__ void conv_item_q(unsigned char* ws, const float* convw, const float* convb, long row0, int colbase, int lane) {
    asm volatile("" : "+v"(lane));
    const int col = colbase + 8 * (lane & 15); const long r0 = row0 + 16 * (lane >> 4); const int tpos0 = (int)(r0 & (SEQ - 1));
    const bf16* XBC = (const bf16*)(ws + WS_XBC); bf16* XC = (bf16*)(ws + WS_XC);
    v4u raw[19];
#pragma unroll
    for (int k = 0; k < 19; ++k) { raw[k] = (v4u){0u, 0u, 0u, 0u}; if (tpos0 - 3 + k >= 0) raw[k] = *(const GAS v4u*)(XBC + (size_t)(r0 - 3 + k) * CONVD + col); }
    ConvW cw; conv_load_w(cw, convw, convb, col);
    float x0[8], x1[8], x2[8], x3[8];
    unpk8(raw[0], x1); unpk8(raw[1], x2); unpk8(raw[2], x3);
#pragma unroll
    for (int k = 3; k < 19; ++k) {
#pragma unroll
        for (int e = 0; e < 8; ++e) { x0[e] = x1[e]; x1[e] = x2[e]; x2[e] = x3[e]; }
        unpk8(raw[k], x3); float y[8];
#pragma unroll
        for (int e = 0; e < 8; ++e) y[e] = silu1(cw.b[e] + cw.w[0][e] * x0[e] + cw.w[1][e] * x1[e] + cw.w[2][e] * x2[e] + cw.w[3][e] * x3[e]);
        *(GAS v4u*)(XC + (size_t)(r0 - 3 + k) * CONVD + col) = pk8(y); }
}

constexpr int P4_BM = 0, P4_BM_PITCH = 320, P4_X = 40960, P4_X_PITCH = 1088, P4_WGT = P4_X + 64 * P4_X_PITCH;
static_assert(P4_WGT + 4096 <= MISC_OFF, "states LDS map");
__device__ __forceinline__ void p4_unit(unsigned char* ws, const float* convw, const float* convb, LAS unsigned char* lds, int unit, int tid, int lane, int wave) {
    asm volatile("" : "+v"(tid));
    lane = tid & 63;
    const int g = unit & 3, c = (unit >> 2) & 31, b = unit >> 7;
    const size_t row0 = (size_t)b * SEQ + (size_t)c * CHUNK;
    const bf16* XC = (const bf16*)(ws + WS_XC);
    const float* DT = (const float*)(ws + WS_DT); float* ACS = (float*)(ws + WS_ACS); const float* par = (const float*)(ws + WS_PAR);
    LAS float* wgtT = (LAS float*)(lds + P4_WGT);
    conv_item(ws, convw, convb, (int)(((row0 >> 4) + wave) * 6 + g), lane);
    if (wave < 4) conv_item_q(ws, convw, convb, (long)row0 + 64 * (wave & 1), ((wave >> 1) ? 2560 : 2048) + 128 * g, lane);
    __syncthreads();
    v4u braw[4], xraw[8];
#pragma unroll
    for (int i = 0; i < 4; ++i) { const int id = tid + 512 * i, l = id >> 4, ch = id & 15; braw[i] = *(const GAS v4u*)(XC + (row0 + l) * CONVD + 2048 + 128 * g + 8 * ch); }
#pragma unroll
    for (int i = 0; i < 8; ++i) { const int id = tid + 512 * i, l = id >> 6, ch = id & 63; xraw[i] = *(const GAS v4u*)(XC + (row0 + l) * CONVD + 512 * g + 8 * ch); }
    { const int hd = 8 * g + wave; const float Ah = -expf(par[PAR_ALOG + hd]);
      const float d0 = DT[(row0 + 2 * lane) * 32 + hd], d1 = DT[(row0 + 2 * lane + 1) * 32 + hd];
      const float a0 = d0 * Ah, a1 = d1 * Ah; const float inc = wave_scan_incl(a0 + a1, lane);
      const float acs1 = inc, acs0 = inc - a1, last = __shfl(inc, 63);
      wgtT[wave * 128 + 2 * lane] = d0 * exp_fast(last - acs0); wgtT[wave * 128 + 2 * lane + 1] = d1 * exp_fast(last - acs1);
      ACS[(row0 + 2 * lane) * 32 + hd] = acs0; ACS[(row0 + 2 * lane + 1) * 32 + hd] = acs1; }
#pragma unroll
    for (int i = 0; i < 4; ++i) { const int id = tid + 512 * i, l = id >> 4, ch = id & 15; *(LAS v4u*)(lds + P4_BM + l * P4_BM_PITCH + 16 * ch) = braw[i]; }
    f32x16 acc[2][4];
#pragma unroll
    for (int pt = 0; pt < 2; ++pt)
#pragma unroll
        for (int nt = 0; nt < 4; ++nt) acc[pt][nt] = (f32x16){};
#pragma unroll 1
    for (int hf = 0; hf < 2; ++hf) {
#pragma unroll
        for (int i = 0; i < 8; ++i) { const int id = tid + 512 * i, l = id >> 6, ch = id & 63; *(LAS v4u*)(lds + P4_X + l * P4_X_PITCH + 16 * ch) = xraw[i]; }
        __syncthreads();
        if (hf == 0) {
#pragma unroll
            for (int i = 0; i < 8; ++i) { const int id = tid + 512 * i, l = id >> 6, ch = id & 63; xraw[i] = *(const GAS v4u*)(XC + (row0 + 64 + l) * CONVD + 512 * g + 8 * ch); } }
        { LAS const unsigned char* xt = lds + P4_X; LAS const unsigned char* bm = lds + P4_BM; const int h = lane >> 5;
#pragma unroll
          for (int ks = 0; ks < 4; ++ks) { bf16x8 af[2], bfr[4];
              const f32x4 w0 = *(LAS const f32x4*)(wgtT + wave * 128 + 64 * hf + 16 * ks + 8 * h), w1 = *(LAS const f32x4*)(wgtT + wave * 128 + 64 * hf + 16 * ks + 8 * h + 4);
#pragma unroll
              for (int pt = 0; pt < 2; ++pt) { const v4u xr = __builtin_bit_cast(v4u, tr_frag(xt, P4_X_PITCH, 16 * ks + 8 * h, 16 * ks + 8 * h + 4, 64 * wave + 32 * pt, lane));
                  v4u xw; xw.x = pk2(bflo(xr.x) * w0[0], bfhi(xr.x) * w0[1]); xw.y = pk2(bflo(xr.y) * w0[2], bfhi(xr.y) * w0[3]); xw.z = pk2(bflo(xr.z) * w1[0], bfhi(xr.z) * w1[1]); xw.w = pk2(bflo(xr.w) * w1[2], bfhi(xr.w) * w1[3]);
                  af[pt] = __builtin_bit_cast(bf16x8, xw); }
#pragma unroll
              for (int nt = 0; nt < 4; ++nt) bfr[nt] = tr_frag(bm, P4_BM_PITCH, 64 * hf + 16 * ks + 8 * h, 64 * hf + 16 * ks + 8 * h + 4, 32 * nt, lane);
#pragma unroll
              for (int pt = 0; pt < 2; ++pt)
#pragma unroll
                  for (int nt = 0; nt < 4; ++nt) acc[pt][nt] = mfma32(af[pt], bfr[nt], acc[pt][nt]); } }
        __syncthreads();
    }
    { bf16* ST = (bf16*)(ws + WS_ST) + ((size_t)(b * NCHUNK + c) * SH + 8 * g + wave) * (SP * SN); const int h = lane >> 5, r = lane & 31;
#pragma unroll
      for (int pt = 0; pt < 2; ++pt)
#pragma unroll
          for (int nt = 0; nt < 4; ++nt)
#pragma unroll
              for (int q = 0; q < 16; ++q) ST[(32 * pt + crow(q, h)) * SN + 32 * nt + r] = (bf16)f2bf(acc[pt][nt][q]); }
}
constexpr int P4S_WAVE = 12288, P4S_BS = 0, P4S_CS = 4096, P4S_XS = 8192, P4S_YO = 10240;
__device__ __forceinline__ void p4s_item(unsigned char* ws, float* dout, const float* convw, const float* convb, const float* sconv, const float* sssm, LAS unsigned char* wl, int item, int lane) {
    asm volatile("" : "+v"(lane));
    const int hd = item & 31, b = item >> 5, g = hd >> 3; const size_t row0 = (size_t)MP + (size_t)b * DECS;
    const bf16* XBC = (const bf16*)(ws + WS_XBC); const float* DT = (const float*)(ws + WS_DT); const float* par = (const float*)(ws + WS_PAR); float* YRAW = (float*)(ws + WS_YRAW);
    LAS float* Bs = (LAS float*)(wl + P4S_BS); LAS float* Cs = (LAS float*)(wl + P4S_CS); LAS float* xsl = (LAS float*)(wl + P4S_XS); LAS float* yo = (LAS float*)(wl + P4S_YO);
    float xs[8];
#pragma unroll
    for (int part = 0; part < 5; ++part) {
        const int col = part == 0 ? 64 * hd + lane : (part == 1 ? 2048 + 128 * g + lane : (part == 2 ? 2048 + 128 * g + 64 + lane : (part == 3 ? 2560 + 128 * g + lane : 2560 + 128 * g + 64 + lane)));
        float xa[11];
#pragma unroll
        for (int j = 0; j < 3; ++j) xa[j] = sconv[((size_t)b * 3 + j) * CONVD + col];
#pragma unroll
        for (int i = 0; i < 8; ++i) xa[3 + i] = __uint_as_float((unsigned)XBC[(row0 + i) * CONVD + col] << 16);
        const float w0 = convw[col], w1 = convw[CONVD + col], w2 = convw[2 * CONVD + col], w3 = convw[3 * CONVD + col], bb = convb[col];
#pragma unroll
        for (int i = 0; i < 8; ++i) { const float y = silu1(bb + w0 * xa[i] + w1 * xa[i + 1] + w2 * xa[i + 2] + w3 * xa[i + 3]);
            if (part == 0) { xs[i] = y; xsl[i * 64 + lane] = y; } else if (part == 1) Bs[i * 128 + lane] = y; else if (part == 2) Bs[i * 128 + 64 + lane] = y; else if (part == 3) Cs[i * 128 + lane] = y; else Cs[i * 128 + 64 + lane] = y; }
        if (part == 0 || (hd & 7) == 0) {
#pragma unroll
            for (int j = 0; j < 3; ++j) dout[O_CONVS + ((size_t)b * 3 + j) * CONVD + col] = xa[8 + j]; }
    }
    float dt[8], acs[8]; { const float Ah = -expf(par[PAR_ALOG + hd]); float cs = 0.f;
#pragma unroll
      for (int i = 0; i < 8; ++i) { dt[i] = DT[(row0 + i) * 32 + hd]; cs += dt[i] * Ah; acs[i] = cs; } }
    float cb = 0.f; { const int l = lane >> 3, sx = lane & 7;
#pragma unroll 8
      for (int n = 0; n < 128; n += 4) { const f32x4 c = *(LAS const f32x4*)(Cs + l * 128 + n), bv = *(LAS const f32x4*)(Bs + sx * 128 + n); cb += (c[0] * bv[0] + c[1] * bv[1]) + (c[2] * bv[2] + c[3] * bv[3]); } }
    float y[8]; const float Dk = par[PAR_DSKIP + hd];
#pragma unroll
    for (int l = 0; l < 8; ++l) { float a = Dk * xs[l];
#pragma unroll
        for (int s = 0; s <= l; ++s) a += __shfl(cb, 8 * l + s) * exp_fast(acs[l] - acs[s]) * dt[s] * xs[s];
        y[l] = a; }
    const float* h0 = sssm + ((size_t)b * SH + hd) * (SP * SN); float* hout = dout + O_SSMS + ((size_t)b * SH + hd) * (SP * SN);
    float wg[8], ea[8];
#pragma unroll
    for (int l = 0; l < 8; ++l) { wg[l] = dt[l] * exp_fast(acs[7] - acs[l]); ea[l] = exp_fast(acs[l]); }
    const float ed = ea[7]; const int pp = lane >> 3, nc = lane & 7;
#pragma unroll 2
    for (int it = 0; it < 8; ++it) { const int p = 8 * it + pp;
        f32x4 hv[4], nv[4];
#pragma unroll
        for (int j = 0; j < 4; ++j) { hv[j] = *(const f32x4*)(h0 + p * SN + 16 * nc + 4 * j); nv[j] = hv[j] * ed; }
#pragma unroll
        for (int l = 0; l < 8; ++l) { const float xv = xsl[l * 64 + p] * wg[l]; float d = 0.f;
#pragma unroll
            for (int j = 0; j < 4; ++j) { const f32x4 c = *(LAS const f32x4*)(Cs + l * 128 + 16 * nc + 4 * j), bv = *(LAS const f32x4*)(Bs + l * 128 + 16 * nc + 4 * j);
                d += (c[0] * hv[j][0] + c[1] * hv[j][1]) + (c[2] * hv[j][2] + c[3] * hv[j][3]); nv[j] += bv * xv; }
            d += __shfl_xor(d, 1); d += __shfl_xor(d, 2); d += __shfl_xor(d, 4);
            if (nc == l) yo[l * 64 + p] = d; }
#pragma unroll
        for (int j = 0; j < 4; ++j) *(f32x4*)(hout + p * SN + 16 * nc + 4 * j) = nv[j]; }
#pragma unroll
    for (int l = 0; l < 8; ++l) YRAW[(size_t)(8 * b + l) * DSSM + 64 * hd + lane] = y[l] + ea[l] * yo[l * 64 + lane];
}
__device__ __forceinline__ void p4s_norm_item(unsigned char* ws, const float* ssdn, int item, int lane) {
    asm volatile("" : "+v"(lane));
    const int g = item & 3, i = item >> 2; const size_t row = (size_t)MP + i; const int ch0 = 512 * g + 8 * lane;
    const bf16* Zb = (const bf16*)(ws + WS_Z); bf16* YS = (bf16*)(ws + WS_YS); const float* YRAW = (const float*)(ws + WS_YRAW) + (size_t)i * DSSM + ch0;
    float z[8], y[8]; unpk8(*(const GAS v4u*)(Zb + row * DSSM + ch0), z); const f32x4 ya = *(const f32x4*)YRAW, yb = *(const f32x4*)(YRAW + 4); float ss = 0.f;
    y[0] = ya[0]; y[1] = ya[1]; y[2] = ya[2]; y[3] = ya[3]; y[4] = yb[0]; y[5] = yb[1]; y[6] = yb[2]; y[7] = yb[3];
#pragma unroll
    for (int e = 0; e < 8; ++e) { y[e] *= silu1(z[e]); ss += y[e] * y[e]; }
    ss = wave_sum(ss); const float rs = rsqrtf(ss * (1.f / 512.f) + 1e-6f);
#pragma unroll
    for (int e = 0; e < 8; ++e) y[e] = y[e] * rs * ssdn[ch0 + e];
    *(GAS v4u*)(YS + row * DSSM + ch0) = pk8(y);
}

__device__ __forceinline__ void p5_scan(unsigned char* ws, float* dout, int gtid, int gthreads) {
    bf16* ST = (bf16*)(ws + WS_ST); const float* ACS = (const float*)(ws + WS_ACS);
    for (int gid = gtid; gid < NBATCH * SH * SP * (SN / 8); gid += gthreads) {
        const int nch = gid & 15, p = (gid >> 4) & 63, hd = (gid >> 10) & 31, b = gid >> 15;
        float h[8] = {};
#pragma unroll 4
        for (int c = 0; c < NCHUNK; ++c) {
            GAS v4u* slot = (GAS v4u*)(ST + ((size_t)(b * NCHUNK + c) * SH + hd) * (SP * SN) + p * SN + nch * 8);
            const v4u sv = *slot; *slot = pk8(h);
            const float dec = expf(ACS[((size_t)b * SEQ + (size_t)c * CHUNK + CHUNK - 1) * 32 + hd]);
            float s[8]; unpk8(sv, s);
#pragma unroll
            for (int e = 0; e < 8; ++e) h[e] = dec * h[e] + s[e];
        }
        float* o = dout + O_SSMP + ((size_t)(b * SH + hd) * SP + p) * SN + nch * 8;
        *(f32x4*)o = (f32x4){h[0], h[1], h[2], h[3]}; *(f32x4*)(o + 4) = (f32x4){h[4], h[5], h[6], h[7]};
    }
}

constexpr int P6_C = 0, P6_B = 34816, P6_PITCH = 272, P6_X = 69632, P6_X_PITCH = 192, P6_X_WAVE = 32 * 192, P6_ACS = P6_X + 8 * P6_X_WAVE, P6_DT = P6_ACS + 4096, P6_SSQ = P6_DT + 4096;
static_assert(P6_SSQ + 4096 <= MISC_OFF, "phase 6 LDS map");
__device__ __forceinline__ float half_sum32(float v) {
    v += __shfl_xor(v, 1); v += __shfl_xor(v, 2); v += __shfl_xor(v, 4); v += __shfl_xor(v, 8); v += __shfl_xor(v, 16); return v; }
__device__ __forceinline__ void p6_unit(unsigned char* ws, const float* ssdn, LAS unsigned char* lds, int unit, int tid, int lane, int wave) {
    asm volatile("" : "+v"(tid));
    lane = tid & 63;
    const int g = unit & 3, c = (unit >> 2) & 31, b = unit >> 7; const size_t row0 = (size_t)b * SEQ + (size_t)c * CHUNK;
    const bf16* XC = (const bf16*)(ws + WS_XC); const float* DT = (const float*)(ws + WS_DT); const float* ACS = (const float*)(ws + WS_ACS); const float* par = (const float*)(ws + WS_PAR);
    const bf16* Zb = (const bf16*)(ws + WS_Z); bf16* YS = (bf16*)(ws + WS_YS);
    LAS float* acsT = (LAS float*)(lds + P6_ACS); LAS float* dtT = (LAS float*)(lds + P6_DT); LAS float* ssqT = (LAS float*)(lds + P6_SSQ);
    const int h = lane >> 5, r = lane & 31, hdl = wave, hd = 8 * g + wave;
    __syncthreads();
    v4u craw[4], braw[4], xraw[16];
#pragma unroll
    for (int i = 0; i < 4; ++i) { const int id = tid + 512 * i, l = id >> 4, ch = id & 15;
        craw[i] = *(const GAS v4u*)(XC + (row0 + l) * CONVD + 2560 + 128 * g + 8 * ch); braw[i] = *(const GAS v4u*)(XC + (row0 + l) * CONVD + 2048 + 128 * g + 8 * ch); }
#pragma unroll
    for (int i = 0; i < 16; ++i) { const int id = lane + 64 * i, rr = id >> 3, ch = id & 7; xraw[i] = *(const GAS v4u*)(XC + (row0 + rr) * CONVD + 512 * g + 64 * hdl + 8 * ch); }
    float ta[2], td[2];
#pragma unroll
    for (int i = 0; i < 2; ++i) { const int l = lane + 64 * i; ta[i] = ACS[(row0 + l) * 32 + hd]; td[i] = DT[(row0 + l) * 32 + hd]; }
    const float Dk = par[PAR_DSKIP + hd];
    const float gn0 = ssdn[512 * g + 64 * hdl + r], gn1 = ssdn[512 * g + 64 * hdl + 32 + r];
    const bf16* Hc = (const bf16*)(ws + WS_ST) + ((size_t)(b * NCHUNK + c) * SH + hd) * (SP * SN) + r * SN + 8 * h;
#pragma unroll
    for (int i = 0; i < 4; ++i) { const int id = tid + 512 * i, l = id >> 4, ch = id & 15; *(LAS v4u*)(lds + P6_C + l * P6_PITCH + 16 * ch) = craw[i]; *(LAS v4u*)(lds + P6_B + l * P6_PITCH + 16 * ch) = braw[i]; }
#pragma unroll
    for (int i = 0; i < 2; ++i) { acsT[hdl * 128 + lane + 64 * i] = ta[i]; dtT[hdl * 128 + lane + 64 * i] = td[i]; }
    LAS unsigned char* xb = lds + P6_X + wave * P6_X_WAVE;
    bf16x8 xf[4][2][2];
#pragma unroll
    for (int jb = 0; jb < 4; ++jb) {
#pragma unroll
        for (int i = 0; i < 4; ++i) { const int id = lane + 64 * i, rr = id >> 3, ch = id & 7; *(LAS v4u*)(xb + rr * P6_X_PITCH + 16 * ch) = xraw[4 * jb + i]; }
#pragma unroll
        for (int t = 0; t < 2; ++t)
#pragma unroll
            for (int pt = 0; pt < 2; ++pt) xf[jb][t][pt] = tr_frag(xb, P6_X_PITCH, 16 * t + 4 * h, 16 * t + 8 + 4 * h, 32 * pt, lane);
        asm volatile("s_waitcnt lgkmcnt(0)" ::: "memory");
    }
    __syncthreads();
    const bf16* Zw = Zb + (row0 + (lane >> 3)) * DSSM + 512 * g + 64 * hdl + 8 * (lane & 7);
    v4u zraw[4];
#pragma unroll
    for (int i = 0; i < 4; ++i) zraw[i] = *(const GAS v4u*)(Zw + (size_t)(8 * i) * DSSM);
#pragma unroll 1
    for (int lt = 0; lt < 4; ++lt) {
#pragma unroll
        for (int i = 0; i < 4; ++i) *(LAS v4u*)(xb + (8 * i + (lane >> 3)) * P6_X_PITCH + 16 * (lane & 7)) = zraw[i];
        if (lt < 3) {
#pragma unroll
            for (int i = 0; i < 4; ++i) zraw[i] = *(const GAS v4u*)(Zw + (size_t)(32 * (lt + 1) + 8 * i) * DSSM); }
        f32x16 acc[2]; acc[0] = (f32x16){}; acc[1] = (f32x16){};
        { bf16x8 hf[8], hg[8];
#pragma unroll
          for (int i = 0; i < 8; ++i) { hf[i] = *(const bf16x8*)(Hc + 16 * i); hg[i] = *(const bf16x8*)(Hc + 32 * SN + 16 * i); }
          bf16x8 cfr[8];
#pragma unroll
          for (int ks = 0; ks < 8; ++ks) cfr[ks] = *(LAS const bf16x8*)(lds + P6_C + (32 * lt + r) * P6_PITCH + (16 * ks + 8 * h) * 2);
          __builtin_amdgcn_sched_barrier(0);
#pragma unroll
          for (int ks = 0; ks < 8; ++ks) { acc[0] = mfma32(cfr[ks], hf[ks], acc[0]); acc[1] = mfma32(cfr[ks], hg[ks], acc[1]); }
          __builtin_amdgcn_sched_barrier(0); }
#pragma unroll
        for (int a = 0; a < 4; ++a) { const f32x4 av = *(LAS const f32x4*)(acsT + hdl * 128 + 32 * lt + 8 * a + 4 * h);
#pragma unroll
            for (int k = 0; k < 4; ++k) { const float ea = exp_fast(av[k]); acc[0][4 * a + k] *= ea; acc[1][4 * a + k] *= ea; } }
        const float al = acsT[hdl * 128 + 32 * lt + r];
#pragma unroll
        for (int jb = 0; jb < 4; ++jb) if (jb <= lt) {
            f32x16 X = (f32x16){};
            { bf16x8 bfr[8], cfr[8];
#pragma unroll
              for (int ks = 0; ks < 8; ++ks) { bfr[ks] = *(LAS const bf16x8*)(lds + P6_B + (32 * jb + r) * P6_PITCH + (16 * ks + 8 * h) * 2); cfr[ks] = *(LAS const bf16x8*)(lds + P6_C + (32 * lt + r) * P6_PITCH + (16 * ks + 8 * h) * 2); }
              __builtin_amdgcn_sched_barrier(0);
#pragma unroll
              for (int ks = 0; ks < 8; ++ks) X = mfma32(bfr[ks], cfr[ks], X);
              __builtin_amdgcn_sched_barrier(0); }
            unsigned gp[8];
#pragma unroll
            for (int a = 0; a < 4; ++a) { const f32x4 av = *(LAS const f32x4*)(acsT + hdl * 128 + 32 * jb + 8 * a + 4 * h), dv = *(LAS const f32x4*)(dtT + hdl * 128 + 32 * jb + 8 * a + 4 * h);
                float v[4];
#pragma unroll
                for (int k = 0; k < 4; ++k) { const int sl = 8 * a + 4 * h + k;
                    float gv = X[4 * a + k] * exp_fast(fminf(al - av[k], 0.f)) * dv[k];
                    if (jb == lt) { gv = (sl <= r) ? gv : 0.f; if (sl == r) gv += Dk; }
                    v[k] = gv; }
                gp[2 * a] = pk2(v[0], v[1]); gp[2 * a + 1] = pk2(v[2], v[3]); }
            const bf16x8 g0 = __builtin_bit_cast(bf16x8, (v4u){gp[0], gp[1], gp[2], gp[3]}), g1 = __builtin_bit_cast(bf16x8, (v4u){gp[4], gp[5], gp[6], gp[7]});
#pragma unroll
            for (int pt = 0; pt < 2; ++pt) { acc[pt] = mfma32(g0, xf[jb][0][pt], acc[pt]); acc[pt] = mfma32(g1, xf[jb][1][pt], acc[pt]); }
            __builtin_amdgcn_sched_barrier(0);
        }
        { const int i15 = lane & 15, qq = i15 >> 2, pp = i15 & 3, g16 = (lane >> 4) & 1;
#pragma unroll
          for (int a = 0; a < 4; ++a) { s16x4 zv[2];
#pragma unroll
              for (int pt = 0; pt < 2; ++pt) zv[pt] = ds_tr(xb + (8 * a + 4 * h + qq) * P6_X_PITCH + (32 * pt + 16 * g16 + 4 * pp) * 2);
#pragma unroll
              for (int k = 0; k < 4; ++k) { const int q = 4 * a + k, l = 32 * lt + crow(q, h);
                  const float y0 = acc[0][q] * silu1(__uint_as_float((unsigned)(unsigned short)zv[0][k] << 16)), y1 = acc[1][q] * silu1(__uint_as_float((unsigned)(unsigned short)zv[1][k] << 16)); acc[0][q] = y0; acc[1][q] = y1;
                  const float ss = half_sum32(y0 * y0 + y1 * y1); if (r == 0) ssqT[l * 8 + hdl] = ss; } } }
        __syncthreads();
#pragma unroll
        for (int q = 0; q < 16; ++q) { const int ll = crow(q, h), l = 32 * lt + ll;
            const f32x4 sa = *(LAS const f32x4*)(ssqT + l * 8), sb = *(LAS const f32x4*)(ssqT + l * 8 + 4);
            const float rs = rsqrtf(((sa[0] + sa[1]) + (sa[2] + sa[3]) + (sb[0] + sb[1]) + (sb[2] + sb[3])) * (1.f / 512.f) + 1e-6f);
            *(LAS bf16*)(xb + ll * 144 + r * 2) = (bf16)f2bf(acc[0][q] * rs * gn0); *(LAS bf16*)(xb + ll * 144 + (32 + r) * 2) = (bf16)f2bf(acc[1][q] * rs * gn1); }
#pragma unroll
        for (int i = 0; i < 4; ++i) { const int l2 = 8 * i + (lane >> 3), ch = lane & 7;
            *(GAS v4u*)(YS + (row0 + 32 * lt + l2) * DSSM + 512 * g + 64 * hdl + 8 * ch) = *(LAS const v4u*)(xb + l2 * 144 + 16 * ch); }
    }
}
__device__ __forceinline__ void ptot_item(unsigned char* ws, const float* clogf, const int* ptab, int item, int lane) {
    asm volatile("" : "+v"(lane));
    const int b = item >> 7, pg = item & 127; const int pid = ptab[b * NPAGES + pg];
    const float* src = clogf + (size_t)pid * PAGE * AH; const int h = lane & 15, rg = lane >> 4; float s = 0.f;
#pragma unroll
    for (int i = 0; i < 32; ++i) s += src[(32 * rg + i) * AH + h];
    s += __shfl_xor(s, 16); s += __shfl_xor(s, 32);
    if (lane < 16) ((float*)(ws + WS_PTOT))[(size_t)item * AH + h] = s;
}
__device__ __forceinline__ void cpl_item(unsigned char* ws, const float* clogf, const int* ptab, int item, int lane) {
    asm volatile("" : "+v"(lane));
    const int b = item >> 7, pg = item & 127; const int pid = ptab[b * NPAGES + pg];
    const float* src = clogf + (size_t)pid * PAGE * AH; const float* ptot = (const float*)(ws + WS_PTOT) + (size_t)b * NPAGES * AH;
    const int h = lane & 15, rg = lane >> 4; float off = 0.f;
#pragma unroll 8
    for (int p = rg; p < pg; p += 4) off += ptot[p * AH + h];
    off += __shfl_xor(off, 16); off += __shfl_xor(off, 32);
    float v[32], s = 0.f;
#pragma unroll
    for (int i = 0; i < 32; ++i) { s += src[(32 * rg + i) * AH + h]; v[i] = s; }
    const float t0 = __shfl(s, h), t1 = __shfl(s, 16 + h), t2 = __shfl(s, 32 + h);
    off += (rg > 0 ? t0 : 0.f) + (rg > 1 ? t1 : 0.f) + (rg > 2 ? t2 : 0.f);
    float* dst = (float*)(ws + WS_CPL) + ((size_t)b * PAST + (size_t)pg * PAGE) * AH;
#pragma unroll
    for (int i = 0; i < 32; ++i) dst[(32 * rg + i) * AH + h] = (off + v[i]) * 1.4426950408889634f;
}
__device__ __forceinline__ void ck_item(unsigned char* ws, int item, int lane) {
    asm volatile("" : "+v"(lane));
    const int h = item & 15, b = item >> 4;
    const float* LOGF = (const float*)(ws + WS_LOGF) + ((size_t)b * SEQ + 64 * lane) * AH + h; float* CK = (float*)(ws + WS_CK) + ((size_t)b * AH + h) * SEQ + 64 * lane;
    float v[64], s = 0.f;
#pragma unroll
    for (int i = 0; i < 64; ++i) v[i] = LOGF[(size_t)i * AH];
#pragma unroll
    for (int i = 0; i < 64; ++i) { s += v[i]; v[i] = s; }
    const float off = wave_scan_incl(s, lane) - s;
#pragma unroll
    for (int i = 0; i < 64; i += 4) *(f32x4*)(CK + i) = (f32x4){(off + v[i]) * 1.4426950408889634f, (off + v[i + 1]) * 1.4426950408889634f, (off + v[i + 2]) * 1.4426950408889634f, (off + v[i + 3]) * 1.4426950408889634f};
}
#include <hip/hip_bf16.h>
#include <cmath>
namespace attn_body {
using bf16=__hip_bfloat16;
using bf16x8=__attribute__((ext_vector_type(8)))short;
using s16x4=__attribute__((ext_vector_type(4)))short;
using f32x16=__attribute__((ext_vector_type(16)))float;
using u32x4=__attribute__((ext_vector_type(4)))unsigned;
constexpr int BATCH=4,NHEAD=16,SEQ=4096,D=64,DM=NHEAD*D,KP=256;
constexpr int NW=8,QBLK=32,QB=QBLK*NW,KVBLK=64,NQB=SEQ/QB;
constexpr int ATTN_PITCH=DM, ATTN_UNIT_ROWS=QB;
__device__ __forceinline__ int crow(int r,int hi){return (r&3)+8*(r>>2)+4*hi;}
#define SBAR() __builtin_amdgcn_sched_barrier(0)
__device__ __forceinline__ void cmask(f32x16&p0,f32x16&p1,int jb,int qrel,int hi){
  const float NEG=-INFINITY; int kb=64*jb+4*hi;
  #pragma unroll
  for(int r=0;r<16;++r){int kv=kb+(r&3)+8*(r>>2); if(kv>qrel)p0[r]=NEG; if(kv+32>qrel)p1[r]=NEG;}
}

constexpr int NSLOT=3, SLOTB=8192;
constexpr int LDS_K=0, LDS_V=NSLOT*SLOTB, LDS_WS=2*NSLOT*SLOTB, LDS_OST=LDS_WS+NW*64*4, LDS_CK=LDS_OST+NW*4096, LDS_BYTES=LDS_CK+SEQ*4;
constexpr float C2=0.125f*1.4426950408889634f;
__device__ __forceinline__ void glds16(const void*gsrc,unsigned lds_dst){unsigned keep;
  asm volatile("s_mov_b32 %0, m0\n\ts_mov_b32 m0, %2\n\ts_nop 0\n\tglobal_load_lds_dwordx4 %1, off\n\ts_mov_b32 m0, %0":"=&s"(keep):"v"(gsrc),"s"(lds_dst):"memory");}
__device__ __forceinline__ float max3f(float a,float b,float c){float r;asm("v_max3_f32 %0, %1, %2, %3":"=v"(r):"v"(a),"v"(b),"v"(c));return r;}
__device__ __forceinline__ float max2f(float a,float b){float r;asm("v_max_f32_e32 %0, %1, %2":"=v"(r):"v"(a),"v"(b));return r;}
__device__ __forceinline__ float fadd_s(float a,float b){float r;asm("v_add_f32_e32 %0, %1, %2":"=v"(r):"v"(a),"v"(b));return r;}
__device__ __forceinline__ float fsub_s(float a,float b){float r;asm("v_sub_f32_e32 %0, %1, %2":"=v"(r):"v"(a),"v"(b));return r;}
typedef float f32x2_t __attribute__((ext_vector_type(2))); typedef float f32x4_t __attribute__((ext_vector_type(4))); typedef __bf16 bf16x2_t __attribute__((ext_vector_type(2)));
__device__ __forceinline__ unsigned cvtpk_s(float lo,float hi){f32x2_t v={lo,hi};bf16x2_t b=__builtin_convertvector(v,bf16x2_t);return __builtin_bit_cast(unsigned,b);}
#define WAIT_BAR(N) asm volatile("s_waitcnt vmcnt(" #N ") lgkmcnt(0)\n\ts_barrier":::"memory")

__device__ __forceinline__ void qkt(f32x16&p0,f32x16&p1,const char*Kslot,const bf16x8*qr,int r32,int hi){
  const char*kb=Kslot+hi*1024+r32*16;
  #pragma unroll
  for(int d0=0;d0<4;++d0){
    const bf16x8 b0=*reinterpret_cast<const bf16x8*>(kb+d0*2048);
    const bf16x8 b1=*reinterpret_cast<const bf16x8*>(kb+d0*2048+512);
    {p0=__builtin_amdgcn_mfma_f32_32x32x16_bf16(b0,qr[d0],p0,0,0,0);p1=__builtin_amdgcn_mfma_f32_32x32x16_bf16(b1,qr[d0],p1,0,0,0);}}
}
typedef __attribute__((address_space(3))) char* lds_cptr;
typedef short v4i16_t __attribute__((ext_vector_type(4)));
__device__ __forceinline__ void kload8(bf16x8*kf,lds_cptr kp){
  kf[0]=*(const __attribute__((address_space(3))) bf16x8*)(kp);      kf[1]=*(const __attribute__((address_space(3))) bf16x8*)(kp+512);
  kf[2]=*(const __attribute__((address_space(3))) bf16x8*)(kp+2048); kf[3]=*(const __attribute__((address_space(3))) bf16x8*)(kp+2560);
  kf[4]=*(const __attribute__((address_space(3))) bf16x8*)(kp+4096); kf[5]=*(const __attribute__((address_space(3))) bf16x8*)(kp+4608);
  kf[6]=*(const __attribute__((address_space(3))) bf16x8*)(kp+6144); kf[7]=*(const __attribute__((address_space(3))) bf16x8*)(kp+6656);
}
__device__ __forceinline__ void kload2(bf16x8*kf,lds_cptr kp,int j){ kf[2*j]=*(const __attribute__((address_space(3))) bf16x8*)(kp+j*2048); kf[2*j+1]=*(const __attribute__((address_space(3))) bf16x8*)(kp+j*2048+512); }
__device__ __forceinline__ s16x4 vtr(lds_cptr p){ return __builtin_bit_cast(s16x4,__builtin_amdgcn_ds_read_tr16_b64_v4i16((__attribute__((address_space(3))) v4i16_t*)p)); }
__device__ __forceinline__ float rowmax(const f32x16&p0,const f32x16&p1){
  float a=max3f(p0[0],p0[1],p1[0]),b=max3f(p0[2],p0[3],p1[1]);a=max3f(a,p1[2],p1[3]);
  #pragma unroll
  for(int r=4;r<16;r+=4){a=max3f(a,p0[r],p0[r+1]);b=max3f(b,p0[r+2],p0[r+3]);a=max3f(a,p1[r],p1[r+1]);b=max3f(b,p1[r+2],p1[r+3]);}
  const float m=max2f(a,b);
  auto rr=__builtin_amdgcn_permlane32_swap(__float_as_uint(m),__float_as_uint(m),false,false);
  return max2f(__uint_as_float(rr[0]),__uint_as_float(rr[1]));
}
__device__ __forceinline__ void pv(f32x16*o,int vb,bf16x8 pa0,bf16x8 pa1,bf16x8 pa2,bf16x8 pa3){
  #pragma unroll
  for(int d0=0;d0<2;++d0){s16x4 lo[4],hi[4];
    #pragma unroll
    for(int ks=0;ks<4;++ks){
      asm volatile("ds_read_b64_tr_b16 %0,%1 offset:%c2":"=&v"(lo[ks]):"v"(vb),"i"(d0*4096+ks*1024):"memory");
      asm volatile("ds_read_b64_tr_b16 %0,%1 offset:%c2":"=&v"(hi[ks]):"v"(vb),"i"(d0*4096+ks*1024+512):"memory");}
    asm volatile("s_waitcnt lgkmcnt(0)":::"memory");SBAR();
    #define PK(k) (bf16x8){lo[k][0],lo[k][1],lo[k][2],lo[k][3],hi[k][0],hi[k][1],hi[k][2],hi[k][3]}
    o[d0]=__builtin_amdgcn_mfma_f32_32x32x16_bf16(pa0,PK(0),o[d0],0,0,0);
    o[d0]=__builtin_amdgcn_mfma_f32_32x32x16_bf16(pa1,PK(1),o[d0],0,0,0);
    o[d0]=__builtin_amdgcn_mfma_f32_32x32x16_bf16(pa2,PK(2),o[d0],0,0,0);
    o[d0]=__builtin_amdgcn_mfma_f32_32x32x16_bf16(pa3,PK(3),o[d0],0,0,0);
    #undef PK
  }
}

#ifndef ATTN_STORE16
#define ATTN_STORE16(p,v) (*(u32x4*)(p)=(v))
#endif
template<int THRL> __device__ __forceinline__ void attn_unit(int b,int h,int qb,const bf16*Q,const bf16*__restrict__ K,const bf16*__restrict__ V,bf16*O,const float*__restrict__ CKT,float skip_thr,char*shm){
  int tid_=threadIdx.x; asm volatile("":"+v"(tid_));
  const int tid=tid_,lane=tid&63,r32=lane&31,hi=lane>>5; const int wid=__builtin_amdgcn_readfirstlane(tid>>6);
  const long rowbase=(long)b*SEQ; const int q0=qb*QB;
  const bf16*Qw=Q+(rowbase+q0+wid*QBLK)*DM+h*D;
  const bf16*Kh=K+rowbase*KP+(h>>2)*D,*Vh=V+rowbase*KP+(h>>2)*D;
  const unsigned lds0=(unsigned)(uintptr_t)shm;
  float*wsf=(float*)(shm+LDS_WS)+wid*64;
  const bf16*ksrc=Kh+(long)lane*KP+wid*8;
  const bf16*vsrc=Vh+(long)(16*(wid&3)+(lane>>2))*KP+(wid>>2)*32+(lane&3)*8;
  const unsigned kdst=lds0+LDS_K+wid*1024, vdst=lds0+LDS_V+wid*1024;
  #define DMA_K(t,slot) glds16(ksrc+(long)((t)+t0)*KVBLK*KP,(unsigned)__builtin_amdgcn_readfirstlane(kdst+(slot)))
  #define DMA_V(t,slot) glds16(vsrc+(long)((t)+t0)*KVBLK*KP,(unsigned)__builtin_amdgcn_readfirstlane(vdst+(slot)))
  const int vb0=(int)(lds0+LDS_V)+((lane>>4)&1)*32+(lane&3)*8+(4*hi+((lane&15)>>2))*64;
  const char*Kbase=shm+LDS_K; bf16x8 kf[8];
  const lds_cptr shm3=(lds_cptr)shm; const lds_cptr kp0=shm3+LDS_K+hi*1024+r32*16; const lds_cptr vp0=shm3+LDS_V+((lane>>4)&1)*32+(lane&3)*8+(4*hi+((lane&15)>>2))*64;
  int NT=(q0+QB)/KVBLK;
  { __attribute__((address_space(3))) float*ckt=(__attribute__((address_space(3))) float*)(shm3+LDS_CK); const float*src=CKT+((long)b*NHEAD+h)*SEQ; for(int i=tid;i<q0+QB;i+=NW*64)ckt[i]=-src[i]; }
  asm volatile("s_waitcnt lgkmcnt(0)\n\ts_barrier":::"memory");
  int t0=0; { const __attribute__((address_space(3))) float*ck0=(const __attribute__((address_space(3))) float*)(shm3+LDS_CK); const float cq=ck0[q0];
    int lo=0,hi=NT-4;
    while(lo<hi){ const int mid=(lo+hi)>>1; if(cq-ck0[64*mid+63]>skip_thr)lo=mid+1; else hi=mid; }
    t0=lo&~1; }
  NT-=t0;
  const __attribute__((address_space(3))) float*ckt3=(const __attribute__((address_space(3))) float*)(shm3+LDS_CK)+64*t0;
  #define LDBIAS(C0,C1,t) do{ const __attribute__((address_space(3))) float*cp_=ckt3+64*(t)+4*hi; \
    _Pragma("unroll") for(int a_=0;a_<4;++a_){ const f32x4_t v0_=*(const __attribute__((address_space(3))) f32x4_t*)(cp_+8*a_), v1_=*(const __attribute__((address_space(3))) f32x4_t*)(cp_+32+8*a_); \
      _Pragma("unroll") for(int b_=0;b_<4;++b_){ C0[4*a_+b_]=v0_[b_]; C1[4*a_+b_]=v1_[b_]; } } }while(0)
  DMA_K(0,0);DMA_V(0,0);DMA_K(1,SLOTB);
  bf16x8 qr[4];
  #pragma unroll
  for(int d0=0;d0<4;++d0)qr[d0]=*reinterpret_cast<const bf16x8*>(&Qw[(long)r32*DM+d0*16+hi*8]);
  float mhat=0.f,l_reg=0.f;f32x16 o[2];o[0]=f32x16{};o[1]=f32x16{};
  const int qrel=wid*QBLK+r32;
  #define CMASK(P0,P1,t) do{int jb_=(t)-(NT-4); if(jb_>=0)cmask(P0,P1,jb_,qrel,hi);}while(0)
  bool resc=false;
  #define START(P0,P1) do{ const float rm=rowmax(P0,P1); resc=false; \
    { const float dl=rm; mhat=fadd_s(mhat,dl); \
      _Pragma("unroll") for(int r=0;r<16;++r){P0[r]=fsub_s(P0[r],dl);P1[r]=fsub_s(P1[r],dl);} \
      } \
    _Pragma("unroll") for(int r=0;r<16;++r)P0[r]=__builtin_amdgcn_exp2f(P0[r]); }while(0)
  #define RESC() do{ if(resc){ asm volatile("s_waitcnt lgkmcnt(0)":::"memory"); \
      _Pragma("unroll") for(int d_=0;d_<2;++d_) _Pragma("unroll") for(int r=0;r<16;++r)o[d_][r]*=wsf[crow(r,hi)]; } }while(0)
  f32x16 pA0,pA1,pB0,pB1;
  int sl_prev=0,sl_cur=0,sl_next=SLOTB;
  #define ROT() do{sl_prev=sl_cur;sl_cur=sl_next;sl_next=(sl_next==(NSLOT-1)*SLOTB)?0:sl_next+SLOTB;}while(0)
  DMA_K(2,2*SLOTB);
  WAIT_BAR(3);
  LDBIAS(pA0,pA1,0); qkt(pA0,pA1,Kbase,qr,r32,hi);asm volatile("s_nop 15\n\ts_nop 7":"+v"(pA0),"+v"(pA1));CMASK(pA0,pA1,0);
  START(pA0,pA1);
  _Pragma("unroll") for(int r=0;r<16;++r)pA1[r]=__builtin_amdgcn_exp2f(pA1[r]);
  LDBIAS(pB0,pB1,1);
  WAIT_BAR(0);
  DMA_K(3,0);DMA_V(1,SLOTB);
  ROT();
  kload8(kf,kp0+sl_cur);
  WAIT_BAR(2);
  s16x4 vlo[8],vhi[8]; u32x4 pw0,pw1,pw2,pw3;
  #define PKW(P,B) cvtpk_s(P[B],P[B+1])
  #define PAF(k) __builtin_bit_cast(bf16x8,pw##k)
  #define VFR(i) (bf16x8){vlo[i][0],vlo[i][1],vlo[i][2],vlo[i][3],vhi[i][0],vhi[i][1],vhi[i][2],vhi[i][3]}
  #define PIN(x) asm volatile("":"+v"(x))
  #define MX3(a,b,c) __builtin_fmaxf(__builtin_fmaxf((a),(b)),(c))
  #define GAPA(MF,A0,A1,A2,A3,W0,W1,PW) do{ MF; sacc+=A0; sacc+=A1; sacc+=A2; sacc+=A3; PIN(sacc); W0; W1; PIN(PW); SBAR(); }while(0)
  #define EX(v) __builtin_amdgcn_exp2f(v)
  #define GAPB(MF,X,B) do{ MF; X[B]=EX(X[B]-mh_); X[B+1]=EX(X[B+1]-mh_); X[B+2]=EX(X[B+2]-mh_); X[B+3]=EX(X[B+3]-mh_); PIN(X); SBAR(); }while(0)
  #define VRD(i) do{ vlo[i]=vtr(vp_+(((i)>>2)*4096+((i)&3)*1024)); vhi[i]=vtr(vp_+(((i)>>2)*4096+((i)&3)*1024+512)); }while(0)
  #define KRD(G,j) do{ if(G){ kload2(kf,kp0+sl_next,j); SBAR(); } }while(0)
  #define STEP(C0,C1,P0,P1,t,GK,GV,GL) do{ SBAR(); \
    const lds_cptr vp_=vp0+sl_prev; \
    VRD(0); SBAR(); float sacc=(P0[0]+P0[1]); \
    GAPA(C0=__builtin_amdgcn_mfma_f32_32x32x16_bf16(kf[0],qr[0],C0,0,0,0), P0[2],P0[3],P0[4],P0[5],     pw0[0]=PKW(P0,0), pw0[1]=PKW(P0,2), pw0); \
    VRD(4); SBAR(); GAPA(C1=__builtin_amdgcn_mfma_f32_32x32x16_bf16(kf[1],qr[0],C1,0,0,0), P0[6],P0[7],P0[8],P0[9],     pw0[2]=PKW(P0,4), pw0[3]=PKW(P0,6), pw0); \
    VRD(1); SBAR(); GAPA(C0=__builtin_amdgcn_mfma_f32_32x32x16_bf16(kf[2],qr[1],C0,0,0,0),   P0[10],P0[11],P0[12],P0[13], pw1[0]=PKW(P0,8), pw1[1]=PKW(P0,10), pw1); \
    VRD(5); SBAR(); GAPA(C1=__builtin_amdgcn_mfma_f32_32x32x16_bf16(kf[3],qr[1],C1,0,0,0),   P0[14],P0[15],P1[0],P1[1],   pw1[2]=PKW(P0,12),pw1[3]=PKW(P0,14), pw1); \
    VRD(2); SBAR(); GAPA(C0=__builtin_amdgcn_mfma_f32_32x32x16_bf16(kf[4],qr[2],C0,0,0,0),   P1[2],P1[3],P1[4],P1[5],     pw2[0]=PKW(P1,0), pw2[1]=PKW(P1,2), pw2); \
    VRD(6); SBAR(); GAPA(C1=__builtin_amdgcn_mfma_f32_32x32x16_bf16(kf[5],qr[2],C1,0,0,0),   P1[6],P1[7],P1[8],P1[9],     pw2[2]=PKW(P1,4), pw2[3]=PKW(P1,6), pw2); \
    VRD(3); SBAR(); GAPA(C0=__builtin_amdgcn_mfma_f32_32x32x16_bf16(kf[6],qr[3],C0,0,0,0),   P1[10],P1[11],P1[12],P1[13], pw3[0]=PKW(P1,8), pw3[1]=PKW(P1,10), pw3); \
    VRD(7); SBAR(); GAPA(C1=__builtin_amdgcn_mfma_f32_32x32x16_bf16(kf[7],qr[3],C1,0,0,0),   P1[14],P1[15],0.f,0.f,       pw3[2]=PKW(P1,12),pw3[3]=PKW(P1,14), pw3); \
    l_reg+=sacc; \
    if(GK){DMA_K((t)+3,sl_cur);} if(GV){DMA_V((t)+1,sl_next);} \
    CMASK(C0,C1,t); \
    { float a=MX3(C0[0],C0[1],C1[0]),b=MX3(C0[2],C0[3],C1[1]); a=MX3(a,C1[2],C1[3]); \
      _Pragma("unroll") for(int r=4;r<16;r+=4){a=MX3(a,C0[r],C0[r+1]);b=MX3(b,C0[r+2],C0[r+3]);a=MX3(a,C1[r],C1[r+1]);b=MX3(b,C1[r+2],C1[r+3]);} \
      float rm=__builtin_fmaxf(a,b); { auto rr=__builtin_amdgcn_permlane32_swap(__float_as_uint(rm),__float_as_uint(rm),false,false); rm=__builtin_fmaxf(__uint_as_float(rr[0]),__uint_as_float(rr[1])); } \
      resc=false; \
      rm-=mhat; \
      if(__builtin_expect(__any(rm>(float)THRL),0)){ const float dl=__builtin_fmaxf(rm,0.f); mhat+=dl; \
        const float f=__builtin_amdgcn_exp2f(-dl); l_reg*=f; if(hi==0)wsf[r32]=f; resc=true; } } \
    const float mh_=mhat; if(GL){ LDBIAS(P0,P1,(t)+1); } SBAR(); \
    GAPB(o[0]=__builtin_amdgcn_mfma_f32_32x32x16_bf16(PAF(0),VFR(0),o[0],0,0,0), C0,0); \
    GAPB(o[1]=__builtin_amdgcn_mfma_f32_32x32x16_bf16(PAF(0),VFR(4),o[1],0,0,0), C0,4); \
    KRD(GL,0); GAPB(o[0]=__builtin_amdgcn_mfma_f32_32x32x16_bf16(PAF(1),VFR(1),o[0],0,0,0), C0,8); \
    KRD(GL,1); GAPB(o[1]=__builtin_amdgcn_mfma_f32_32x32x16_bf16(PAF(1),VFR(5),o[1],0,0,0), C0,12); \
    KRD(GL,2); GAPB(o[0]=__builtin_amdgcn_mfma_f32_32x32x16_bf16(PAF(2),VFR(2),o[0],0,0,0), C1,0); \
    KRD(GL,3); GAPB(o[1]=__builtin_amdgcn_mfma_f32_32x32x16_bf16(PAF(2),VFR(6),o[1],0,0,0), C1,4); \
    GAPB(o[0]=__builtin_amdgcn_mfma_f32_32x32x16_bf16(PAF(3),VFR(3),o[0],0,0,0), C1,8); \
    GAPB(o[1]=__builtin_amdgcn_mfma_f32_32x32x16_bf16(PAF(3),VFR(7),o[1],0,0,0), C1,12); \
    }while(0)
  int t=1;
  #undef CMASK
  #define CMASK(P0,P1,t) do{}while(0)
  for(;t+5<NT;t+=2){
    STEP(pB0,pB1,pA0,pA1,t,true,true,true);     WAIT_BAR(2); RESC(); ROT();
    STEP(pA0,pA1,pB0,pB1,t+1,true,true,true);   WAIT_BAR(2); RESC(); ROT();
  }
  #undef CMASK
  #define CMASK(P0,P1,t) do{int jb_=(t)-(NT-4); if(jb_>=0)cmask(P0,P1,jb_,qrel,hi);}while(0)
  #define ENDW(tt) do{ if((tt)+3<NT){WAIT_BAR(2);} else if((tt)+2<NT){WAIT_BAR(1);} else {WAIT_BAR(0);} }while(0)
  for(;t+1<NT;t+=2){
    STEP(pB0,pB1,pA0,pA1,t,(t+3<NT),(t+1<NT),(t+1<NT));       ENDW(t);   RESC(); ROT();
    STEP(pA0,pA1,pB0,pB1,t+1,(t+4<NT),(t+2<NT),(t+2<NT));     ENDW(t+1); RESC(); ROT();
  }
  STEP(pB0,pB1,pA0,pA1,NT-1,false,false,false); RESC();
  { float sacc=pB0[0]+pB0[1]; _Pragma("unroll") for(int r=2;r<16;++r)sacc+=pB0[r]; _Pragma("unroll") for(int r=0;r<16;++r)sacc+=pB1[r]; l_reg+=sacc;
    pw0=(u32x4){PKW(pB0,0),PKW(pB0,2),PKW(pB0,4),PKW(pB0,6)};pw1=(u32x4){PKW(pB0,8),PKW(pB0,10),PKW(pB0,12),PKW(pB0,14)};pw2=(u32x4){PKW(pB1,0),PKW(pB1,2),PKW(pB1,4),PKW(pB1,6)};pw3=(u32x4){PKW(pB1,8),PKW(pB1,10),PKW(pB1,12),PKW(pB1,14)};
    SBAR(); pv(o,vb0+sl_cur,PAF(0),PAF(1),PAF(2),PAF(3)); }
  #undef PKW
  #undef PAF
  #undef VFR
  #undef PIN
  #undef MX3
  #undef GAPA
  #undef GAPB
  #undef EX
  #undef VRD
  #undef KRD
  #undef STEP
  #undef ENDW
  {auto rr=__builtin_amdgcn_permlane32_swap(__float_as_uint(l_reg),__float_as_uint(l_reg),false,false);l_reg=__uint_as_float(rr[0])+__uint_as_float(rr[1]);}
  if(hi==0)wsf[32+r32]=l_reg;asm volatile("s_waitcnt lgkmcnt(0)":::"memory");
  float rli[16];
  #pragma unroll
  for(int r=0;r<16;++r)rli[r]=__builtin_amdgcn_rcpf(wsf[32+crow(r,hi)]);
  bf16*Ow=O+(rowbase+q0+wid*QBLK)*DM+h*D;
  { bf16*stg=(bf16*)(shm+LDS_OST)+wid*2048;
    #pragma unroll
    for(int r=0;r<16;++r){const int orow=crow(r,hi);
      #pragma unroll
      for(int d0=0;d0<2;++d0)stg[orow*64+d0*32+r32]=__float2bfloat16(o[d0][r]*rli[r]);}
    asm volatile("s_waitcnt lgkmcnt(0)":::"memory");
    #pragma unroll
    for(int i=0;i<4;++i){const int row=i*8+(lane>>3),ch=lane&7; const u32x4 v=*(const u32x4*)(stg+row*64+ch*8); ATTN_STORE16(Ow+(long)row*DM+ch*8,v);} }
  asm volatile("s_waitcnt lgkmcnt(0)\n\ts_barrier":::"memory");
  #undef DMA_K
  #undef DMA_V
  #undef CMASK
  #undef START
  #undef RESC
  #undef ROT
}
constexpr int ATTN_LDS_BYTES=LDS_BYTES;
struct AttnTensors { const bf16* Q; const bf16* K; const bf16* V; bf16* O; const float* CKT; };
template<int THRL=8> __device__ __forceinline__ void attn_phase(char*lds,const AttnTensors&T,float skip_thr,int vcu,int G,int i_lo,int i_hi){
  for(int cl=vcu;cl<BATCH*NHEAD*4;cl+=G){ const int s=cl&3,bh=cl>>2;
    #pragma unroll 1
    for(int i=i_lo;i<i_hi;++i){ const int qb=(i==0)?s:(i==1)?7-s:(i==2)?8+s:15-s; attn_unit<THRL>(bh/NHEAD,bh%NHEAD,qb,T.Q,T.K,T.V,T.O,T.CKT,skip_thr,lds); } }
}
#undef SBAR
#undef WAIT_BAR
}
constexpr int DK_OFF = 0, DK_PITCH = 144, DK_HEAD = 64 * 144, DV_OFF = 4 * DK_HEAD, DV_PITCH = 192, DV_HEAD = 64 * 192, DC_OFF = DV_OFF + 4 * DV_HEAD, DW_OFF = DC_OFF + 4096;
constexpr int DPART_STRIDE = 32 + 32 + 32 * 64;
static_assert(DW_OFF + 2048 <= MISC_OFF, "decode LDS map");
__device__ __forceinline__ void dec_unit(unsigned char* ws, const float* ck, const float* cv, const int* ptab, LAS unsigned char* lds, int unit, int tid, int lane, int wave) {
    asm volatile("" : "+v"(tid));
    lane = tid & 63;
    const int b = unit & 31, sp = unit >> 5; const int kvh = wave >> 1, kh = wave & 1, h = lane >> 5, r = lane & 31, g = r >> 3, qi = r & 7, hq = 4 * kvh + g;
    const int tile0 = sp < 4 ? 35 * sp : (sp == 4 ? 140 : (sp == 5 ? 176 : (sp == 6 ? 212 : 238))), ntile = sp < 4 ? 35 : (sp < 6 ? 36 : (sp == 6 ? 26 : 18));
    const bf16* Qb = (const bf16*)(ws + WS_Q); const float* CPL = (const float*)(ws + WS_CPL) + ((size_t)b * PAST + (size_t)tile0 * 64) * AH;
    bf16x8 qf[4];
#pragma unroll
    for (int ks = 0; ks < 4; ++ks) qf[ks] = *(const bf16x8*)(Qb + ((size_t)MP + 8 * b + qi) * 1024 + hq * 64 + 16 * ks + 8 * h);
    float m;
    { const bf16* Kb = (const bf16*)(ws + WS_K) + ((size_t)MP + 8 * b + qi) * 256 + kvh * 64; const bf16* Qr = Qb + ((size_t)MP + 8 * b + qi) * 1024 + hq * 64; float d = 0.f;
#pragma unroll
      for (int k = 0; k < 8; ++k) { float qa[8], ka[8]; unpk8(*(const GAS v4u*)(Qr + 8 * k), qa); unpk8(*(const GAS v4u*)(Kb + 8 * k), ka);
#pragma unroll
          for (int e = 0; e < 8; ++e) d += qa[e] * ka[e]; }
      const float* LOGF = (const float*)(ws + WS_LOGF) + ((size_t)MP + 8 * b) * AH + hq; float cum = ((const float*)(ws + WS_CPL))[((size_t)b * PAST + PAST - 1) * AH + hq];
      for (int k = 0; k <= qi; ++k) cum += LOGF[k * AH] * 1.4426950408889634f;
      m = d - cum; }
    float l = 0.f; f32x16 o[2]; o[0] = (f32x16){}; o[1] = (f32x16){};
    LAS float* wsf = (LAS float*)(lds + DW_OFF) + wave * 64; LAS unsigned* flg = (LAS unsigned*)(lds + DW_OFF + 2048 - 16);
    f32x4 kr[8], vr[8], cr;
    __syncthreads();
    if (tid == 0) { flg[0] = 0u; flg[1] = 0u; }
    { const int ta = tile0 + ntile - 1; const int pid = ptab[b * NPAGES + (ta >> 1)]; const float* kb = ck + ((size_t)pid * PAGE + 64 * (ta & 1)) * 256;
#pragma unroll
      for (int i = 0; i < 8; ++i) kr[i] = *(const GAS f32x4*)(kb + 4 * (tid + 512 * i));
      if (tid < 256) cr = *(const GAS f32x4*)(CPL + (size_t)(ntile - 1) * 64 * AH + 4 * tid); }
    bool vhave = false;
#pragma unroll 1
    for (int tt = ntile - 1; tt >= 0; --tt) {
#pragma unroll
        for (int i = 0; i < 8; ++i) { const int idx = tid + 512 * i, tok = idx >> 6, w = idx & 63, hh = w >> 4, d = (w & 15) * 4;
            *(LAS v2u*)(lds + DK_OFF + hh * DK_HEAD + tok * DK_PITCH + d * 2) = (v2u){pk2(kr[i][0], kr[i][1]), pk2(kr[i][2], kr[i][3])}; }
        if (vhave) {
#pragma unroll
            for (int i = 0; i < 8; ++i) { const int idx = tid + 512 * i, tok = idx >> 6, w = idx & 63, hh = w >> 4, d = (w & 15) * 4;
                *(LAS v2u*)(lds + DV_OFF + hh * DV_HEAD + tok * DV_PITCH + d * 2) = (v2u){pk2(vr[i][0], vr[i][1]), pk2(vr[i][2], vr[i][3])}; } }
        if (tid < 256) *(LAS f32x4*)(lds + DC_OFF + 16 * tid) = cr;
        if (tid == 0) flg[(tt + 1) & 1] = 0u;
        __syncthreads();
        if (tt > 0) { const int t1 = tt - 1, ta = tile0 + t1; const int pid = ptab[b * NPAGES + (ta >> 1)]; const float* kb = ck + ((size_t)pid * PAGE + 64 * (ta & 1)) * 256;
#pragma unroll
            for (int i = 0; i < 8; ++i) kr[i] = *(const GAS f32x4*)(kb + 4 * (tid + 512 * i));
            if (tid < 256) cr = *(const GAS f32x4*)(CPL + (size_t)t1 * 64 * AH + 4 * tid); }
        f32x16 s; const LAS float* cp = (const LAS float*)(lds + DC_OFF);
#pragma unroll
        for (int q = 0; q < 16; ++q) s[q] = -cp[(32 * kh + crow(q, h)) * AH + hq];
#pragma unroll
        for (int ks = 0; ks < 4; ++ks) { const bf16x8 kf = *(LAS const bf16x8*)(lds + DK_OFF + kvh * DK_HEAD + (32 * kh + r) * DK_PITCH + (16 * ks + 8 * h) * 2); s = mfma32(kf, qf[ks], s); }
        float tm = s[0];
#pragma unroll
        for (int q = 1; q < 16; ++q) tm = fmaxf(tm, s[q]);
        { auto rr = __builtin_amdgcn_permlane32_swap(__float_as_uint(tm), __float_as_uint(tm), false, false); tm = fmaxf(__uint_as_float(rr[0]), __uint_as_float(rr[1])); }
        const bool need = __any(tm - m >= -152.f);
        if (need && lane == 0) flg[tt & 1] = 1u;
        __syncthreads();
        const bool need_any = (flg[tt & 1] != 0u);
        if (need_any) {
            if (!vhave) {
                const int ta = tile0 + tt; const int pid = ptab[b * NPAGES + (ta >> 1)]; const float* vb = cv + ((size_t)pid * PAGE + 64 * (ta & 1)) * 256;
#pragma unroll
                for (int i = 0; i < 8; ++i) vr[i] = *(const GAS f32x4*)(vb + 4 * (tid + 512 * i));
#pragma unroll
                for (int i = 0; i < 8; ++i) { const int idx = tid + 512 * i, tok = idx >> 6, w = idx & 63, hh = w >> 4, d = (w & 15) * 4;
                    *(LAS v2u*)(lds + DV_OFF + hh * DV_HEAD + tok * DV_PITCH + d * 2) = (v2u){pk2(vr[i][0], vr[i][1]), pk2(vr[i][2], vr[i][3])}; }
                __syncthreads();
            }
            if (tt > 0) { const int ta = tile0 + tt - 1; const int pid = ptab[b * NPAGES + (ta >> 1)]; const float* vb = cv + ((size_t)pid * PAGE + 64 * (ta & 1)) * 256;
#pragma unroll
                for (int i = 0; i < 8; ++i) vr[i] = *(const GAS f32x4*)(vb + 4 * (tid + 512 * i)); }
            if (need) {
                const float mn = fmaxf(m, tm), alpha = __builtin_amdgcn_exp2f(m - mn); m = mn;
                float ps = 0.f;
#pragma unroll
                for (int q = 0; q < 16; ++q) { s[q] = __builtin_amdgcn_exp2f(s[q] - mn); ps += s[q]; }
                l = l * alpha + ps;
                if (h == 0) wsf[r] = alpha;
                unsigned pp[8];
#pragma unroll
                for (int q = 0; q < 16; q += 2) pp[q >> 1] = pk2(s[q], s[q + 1]);
                const bf16x8 p0 = __builtin_bit_cast(bf16x8, (v4u){pp[0], pp[1], pp[2], pp[3]}), p1 = __builtin_bit_cast(bf16x8, (v4u){pp[4], pp[5], pp[6], pp[7]});
#pragma unroll
                for (int q = 0; q < 16; ++q) { const float a = wsf[crow(q, h)]; o[0][q] *= a; o[1][q] *= a; }
                LAS const unsigned char* vt = lds + DV_OFF + kvh * DV_HEAD;
#pragma unroll
                for (int dt = 0; dt < 2; ++dt) { const bf16x8 v0 = tr_frag(vt, DV_PITCH, 32 * kh + 4 * h, 32 * kh + 8 + 4 * h, 32 * dt, lane), v1 = tr_frag(vt, DV_PITCH, 32 * kh + 16 + 4 * h, 32 * kh + 24 + 4 * h, 32 * dt, lane);
                    o[dt] = mfma32(p0, v0, o[dt]); o[dt] = mfma32(p1, v1, o[dt]); }
            }
        }
        vhave = need_any && tt > 0;
        __syncthreads();
    }
    { auto rr = __builtin_amdgcn_permlane32_swap(__float_as_uint(l), __float_as_uint(l), false, false); l = __uint_as_float(rr[0]) + __uint_as_float(rr[1]); }
    float* part = (float*)(ws + WS_DPART) + ((size_t)(b * KVH + kvh) * 16 + 2 * sp + kh) * DPART_STRIDE;
    if (h == 0) { part[r] = m; part[32 + r] = l; }
#pragma unroll
    for (int dt = 0; dt < 2; ++dt)
#pragma unroll
        for (int q = 0; q < 16; ++q) part[64 + crow(q, h) * 64 + 32 * dt + r] = o[dt][q];
}

__device__ __forceinline__ void dec_combine(unsigned char* ws, int unit, int tid) {
    asm volatile("" : "+v"(tid));
    const int b = unit >> 2, kvh = unit & 3, j = tid >> 4, dq = tid & 15, g = j >> 3, qi = j & 7, hq = 4 * kvh + g;
    const bf16* Qb = (const bf16*)(ws + WS_Q); const bf16* Kb = (const bf16*)(ws + WS_K); const bf16* Vb = (const bf16*)(ws + WS_V); bf16* YA = (bf16*)(ws + WS_YA);
    const float* LOGF = (const float*)(ws + WS_LOGF); const float* CPL = (const float*)(ws + WS_CPL);
    const float* part = (const float*)(ws + WS_DPART) + (size_t)(b * KVH + kvh) * 16 * DPART_STRIDE;
    const size_t rq = (size_t)MP + 8 * b + qi;
    const v2u qw = *(const GAS v2u*)(Qb + rq * 1024 + hq * 64 + 4 * dq); const float q0 = bflo(qw.x), q1 = bfhi(qw.x), q2 = bflo(qw.y), q3 = bfhi(qw.y);
    float sn[8]; float cum = CPL[((size_t)b * PAST + PAST - 1) * AH + hq];
#pragma unroll
    for (int jj = 0; jj < 8; ++jj) { const size_t rk = (size_t)MP + 8 * b + jj; cum += LOGF[rk * AH + hq] * 1.4426950408889634f;
        const v2u kw = *(const GAS v2u*)(Kb + rk * 256 + kvh * 64 + 4 * dq); float d = q0 * bflo(kw.x) + q1 * bfhi(kw.x) + q2 * bflo(kw.y) + q3 * bfhi(kw.y);
        d += __shfl_xor(d, 1); d += __shfl_xor(d, 2); d += __shfl_xor(d, 4); d += __shfl_xor(d, 8);
        sn[jj] = (jj <= qi) ? d - cum : -1e30f; }
    float mp[16], M = -1e30f;
#pragma unroll
    for (int n = 0; n < 16; ++n) { mp[n] = part[(size_t)n * DPART_STRIDE + j]; M = fmaxf(M, mp[n]); }
#pragma unroll
    for (int jj = 0; jj < 8; ++jj) M = fmaxf(M, sn[jj]);
    float L = 0.f; f32x4 O = (f32x4){0.f, 0.f, 0.f, 0.f};
#pragma unroll
    for (int n = 0; n < 16; ++n) { const float w = __builtin_amdgcn_exp2f(mp[n] - M); L += w * part[(size_t)n * DPART_STRIDE + 32 + j];
        O += *(const f32x4*)(part + (size_t)n * DPART_STRIDE + 64 + j * 64 + 4 * dq) * w; }
#pragma unroll
    for (int jj = 0; jj < 8; ++jj) { const float w = __builtin_amdgcn_exp2f(sn[jj] - M); L += w; const size_t rk = (size_t)MP + 8 * b + jj;
        const v2u vw = *(const GAS v2u*)(Vb + rk * 256 + kvh * 64 + 4 * dq); O += (f32x4){bflo(vw.x), bfhi(vw.x), bflo(vw.y), bfhi(vw.y)} * w; }
    const float il = 1.f / L;
    *(GAS v2u*)(YA + rq * 1024 + hq * 64 + 4 * dq) = (v2u){pk2(O[0] * il, O[1] * il), pk2(O[2] * il, O[3] * il)};
}
template <bool OUT8 = false> struct SResidT {
    const float* resF; const bf16* resB; float* outF; bf16* outB; pg8::ssq_t* ssq; float alpha;
    __device__ __forceinline__ void operator()(int row, int col, f32x4 v, int t) const {
        f32x4 rr; if (resF) rr = *(const f32x4*)(resF + (size_t)row * 1024 + col); else { const v2u w = *(const GAS v2u*)(resB + (size_t)row * 1024 + col); rr = (f32x4){bflo(w.x), bfhi(w.x), bflo(w.y), bfhi(w.y)}; }
        const f32x4 o = rr + v * alpha;
        if (outF) *(f32x4*)(outF + (size_t)row * 1024 + col) = o;
        if (outB) *(GAS v2u*)(outB + (size_t)row * 1024 + col) = (v2u){pk2(o[0], o[1]), pk2(o[2], o[3])};
        if constexpr (OUT8) { int w = 0; const f32x4 q = o * pg8::H2_F8_SCALE; w = __builtin_amdgcn_cvt_pk_fp8_f32(__builtin_amdgcn_fmed3f(q[0], -448.f, 448.f), __builtin_amdgcn_fmed3f(q[1], -448.f, 448.f), w, false);
            w = __builtin_amdgcn_cvt_pk_fp8_f32(__builtin_amdgcn_fmed3f(q[2], -448.f, 448.f), __builtin_amdgcn_fmed3f(q[3], -448.f, 448.f), w, true);
            *(GAS unsigned*)((unsigned char*)outB + ((WS_H2F8 + (size_t)MP * 1024) - (WS_XB + (size_t)MP * 2048)) + (size_t)row * 1024 + col) = (unsigned)w; }
        if (ssq) { float s = (o[0] * o[0] + o[1] * o[1]) + (o[2] * o[2] + o[3] * o[3]); s += __shfl_xor(s, 1); s += __shfl_xor(s, 2); s += __shfl_xor(s, 4);
            if ((t & 7) == 0) __hip_atomic_fetch_add(ssq + row, pg8::ssq_fx(s), __ATOMIC_RELAXED, __HIP_MEMORY_SCOPE_AGENT); } }
};
using SResid = SResidT<false>;
struct SGateMul { const bf16* G; bf16* MPo;
    __device__ __forceinline__ void operator()(int row, int col, f32x4 v, int) const { const v2u g = *(const GAS v2u*)(G + (size_t)row * 1024 + col);
        const f32x4 o = (f32x4){bflo(g.x), bfhi(g.x), bflo(g.y), bfhi(g.y)} * v; *(GAS v2u*)(MPo + (size_t)row * 1024 + col) = (v2u){pk2(o[0], o[1]), pk2(o[2], o[3])}; } };
struct SGateAdd { const bf16* G; const bf16* MPi; bf16* O;
    __device__ __forceinline__ void operator()(int row, int col, f32x4 v, int) const { const v2u g = *(const GAS v2u*)(G + (size_t)row * 1024 + col), m = *(const GAS v2u*)(MPi + (size_t)row * 1024 + col);
        const f32x4 o = (f32x4){bflo(m.x), bfhi(m.x), bflo(m.y), bfhi(m.y)} + (f32x4){bflo(g.x), bfhi(g.x), bflo(g.y), bfhi(g.y)} * v;
        *(GAS v2u*)(O + (size_t)row * 1024 + col) = (v2u){pk2(o[0], o[1]), pk2(o[2], o[3])}; } };
template <int K, class Epi> __device__ __forceinline__ void smallm_phase(const bf16* A, const bf16* Bt, LAS unsigned char* lds, const Epi& E, int G) {
    int tid = threadIdx.x; asm volatile("" : "+v"(tid));
    const int lane = tid & 63, wave = __builtin_amdgcn_readfirstlane(tid >> 6), r = lane & 31, h = lane >> 5;
    constexpr int KW = K / 8, NS = KW / 16;
    LAS float* red = (LAS float*)lds;
    for (int tile = (int)blockIdx.x; tile < 256; tile += G) {
        const int tm = tile >> 5, tn = tile & 31;
        const bf16* ap = A + (size_t)(32 * tm + r) * K + wave * KW + 8 * h; const bf16* bp = Bt + (size_t)(32 * tn + r) * K + wave * KW + 8 * h;
        f32x16 acc = (f32x16){};
        constexpr int UN = (NS % 11 == 0) ? 11 : 8;
#pragma unroll 1
        for (int k0 = 0; k0 < NS; k0 += UN) { bf16x8 a[UN], b[UN];
#pragma unroll
            for (int k = 0; k < UN; ++k) { a[k] = *(const bf16x8*)(ap + 16 * (k0 + k)); b[k] = *(const bf16x8*)(bp + 16 * (k0 + k)); }
#pragma unroll
            for (int k = 0; k < UN; ++k) acc = mfma32(a[k], b[k], acc); }
        __syncthreads();
#pragma unroll
        for (int q = 0; q < 16; ++q) red[(wave * 32 + crow(q, h)) * 33 + r] = acc[q];
        __syncthreads();
        if (tid < 256) { const int row = tid >> 3, c4 = (tid & 7) * 4; f32x4 v = (f32x4){0.f, 0.f, 0.f, 0.f};
#pragma unroll
            for (int w = 0; w < 8; ++w) { const LAS float* p = red + (w * 32 + row) * 33 + c4; v += (f32x4){p[0], p[1], p[2], p[3]}; }
            E(32 * tm + row, 32 * tn + c4, v, tid); }
    }
    __syncthreads();
}
constexpr int NPHASE = 11;
struct Args { const float* in[30]; const int* page_table; float* out; unsigned char* ws; int ph_lo, ph_hi; };
static_assert(sizeof(Args) == 30 * 8 + 8 + 8 + 8 + 8, "Args has no padding bytes");
enum { I_XP = 0, I_XS, I_CK, I_CV, I_CLF, I_SSM, I_SCONV, I_PT, I_F1N, I_F1G, I_F1U, I_F1D, I_MIXN, I_WIN, I_CONVW, I_CONVB, I_DTB, I_ALOG, I_DSKIP, I_SSDN, I_QN, I_KN, I_BF,
       I_WSP, I_WAP, I_WO, I_F2N, I_F2G, I_F2U, I_F2D };

__global__ void __launch_bounds__(NWAVES * 64, 2) mega_fwd(Args args) {
    extern __shared__ __attribute__((aligned(16))) unsigned char lds_raw[];
    LAS unsigned char* lds = (LAS unsigned char*)lds_raw;
    volatile LAS unsigned* MISC = (volatile LAS unsigned*)(lds + MISC_OFF);
    const int tid = threadIdx.x, lane = tid & 63, wave = __builtin_amdgcn_readfirstlane(tid >> 6);
    const int G = gridDim.x; const int vcu = (G % 8 == 0) ? ((int)blockIdx.x % 8) * (G / 8) + (int)blockIdx.x / 8 : (int)blockIdx.x;
    unsigned char* ws = args.ws; float* dout = args.out;
    gu32* ctl = (gu32*)(ws + WS_CTL);
    for (int u = tid; u < 64; u += NWAVES * 64) MISC[u] = 0u;
    __syncthreads();
    XcdBarrier bar = xcd_barrier_post((unsigned*)ctl + CW_BAR, MISC + 8);
    const int lo = args.ph_lo, hi = args.ph_hi;
#define IN(k) (lo <= (k) && (k) < hi)
#define SEAM(k) do { if (IN(k) && IN((k) + 1)) xcd_barrier(bar); } while (0)
    const int gw = vcu * NWAVES + wave, NGW = G * NWAVES;
    pg8::ssq_t* ssqX = (pg8::ssq_t*)(ws + WS_SSQX); pg8::ssq_t* ssqH = (pg8::ssq_t*)(ws + WS_CTL + CTL_SSQH); pg8::ssq_t* ssqH2 = (pg8::ssq_t*)(ws + WS_CTL + CTL_SSQH2);
    bf16 *Wgu1 = (bf16*)(ws + WS_WGU1), *Wd1 = (bf16*)(ws + WS_WD1), *Win = (bf16*)(ws + WS_WIN), *Wsp = (bf16*)(ws + WS_WSP), *Wap = (bf16*)(ws + WS_WAP), *Wo = (bf16*)(ws + WS_WO),
         *Wgu2 = (bf16*)(ws + WS_WGU2), *Wd2 = (bf16*)(ws + WS_WD2);
    bf16 *XB = (bf16*)(ws + WS_XB), *ACT = (bf16*)(ws + WS_ACT), *HB = (bf16*)(ws + WS_HB), *Zb = (bf16*)(ws + WS_Z), *XBC = (bf16*)(ws + WS_XBC), *Qb = (bf16*)(ws + WS_Q), *Kb = (bf16*)(ws + WS_K),
         *Vb = (bf16*)(ws + WS_V), *GSb = (bf16*)(ws + WS_GS), *GAb = (bf16*)(ws + WS_GA);
    float *DTf = (float*)(ws + WS_DT), *LOGFf = (float*)(ws + WS_LOGF);

    constexpr int I_GU = (5632 / 64) * (1024 / 64), I_D = (1024 / 64) * (2816 / 64), I_W = (NWIN / 64) * (1024 / 64), I_SP = (1024 / 64) * (2048 / 64), I_SQ = (1024 / 64) * (1024 / 64);
    constexpr int T_GU1 = I_GU, T_D1 = T_GU1 + I_D, T_WIN = T_D1 + I_W, T_SP = T_WIN + I_SP, T_AP = T_SP + I_SQ, T_WO = T_AP + I_SQ, T_GU2 = T_WO + I_GU, T_END = T_GU2 + I_D;
#define TRANSPOSE_RANGE(LO, HI, IDX, NIDX) do { LAS float* scr = (LAS float*)(lds + RING_OFF + wave * 16640);     \
        for (int it = (LO) + (IDX); it < (HI); it += (NIDX)) { int r = it; \
            if (r < T_GU1) { if ((r % 88) & 2) p0_transpose_item(MapGU{args.in[I_F1U]}, args.in[I_F1N], 1024, Wgu1, scr, r / 88, r % 88, lane); else p0_transpose_item(MapGU{args.in[I_F1G]}, args.in[I_F1N], 1024, Wgu1, scr, r / 88, r % 88, lane); continue; } r -= T_GU1; \
            if (r < I_D) { p0_transpose_item(MapPlain{args.in[I_F1D], 1024}, nullptr, 2816, Wd1, scr, r / 16, r % 16, lane); continue; } r -= I_D; \
            if (r < I_W) { p0_transpose_item(MapWin{args.in[I_WIN]}, args.in[I_MIXN], 1024, Win, scr, r / 140, r % 140, lane); continue; } r -= I_W; \
            if (r < I_SP) { p0_transpose_item(MapPlain{args.in[I_WSP], 1024}, nullptr, 2048, Wsp, scr, r / 16, r % 16, lane); continue; } r -= I_SP; \
            if (r < I_SQ) { p0_transpose_item(MapPlain{args.in[I_WAP], 1024}, nullptr, 1024, Wap, scr, r / 16, r % 16, lane); continue; } r -= I_SQ; \
            if (r < I_SQ) { p0_transpose_item(MapPlain{args.in[I_WO], 1024}, nullptr, 1024, Wo, scr, r / 16, r % 16, lane); continue; } r -= I_SQ; \
            if (r < I_GU) { if ((r % 88) & 2) p0_transpose_item(MapGU{args.in[I_F2U]}, args.in[I_F2N], 1024, (bf16*)nullptr, scr, r / 88, r % 88, lane, ws + WS_WGU2F8, pg8::WGU_F8_SCALE); else p0_transpose_item(MapGU{args.in[I_F2G]}, args.in[I_F2N], 1024, (bf16*)nullptr, scr, r / 88, r % 88, lane, ws + WS_WGU2F8, pg8::WGU_F8_SCALE); continue; } r -= I_GU; \
            p0_transpose_item(MapPlain{args.in[I_F2D], 1024}, nullptr, 2816, Wd2, scr, r / 16, r % 16, lane, ws + WS_WD2F8, pg8::WD_F8_SCALE); } } while (0)
    if (IN(0)) {
        if (G == 256) { TRANSPOSE_RANGE(0, T_GU1, gw, NGW); } else { TRANSPOSE_RANGE(0, T_END, gw, NGW); }
        for (int m = 2 * gw; m < MT; m += 2 * NGW) { const float* xr = (m < MP) ? args.in[I_XP] + (size_t)m * 1024 : args.in[I_XS] + (size_t)(m - MP) * 1024; p0_rows_to_bf16(xr, XB + (size_t)m * 1024, ssqX + m, lane); }
        if (blockIdx.x == 0 && tid < 256) { float* par = (float*)(ws + WS_PAR); float v;
            if (tid < 64) v = args.in[I_QN][tid]; else if (tid < 128) v = args.in[I_KN][tid - 64]; else if (tid < 160) v = args.in[I_DTB][tid - 128]; else if (tid < 176) v = args.in[I_BF][tid - 160];
            else if (tid < 192) v = 0.f; else if (tid < 224) v = args.in[I_ALOG][tid - 192]; else v = args.in[I_DSKIP][tid - 224];
            par[tid] = v; }
        if (G != 256) { for (int it = gw; it < DECB * NPAGES; it += NGW) ptot_item(ws, args.in[I_CLF], args.page_table, it, lane); }
    }
    SEAM(0);
    if (IN(1)) {
        if (G == 256 && blockIdx.x >= 150) { TRANSPOSE_RANGE(T_GU1, T_WIN, ((int)blockIdx.x - 150) * NWAVES + wave, 106 * NWAVES);
            for (int it = ((int)blockIdx.x - 150) * NWAVES + wave; it < DECB * NPAGES; it += 106 * NWAVES) ptot_item(ws, args.in[I_CLF], args.page_table, it, lane);
            __syncthreads(); }
        pg8::Gemm g{XB, Wgu1, MT, 5632, 1024}; pg8::StaticOrder S; S.init(MT, 5632, G, (int)blockIdx.x);
        pg8::EpiSwiglu E{ACT, ssqX, 1.f};
        pg8::gemm_phase<pg8::EpiSwiglu, pg8::StaticOrder, true, true>(lds + RING_OFF, g, S, E);
    }
    SEAM(1);
    if (IN(2)) {
        pg8::Gemm g{ACT, Wd1, MP, 1024, DFF}; pg8::StaticOrder S; S.init(MP, 1024, G, (int)blockIdx.x);
        pg8::EpiResid E{args.in[I_XP], nullptr, nullptr, HB, ssqH, 0.5f};
        pg8::gemm_phase<pg8::EpiResid, pg8::StaticOrder, true, true>(lds + RING_OFF, g, S, E);
        smallm_phase<DFF>(ACT + (size_t)MP * DFF, Wd1, lds, SResid{args.in[I_XS], nullptr, nullptr, HB + (size_t)MP * 1024, ssqH + MP, 0.5f}, G);
    }
    SEAM(2);
    if (IN(3)) {
        if (G == 256 && ((blockIdx.x >> 3) & 1)) { TRANSPOSE_RANGE(T_WIN, T_END, ((int)blockIdx.x >> 4) * 8 * NWAVES + ((int)blockIdx.x & 7) * NWAVES + wave, 128 * NWAVES); __syncthreads(); }
        pg8::Gemm g{HB, Win, MT, NWIN, 1024}; pg8::StaticOrder S; S.init(MT, NWIN, G, (int)blockIdx.x);
        pg8::EpiWin E{ws, dout};
        pg8::gemm_phase<pg8::EpiWin, pg8::StaticOrder, true, true>(lds + RING_OFF, g, S, E);
    }
    SEAM(3);
    if (IN(4)) {
        { LAS unsigned char* wl = lds + wave * P4S_WAVE;
          if (NGW == 2048) { const int half = vcu * 4 + (wave >> 1);
              if ((wave & 1) == 0) p4s_item(ws, dout, args.in[I_CONVW], args.in[I_CONVB], args.in[I_SCONV], args.in[I_SSM], wl, half, lane);
              else if (half < NBATCH * AH) ck_item(ws, half, lane);
          } else {
              for (int it = gw; it < NBATCH * AH; it += NGW) ck_item(ws, it, lane);
              for (int it = gw; it < DECB * SH; it += NGW) p4s_item(ws, dout, args.in[I_CONVW], args.in[I_CONVB], args.in[I_SCONV], args.in[I_SSM], wl, it, lane);
          }
          for (int it = gw; it < DECB * NPAGES; it += NGW) cpl_item(ws, args.in[I_CLF], args.page_table, it, lane); }
        for (int i = (int)blockIdx.x * 512 + tid; i < NBATCH * 3 * CONVD; i += G * 512) { const int bb = i / (3 * CONVD), rem = i % (3 * CONVD), j = rem / CONVD, col = rem % CONVD;
            dout[O_CONVP + i] = __uint_as_float((unsigned)XBC[((size_t)bb * SEQ + SEQ - 3 + j) * CONVD + col] << 16); }
        for (int u = (int)blockIdx.x; u < 512; u += G) p4_unit(ws, args.in[I_CONVW], args.in[I_CONVB], lds, u, tid, lane, wave);
        __syncthreads();
    }
    SEAM(4);
    if (IN(5)) {
        for (int it = gw; it < MS * SG; it += NGW) p4s_norm_item(ws, args.in[I_SSDN], it, lane);
        p5_scan(ws, dout, (int)blockIdx.x * 512 + tid, G * 512);
        const attn_body::AttnTensors AT{(const attn_body::bf16*)Qb, (const attn_body::bf16*)Kb, (const attn_body::bf16*)Vb, (attn_body::bf16*)(ws + WS_YA), (const float*)(ws + WS_CK)};
        const float skip_thr = 153.f + 2.f * sqrtf(__uint_as_float(__hip_atomic_load((unsigned*)ctl + CW_QMAX2, RLX_AGENT)) * __uint_as_float(__hip_atomic_load((unsigned*)ctl + CW_KMAX2, RLX_AGENT))) * 1.0001f;
        const int nbefore = ((blockIdx.x >> 3) & 1) ? 0 : 4;
        attn_body::attn_phase<8>((char*)lds_raw, AT, skip_thr, vcu, G, 0, nbefore);
        __syncthreads();
        for (int u = (int)blockIdx.x; u < DECB * 8; u += G) dec_unit(ws, args.in[I_CK], args.in[I_CV], args.page_table, lds, u, tid, lane, wave);
        __syncthreads();
        attn_body::attn_phase<8>((char*)lds_raw, AT, skip_thr, vcu, G, nbefore, 4);
    }
    SEAM(5);
    if (IN(6)) { for (int u = (int)blockIdx.x; u < DECB * KVH; u += G) dec_combine(ws, u, tid);
        for (int u = (int)blockIdx.x; u < 512; u += G) p6_unit(ws, args.in[I_SSDN], lds, u, tid, lane, wave); __syncthreads(); }
    SEAM(6);
    if (IN(7)) {
        { pg8::Gemm g{(const bf16*)(ws + WS_YS), Wsp, MP, 1024, DSSM}; pg8::StaticOrder S; S.init(MP, 1024, G, (int)blockIdx.x);
          pg8::EpiGateMul E{GSb, (bf16*)(ws + WS_MP)};
          pg8::gemm_phase<pg8::EpiGateMul, pg8::StaticOrder, true, true>(lds + RING_OFF, g, S, E); }
        { pg8::Gemm g{(const bf16*)(ws + WS_YA), Wap, MP, 1024, 1024}; pg8::StaticOrder S; S.init(MP, 1024, G, (int)blockIdx.x);
          pg8::EpiGateAdd E{GAb, (const bf16*)(ws + WS_MP), (bf16*)(ws + WS_MG)};
          pg8::gemm_phase<pg8::EpiGateAdd, pg8::StaticOrder, true, true>(lds + RING_OFF, g, S, E); }
        smallm_phase<DSSM>((const bf16*)(ws + WS_YS) + (size_t)MP * DSSM, Wsp, lds, SGateMul{GSb + (size_t)MP * 1024, (bf16*)(ws + WS_MP) + (size_t)MP * 1024}, G);
        smallm_phase<1024>((const bf16*)(ws + WS_YA) + (size_t)MP * 1024, Wap, lds, SGateAdd{GAb + (size_t)MP * 1024, (const bf16*)(ws + WS_MP) + (size_t)MP * 1024, (bf16*)(ws + WS_MG) + (size_t)MP * 1024}, G);
    }
    SEAM(7);
    if (IN(8)) {
        pg8::Gemm g{(const bf16*)(ws + WS_MG), Wo, MP, 1024, 1024}; pg8::StaticOrder S; S.init(MP, 1024, G, (int)blockIdx.x);
        pg8::EpiResidT<false, true> E{nullptr, HB, nullptr, XB, ssqH2, 1.0f};
        pg8::gemm_phase<pg8::EpiResidT<false, true>, pg8::StaticOrder, true, true>(lds + RING_OFF, g, S, E);
        smallm_phase<1024>((const bf16*)(ws + WS_MG) + (size_t)MP * 1024, Wo, lds, SResidT<true>{nullptr, HB + (size_t)MP * 1024, nullptr, XB + (size_t)MP * 1024, ssqH2 + MP, 1.0f}, G);
    }
    SEAM(8);
    if (IN(9)) {
        pg8::Gemm g{(const bf16*)(ws + WS_H2F8), (const bf16*)(ws + WS_WGU2F8), MT, 5632, 512}; pg8::StaticOrder S; S.init(MT, 5632, G, (int)blockIdx.x);
        pg8::EpiSwigluT<true, true> E{ACT, ssqH2, 1.f / (pg8::H2_F8_SCALE * pg8::WGU_F8_SCALE)};
        pg8::gemm_phase<pg8::EpiSwigluT<true, true>, pg8::StaticOrder, true, true>(lds + RING_OFF, g, S, E);
    }
    SEAM(9);
    if (IN(10)) {
        pg8::Gemm g{ACT, (const bf16*)(ws + WS_WD2F8), MP, 1024, DFF / 2}; pg8::StaticOrder S; S.init(MP, 1024, G, (int)blockIdx.x);
        pg8::EpiResidT<true> E{nullptr, XB, dout, nullptr, nullptr, 0.5f / (pg8::ACT_F8_SCALE * pg8::WD_F8_SCALE)};
        pg8::gemm_phase<pg8::EpiResidT<true>, pg8::StaticOrder, true, true>(lds + RING_OFF, g, S, E);
        smallm_phase<DFF>(ACT + (size_t)MP * DFF, Wd2, lds, SResid{nullptr, XB + (size_t)MP * 1024, dout + (size_t)MP * 1024, nullptr, nullptr, 0.5f}, G);
    }
#undef IN
#undef SEAM
}

extern "C" void kernel_launch(void* const* d_in, const int* in_sizes, int n_in, void* d_out, int out_size, void* d_ws, size_t ws_size, hipStream_t stream) {
    static int grid = 0;
    if (grid == 0) {
        if (n_in != 30 || (size_t)out_size != O_END || ws_size < WS_END) { fprintf(stderr, "kernel_launch: unexpected problem (n_in %d, out %d, ws %zu)\n", n_in, out_size, ws_size); grid = -1; return; }
        int dev = 0, cus = 0, per_cu = 0;
        if (hipGetDevice(&dev) != hipSuccess || hipDeviceGetAttribute(&cus, hipDeviceAttributeMultiprocessorCount, dev) != hipSuccess) { grid = -1; return; }
        if (hipFuncSetAttribute((const void*)mega_fwd, hipFuncAttributeMaxDynamicSharedMemorySize, LDS_BYTES) != hipSuccess) { fprintf(stderr, "kernel_launch: hipFuncSetAttribute failed\n"); grid = -1; return; }
        if (hipOccupancyMaxActiveBlocksPerMultiprocessor(&per_cu, (const void*)mega_fwd, NWAVES * 64, LDS_BYTES) != hipSuccess || per_cu < 1) { fprintf(stderr, "kernel_launch: occupancy query reports %d\n", per_cu); }
        (void)hipGetLastError();
        grid = cus;
    }
    if (grid < 0) return;
    if (hipMemsetAsync((char*)d_ws + WS_CTL, 0, CTL_ZERO_BYTES, stream) != hipSuccess) return;
    Args a{};
    for (int i = 0; i < 30; ++i) a.in[i] = (const float*)d_in[i];
    a.page_table = (const int*)d_in[I_PT]; a.out = (float*)d_out; a.ws = (unsigned char*)d_ws; a.ph_lo = 0; a.ph_hi = NPHASE;
    hipLaunchKernelGGL(mega_fwd, dim3(grid), dim3(NWAVES * 64), LDS_BYTES, stream, a);
}
```

```cpp
#include <hip/hip_runtime.h>
#include <cstdio>
#include <cstdint>
constexpr int NWAVES = 8;
constexpr int DMODEL = 1024, NBATCH = 4, SEQ = 4096, MP = NBATCH * SEQ, DECB = 32, DECS = 8, MS = DECB * DECS, MT = MP + MS;
constexpr int DFF = 2816, DSSM = 2048, SH = 32, SP = 64, SG = 4, SN = 128, CONVD = 3072, CHUNK = 128, NCHUNK = SEQ / CHUNK;
constexpr int AH = 16, KVH = 4, HD = 64, KVD = 256, INDIM = 8752, NWIN = 35 * 256;
constexpr int PAST = 16384, PAGE = 128, NPAGES = 128;
constexpr size_t O_YP = 0, O_YS = O_YP + (size_t)MP * 1024, O_KP = O_YS + (size_t)MS * 1024, O_VP = O_KP + (size_t)MP * 256, O_LFP = O_VP + (size_t)MP * 256,
    O_SSMP = O_LFP + (size_t)MP * 16, O_CONVP = O_SSMP + (size_t)NBATCH * SH * SP * SN, O_KS = O_CONVP + (size_t)NBATCH * 3 * CONVD, O_VS = O_KS + (size_t)MS * 256,
    O_LFS = O_VS + (size_t)MS * 256, O_SSMS = O_LFS + (size_t)MS * 16, O_CONVS = O_SSMS + (size_t)DECB * SH * SP * SN, O_END = O_CONVS + (size_t)DECB * 3 * CONVD;
static_assert(O_END == 35594240, "d_out map");
constexpr size_t al256(size_t x) { return (x + 255) & ~(size_t)255; }
constexpr size_t WS_CTL = 0, CTL_ZERO_BYTES = 1u << 20;
constexpr int CW_BAR = 4096, CW_Q4 = 8192, CW_QMAX2 = 8256, CW_KMAX2 = 8320;
constexpr size_t CTL_SSQH = 256 * 1024, CTL_SSQH2 = 512 * 1024;
constexpr size_t WS_PAR = al256(WS_CTL + CTL_ZERO_BYTES);
constexpr int PAR_QN = 0, PAR_KN = 64, PAR_DTB = 128, PAR_BF = 160, PAR_ALOG = 192, PAR_DSKIP = 224, PAR_END = 256;
constexpr size_t WS_SSQX = al256(WS_PAR + 4096);
constexpr size_t WS_WGU1 = al256(WS_SSQX + (size_t)MT * 8);
constexpr size_t WS_WD1 = al256(WS_WGU1 + (size_t)5632 * 1024 * 2);
constexpr size_t WS_WIN = al256(WS_WD1 + (size_t)1024 * 2816 * 2);
constexpr size_t WS_WSP = al256(WS_WIN + (size_t)NWIN * 1024 * 2);
constexpr size_t WS_WAP = al256(WS_WSP + (size_t)1024 * 2048 * 2);
constexpr size_t WS_WO = al256(WS_WAP + (size_t)1024 * 1024 * 2);
constexpr size_t WS_WGU2 = al256(WS_WO + (size_t)1024 * 1024 * 2);
constexpr size_t WS_WD2 = al256(WS_WGU2 + (size_t)5632 * 1024 * 2);
constexpr size_t WS_XB = al256(WS_WD2 + (size_t)1024 * 2816 * 2);
constexpr size_t WS_ACT = al256(WS_XB + (size_t)MT * 1024 * 2);
constexpr size_t WS_HB = al256(WS_ACT + (size_t)MT * 2816 * 2);
constexpr size_t WS_Z = al256(WS_HB + (size_t)MT * 1024 * 2);
constexpr size_t WS_XBC = al256(WS_Z + (size_t)MT * 2048 * 2);
constexpr size_t WS_Q = al256(WS_XBC + (size_t)MT * 3072 * 2);
constexpr size_t WS_K = al256(WS_Q + (size_t)MT * 1024 * 2);
constexpr size_t WS_V = al256(WS_K + (size_t)MT * 256 * 2);
constexpr size_t WS_GS = al256(WS_V + (size_t)MT * 256 * 2);
constexpr size_t WS_GA = al256(WS_GS + (size_t)MT * 1024 * 2);
constexpr size_t WS_DT = al256(WS_GA + (size_t)MT * 1024 * 2);
constexpr size_t WS_LOGF = al256(WS_DT + (size_t)MT * 32 * 4);
constexpr size_t WS_XC = al256(WS_LOGF + (size_t)MT * 16 * 4);
constexpr size_t WS_YS = al256(WS_XC + (size_t)MT * 3072 * 2);
constexpr size_t WS_YA = al256(WS_YS + (size_t)MT * 2048 * 2);
constexpr size_t WS_MP = al256(WS_YA + (size_t)MT * 1024 * 2);
constexpr size_t WS_ST = al256(WS_MP + (size_t)MT * 1024 * 4);
constexpr size_t WS_ACS = al256(WS_ST + (size_t)NBATCH * NCHUNK * SH * SP * SN * 2);
constexpr size_t WS_CK = al256(WS_ACS + (size_t)MP * 32 * 4);
constexpr size_t WS_PTOT = al256(WS_CK + (size_t)MP * 16 * 4);
constexpr size_t WS_CPL = al256(WS_PTOT + (size_t)DECB * NPAGES * 16 * 4);
constexpr size_t WS_DPART = al256(WS_CPL + (size_t)DECB * PAST * 16 * 4);
constexpr size_t WS_YRAW = al256(WS_DPART + (size_t)64 * 1024 * 1024);
constexpr size_t WS_MG = al256(WS_YRAW + (size_t)MS * DSSM * 4);
constexpr size_t WS_HS = al256(WS_MG + (size_t)MT * 1024 * 2);
constexpr size_t WS_WD1F8 = al256(WS_HS + (size_t)NBATCH * NCHUNK * SH * SP * SN * 2);
constexpr size_t WS_WD2F8 = al256(WS_WD1F8 + (size_t)1024 * 2816);
constexpr size_t WS_WGU2F8 = al256(WS_WD2F8 + (size_t)1024 * 2816);
constexpr size_t WS_H2F8 = al256(WS_WGU2F8 + (size_t)5632 * 1024);
constexpr size_t WS_END = al256(WS_H2F8 + (size_t)MT * 1024);
constexpr int RING_OFF = 0, RING_BYTES = 131072;
constexpr int LDS_BYTES = 160 * 1024;
constexpr int MISC_OFF = LDS_BYTES - 256;
namespace pg8 {
#define PG8_LAS __attribute__((address_space(3)))
typedef unsigned short bf16_t;
typedef short bf16x8 __attribute__((ext_vector_type(8)));
typedef float f32x4 __attribute__((ext_vector_type(4)));
typedef unsigned u32x4 __attribute__((ext_vector_type(4)));
typedef int v4i __attribute__((ext_vector_type(4)));
typedef unsigned u32x2 __attribute__((ext_vector_type(2)));
typedef int v8i __attribute__((ext_vector_type(8)));
typedef unsigned long long ssq_t;
constexpr float SSQ_ONE = 1048576.f;
__device__ __forceinline__ float ssq_ld(const ssq_t* p, size_t row) { return (float)p[row] * (1.f / SSQ_ONE); }
__device__ __forceinline__ ssq_t ssq_fx(float s) { return (ssq_t)(s * SSQ_ONE + 0.5f); }
template <bool F8> struct FragSel { typedef bf16x8 type; };
template <> struct FragSel<true> { typedef v8i type; };
constexpr int BM = 256, BK = 64, HALF = 128, HTB = HALF * BK * 2  , STAGE_BYTES = 8 * HTB, NXCD = 8, WGM = 8;

__host__ __device__ __forceinline__ int lds_byte(int r, int c) { const int st = (r >> 4) * 2 + (c >> 5), rr = r & 15, cc = c & 31, ob = rr * 64 + cc * 2; return st * 1024 + (ob ^ (((ob >> 9) & 1) << 5)); }
__host__ __device__ __forceinline__ void stage_rc(int b, int& R, int& C) { const int st = b / 1024, sb = b % 1024, swz = sb ^ (((sb >> 9) & 1) << 5); R = (st >> 1) * 16 + swz / 64; C = (st & 1) * 32 + (swz % 64) / 2; }
__host__ __device__ __forceinline__ int perm32(int rho) { const int n = rho >> 4, i = rho & 15; return 8 * (i >> 2) + 4 * n + (i & 3); }

struct Unit { int pm, pn; };
struct Gemm { const bf16_t* A; const bf16_t* Bt; int M, N, K; };

struct StaticOrder {
    int nM, nN, nwg, G, c;
    __host__ __device__ void init(int M, int N, int G_, int c_) { nM = M / BM; nN = N / BM; nwg = nM * nN; G = G_; c = c_; }
    __host__ __device__ bool next(int i, Unit& u) const {
        const long L = (long)i * G + c; if (L >= nwg) return false;
        int wgid = (int)L; { const int q = nwg / NXCD, r = nwg % NXCD, xcd = wgid % NXCD, off = wgid / NXCD; wgid = (xcd < r ? xcd * (q + 1) : r * (q + 1) + (xcd - r) * q) + off; }
        const int nig = WGM * nN, gid = wgid / nig, fm = gid * WGM, gsz = (nM - fm) < WGM ? (nM - fm) : WGM;
        u.pm = fm + ((wgid % nig) % gsz); u.pn = (wgid % nig) / gsz; return true;
    }
    __device__ __forceinline__ void a_ready(const Unit&) const {}
    __device__ __forceinline__ void done(const Unit&) const {}
};

__device__ __forceinline__ unsigned cvt_pk_bf16(float lo, float hi) { unsigned r; asm volatile("v_cvt_pk_bf16_f32 %0, %1, %2" : "=v"(r) : "v"(lo), "v"(hi)); return r; }
__device__ __forceinline__ unsigned cvt_pk_bf16_t(float lo, float hi) { unsigned r; asm volatile("s_nop 1\n\tv_cvt_pk_bf16_f32 %0, %1, %2" : "=v"(r) : "v"(lo), "v"(hi)); return r; }
typedef float f32x2 __attribute__((ext_vector_type(2)));
constexpr float RMS_EPS_F = 1e-6f;
constexpr float LOG2E_F = 1.4426950408889634f;
constexpr float ATT_C2 = 0.125f * 1.4426950408889634f;
constexpr int MPROMPT = 16384;
__device__ __forceinline__ float sigmoid_f(float x) { return __builtin_amdgcn_rcpf(1.f + __builtin_amdgcn_exp2f(-LOG2E_F * x)); }
__device__ __forceinline__ float silu_f(float x) { return x * sigmoid_f(x); }
__device__ __forceinline__ float softplus_f(float x) { return fmaxf(x, 0.f) + log1pf(expf(-fabsf(x))); }
__device__ __forceinline__ float logsigmoid_f(float x) { return fminf(x, 0.f) - log1pf(expf(-fabsf(x))); }
__device__ __forceinline__ float bf2f(unsigned short b) { return __uint_as_float((unsigned)b << 16); }
__device__ __forceinline__ u32x4 pack8(const f32x4 a, const f32x4 b) { u32x4 w; w.x = cvt_pk_bf16(a[0], a[1]); w.y = cvt_pk_bf16(a[2], a[3]); w.z = cvt_pk_bf16(b[0], b[1]); w.w = cvt_pk_bf16(b[2], b[3]); return w; }
__device__ __forceinline__ u32x4 pack8_t(const f32x4 a, const f32x4 b) { u32x4 w; w.x = cvt_pk_bf16_t(a[0], a[1]); w.y = cvt_pk_bf16_t(a[2], a[3]); w.z = cvt_pk_bf16_t(b[0], b[1]); w.w = cvt_pk_bf16_t(b[2], b[3]); return w; }
__device__ __forceinline__ void unpack8(const u32x4 w, f32x4& a, f32x4& b) {
    a[0] = __uint_as_float(w.x << 16); a[1] = __uint_as_float(w.x & 0xffff0000u); a[2] = __uint_as_float(w.y << 16); a[3] = __uint_as_float(w.y & 0xffff0000u);
    b[0] = __uint_as_float(w.z << 16); b[1] = __uint_as_float(w.z & 0xffff0000u); b[2] = __uint_as_float(w.w << 16); b[3] = __uint_as_float(w.w & 0xffff0000u); }

__device__ __forceinline__ void cx8(const u32x4 w0, const u32x4 w1, int lane, u32x4& oA, u32x4& oB) {
    const int p = lane & 7, r8 = lane >> 3, srcA = (16 * (p & 3) + r8) * 4, srcB = srcA + 32; const bool hi = p >= 4;
#pragma unroll
    for (int d = 0; d < 4; ++d) {
        const unsigned a0 = (unsigned)__builtin_amdgcn_ds_bpermute(srcA, (int)w0[d]), a1 = (unsigned)__builtin_amdgcn_ds_bpermute(srcA, (int)w1[d]);
        const unsigned b0 = (unsigned)__builtin_amdgcn_ds_bpermute(srcB, (int)w0[d]), b1 = (unsigned)__builtin_amdgcn_ds_bpermute(srcB, (int)w1[d]);
        oA[d] = hi ? a1 : a0; oB[d] = hi ? b1 : b0; }
}
constexpr float ACT_F8_SCALE = 4.f, WD_F8_SCALE = 64.f, H2_F8_SCALE = 16.f, WGU_F8_SCALE = 32.f;
__device__ __forceinline__ u32x2 pack8_f8(f32x4 a, f32x4 b, float sc) { int w0 = 0, w1 = 0;
    a = a * sc; b = b * sc;
#pragma unroll
    for (int e = 0; e < 4; ++e) { a[e] = __builtin_amdgcn_fmed3f(a[e], -448.f, 448.f); b[e] = __builtin_amdgcn_fmed3f(b[e], -448.f, 448.f); }
    w0 = __builtin_amdgcn_cvt_pk_fp8_f32(a[0], a[1], w0, false); w0 = __builtin_amdgcn_cvt_pk_fp8_f32(a[2], a[3], w0, true);
    w1 = __builtin_amdgcn_cvt_pk_fp8_f32(b[0], b[1], w1, false); w1 = __builtin_amdgcn_cvt_pk_fp8_f32(b[2], b[3], w1, true);
    u32x2 w; w.x = (unsigned)w0; w.y = (unsigned)w1; return w; }
template <bool F8, bool F8IN = false> struct EpiSwigluT {
    static constexpr bool PERM = true, AFTER_DRAIN = false, FP8 = F8IN, PROBE_TWICE = false;
    bf16_t* O; const ssq_t* ssq; float inv;
    __device__ __forceinline__ void operator()(const f32x4 (&acc)[2][2][4][2], const Unit& u, int wr, int wc, int fr, int fq) const {
        constexpr int ldc = 2816;
        asm volatile("" : "+v"(fr), "+v"(fq));
        const int row0 = u.pm * BM + wr * 64 + fr, col0 = u.pn * HALF + wc * 32 + 8 * fq;
        const bool f8 = F8 && (u.pm < MPROMPT / BM);
        float rsv[2][4];
#pragma unroll
        for (int ai = 0; ai < 2; ++ai)
#pragma unroll
            for (int m = 0; m < 4; ++m) rsv[ai][m] = rsqrtf(ssq_ld(ssq, row0 + ai * HALF + m * 16) * (1.f / 1024.f) + RMS_EPS_F) * inv;
#pragma unroll
        for (int ai = 0; ai < 2; ++ai)
#pragma unroll
            for (int m = 0; m < 4; ++m) { const int row = row0 + ai * HALF + m * 16; const float rs = rsv[ai][m];
                f32x4 o[2];
#pragma unroll
                for (int n = 0; n < 2; ++n)
#pragma unroll
                    for (int e = 0; e < 4; ++e) o[n][e] = silu_f(acc[ai][0][m][n][e] * rs) * (acc[ai][1][m][n][e] * rs);
                if (f8) *(u32x2*)((unsigned char*)O + (size_t)row * ldc + col0) = pack8_f8(o[0], o[1], ACT_F8_SCALE);
                else *(u32x4*)(O + (size_t)row * ldc + col0) = pack8(o[0], o[1]); }
    }
};
using EpiSwiglu = EpiSwigluT<false>;
template <bool F8IN, bool OUT8 = false> struct EpiResidT {
    static constexpr bool PERM = true, AFTER_DRAIN = false, PROBE_TWICE = false, FP8 = F8IN;
    const float* resF; const bf16_t* resB; float* outF; bf16_t* outB; ssq_t* ssq; float alpha;
    __device__ __forceinline__ void operator()(const f32x4 (&acc)[2][2][4][2], const Unit& u, int wr, int wc, int fr, int fq) const {
        const int row0 = u.pm * BM + wr * 64 + fr, col0 = u.pn * BM + wc * 32 + 8 * fq;
        if (resF) {
#pragma unroll
            for (int am = 0; am < 4; ++am) { const int ai = am >> 1; f32x4 rr[4][2][2];
#pragma unroll
                for (int m = 2 * (am & 1); m < 2 * (am & 1) + 2; ++m)
#pragma unroll
                    for (int bj = 0; bj < 2; ++bj) { const float* rp = resF + (size_t)(row0 + ai * HALF + m * 16) * 1024 + col0 + bj * HALF; rr[m][bj][0] = *(const f32x4*)rp; rr[m][bj][1] = *(const f32x4*)(rp + 4); }
#pragma unroll
                for (int m = 2 * (am & 1); m < 2 * (am & 1) + 2; ++m) { const size_t row = (size_t)(row0 + ai * HALF + m * 16); float s = 0.f;
#pragma unroll
                    for (int bj = 0; bj < 2; ++bj) { const int col = col0 + bj * HALF;
                        const f32x4 o0 = rr[m][bj][0] + acc[ai][bj][m][0] * alpha, o1 = rr[m][bj][1] + acc[ai][bj][m][1] * alpha;
                        if (outF) { *(f32x4*)(outF + row * 1024 + col) = o0; *(f32x4*)(outF + row * 1024 + col + 4) = o1; }
                        if (outB) *(u32x4*)(outB + row * 1024 + col) = pack8(o0, o1);
                        if constexpr (OUT8) *(u32x2*)((unsigned char*)outB + (WS_H2F8 - WS_XB) + row * 1024 + col) = pack8_f8(o0, o1, H2_F8_SCALE);
                        s += (o0[0] * o0[0] + o0[1] * o0[1]) + (o0[2] * o0[2] + o0[3] * o0[3]) + (o1[0] * o1[0] + o1[1] * o1[1]) + (o1[2] * o1[2] + o1[3] * o1[3]); }
                    if (ssq) { s += __shfl_xor(s, 16); s += __shfl_xor(s, 32); if (fq == 0) __hip_atomic_fetch_add(ssq + row, ssq_fx(s), __ATOMIC_RELAXED, __HIP_MEMORY_SCOPE_AGENT); } } }
        } else {
#pragma unroll
            for (int ai = 0; ai < 2; ++ai) { u32x4 rw[2][4][2];
#pragma unroll
                for (int m = 0; m < 4; ++m)
#pragma unroll
                    for (int bj = 0; bj < 2; ++bj) rw[ai][m][bj] = *(const u32x4*)(resB + (size_t)(row0 + ai * HALF + m * 16) * 1024 + col0 + bj * HALF);
#pragma unroll
                for (int m = 0; m < 4; ++m) { const size_t row = (size_t)(row0 + ai * HALF + m * 16); float s = 0.f;
#pragma unroll
                    for (int bj = 0; bj < 2; ++bj) { const int col = col0 + bj * HALF; f32x4 r0, r1; unpack8(rw[ai][m][bj], r0, r1);
                        const f32x4 o0 = r0 + acc[ai][bj][m][0] * alpha, o1 = r1 + acc[ai][bj][m][1] * alpha;
                        if (outF) { *(f32x4*)(outF + row * 1024 + col) = o0; *(f32x4*)(outF + row * 1024 + col + 4) = o1; }
                        if (outB) *(u32x4*)(outB + row * 1024 + col) = pack8(o0, o1);
                        if constexpr (OUT8) *(u32x2*)((unsigned char*)outB + (WS_H2F8 - WS_XB) + row * 1024 + col) = pack8_f8(o0, o1, H2_F8_SCALE);
                        s += (o0[0] * o0[0] + o0[1] * o0[1]) + (o0[2] * o0[2] + o0[3] * o0[3]) + (o1[0] * o1[0] + o1[1] * o1[1]) + (o1[2] * o1[2] + o1[3] * o1[3]); }
                    if (ssq) { s += __shfl_xor(s, 16); s += __shfl_xor(s, 32); if (fq == 0) __hip_atomic_fetch_add(ssq + row, ssq_fx(s), __ATOMIC_RELAXED, __HIP_MEMORY_SCOPE_AGENT); } } }
        }
    }
};
using EpiResid = EpiResidT<false>;
struct EpiGateMul {
    static constexpr bool PERM = true, AFTER_DRAIN = false, FP8 = false, PROBE_TWICE = false;
    const bf16_t* G; bf16_t* MPb;
    __device__ __forceinline__ void operator()(const f32x4 (&acc)[2][2][4][2], const Unit& u, int wr, int wc, int fr, int fq) const {
        const int row0 = u.pm * BM + wr * 64 + fr, col0 = u.pn * BM + wc * 32 + 8 * fq;
        u32x4 gw[2][4][2];
#pragma unroll
        for (int ai = 0; ai < 2; ++ai)
#pragma unroll
            for (int m = 0; m < 4; ++m)
#pragma unroll
                for (int bj = 0; bj < 2; ++bj) gw[ai][m][bj] = *(const u32x4*)(G + (size_t)(row0 + ai * HALF + m * 16) * 1024 + col0 + bj * HALF);
#pragma unroll
        for (int ai = 0; ai < 2; ++ai)
#pragma unroll
            for (int m = 0; m < 4; ++m) { const size_t row = (size_t)(row0 + ai * HALF + m * 16);
#pragma unroll
                for (int bj = 0; bj < 2; ++bj) { const int col = col0 + bj * HALF; f32x4 g0, g1; unpack8(gw[ai][m][bj], g0, g1);
                    *(u32x4*)(MPb + row * 1024 + col) = pack8(g0 * acc[ai][bj][m][0], g1 * acc[ai][bj][m][1]); } }
    }
};
struct EpiGateAdd {
    static constexpr bool PERM = true, AFTER_DRAIN = false, FP8 = false, PROBE_TWICE = false;
    const bf16_t* G; const bf16_t* MPb; bf16_t* O;
    __device__ __forceinline__ void operator()(const f32x4 (&acc)[2][2][4][2], const Unit& u, int wr, int wc, int fr, int fq) const {
        const int row0 = u.pm * BM + wr * 64 + fr, col0 = u.pn * BM + wc * 32 + 8 * fq;
#pragma unroll
        for (int ai = 0; ai < 2; ++ai) { u32x4 gw[4][2], pw[4][2];
#pragma unroll
            for (int m = 0; m < 4; ++m)
#pragma unroll
                for (int bj = 0; bj < 2; ++bj) { const size_t off = (size_t)(row0 + ai * HALF + m * 16) * 1024 + col0 + bj * HALF; gw[m][bj] = *(const u32x4*)(G + off); pw[m][bj] = *(const u32x4*)(MPb + off); }
#pragma unroll
            for (int m = 0; m < 4; ++m) { const size_t row = (size_t)(row0 + ai * HALF + m * 16);
#pragma unroll
                for (int bj = 0; bj < 2; ++bj) { const int col = col0 + bj * HALF; f32x4 g0, g1, p0, p1; unpack8(gw[m][bj], g0, g1); unpack8(pw[m][bj], p0, p1);
                    *(u32x4*)(O + row * 1024 + col) = pack8(p0 + g0 * acc[ai][bj][m][0], p1 + g1 * acc[ai][bj][m][1]); } } }
    }
};
struct EpiWin {
    static constexpr bool PERM = true, AFTER_DRAIN = false, FP8 = false, PROBE_TWICE = false;
    unsigned char* ws; float* dout;
    __device__ __forceinline__ void operator()(const f32x4 (&acc)[2][2][4][2], const Unit& u, int wr, int wc, int fr, int fq) const {
        asm volatile("" : "+v"(fr), "+v"(fq));
        const ssq_t* ssq = (const ssq_t*)(ws + WS_CTL + CTL_SSQH);
        bf16_t *Z = (bf16_t*)(ws + WS_Z), *XBC = (bf16_t*)(ws + WS_XBC), *Q = (bf16_t*)(ws + WS_Q), *K = (bf16_t*)(ws + WS_K), *V = (bf16_t*)(ws + WS_V), *GS = (bf16_t*)(ws + WS_GS), *GA = (bf16_t*)(ws + WS_GA);
        float *DT = (float*)(ws + WS_DT), *LOGF = (float*)(ws + WS_LOGF);
        float *koP = dout + O_KP, *koS = dout + O_KS, *voP = dout + O_VP, *voS = dout + O_VS, *lfP = dout + O_LFP, *lfS = dout + O_LFS;
        const float *qn = (const float*)(ws + WS_PAR) + PAR_QN, *kn = (const float*)(ws + WS_PAR) + PAR_KN, *dtb = (const float*)(ws + WS_PAR) + PAR_DTB, *bf = (const float*)(ws + WS_PAR) + PAR_BF;
        const int row0 = u.pm * BM + wr * 64 + fr, pn = u.pn;
        float rsv[2][4];
#pragma unroll
        for (int ai = 0; ai < 2; ++ai)
#pragma unroll
            for (int m = 0; m < 4; ++m) rsv[ai][m] = rsqrtf(ssq_ld(ssq, row0 + ai * HALF + m * 16) * (1.f / 1024.f) + RMS_EPS_F);
        if (pn < 20 || (pn >= 25 && pn < 34)) {
            bf16_t* O; int ldc, cb; int mode = 0;
            if (pn < 8) { O = Z; ldc = 2048; cb = pn * BM; } else if (pn < 20) { O = XBC; ldc = 3072; cb = (pn - 8) * BM; }
            else if (pn == 25) { O = V; ldc = 256; cb = 0; mode = 2; } else if (pn < 30) { O = GS; ldc = 1024; cb = (pn - 26) * BM; mode = 1; } else { O = GA; ldc = 1024; cb = (pn - 30) * BM; mode = 1; }
            const int col0 = cb + wc * 64 + 8 * fq;
            const int lane = 16 * fq + fr, colx = cb + wc * 64 + 8 * (lane & 7), rowx = u.pm * BM + wr * 64 + (lane >> 3);
#pragma unroll
            for (int ai = 0; ai < 2; ++ai)
#pragma unroll
                for (int m = 0; m < 4; ++m) { const int row = row0 + ai * HALF + m * 16; const float rs = rsv[ai][m];
                    u32x4 w[2];
#pragma unroll
                    for (int bj = 0; bj < 2; ++bj) { f32x4 v0 = acc[ai][bj][m][0] * rs, v1 = acc[ai][bj][m][1] * rs; const int col = col0 + bj * 32;
                        if (mode == 1) {
#pragma unroll
                            for (int e = 0; e < 4; ++e) { v0[e] = sigmoid_f(v0[e]); v1[e] = sigmoid_f(v1[e]); } }
                        if (mode == 2) { float* vo = (row < MPROMPT) ? voP + (size_t)row * 256 : voS + (size_t)(row - MPROMPT) * 256; *(f32x4*)(vo + col) = v0; *(f32x4*)(vo + col + 4) = v1; }
                        w[bj] = (mode == 1) ? pack8_t(v0, v1) : pack8(v0, v1); }
                    u32x4 oA, oB; cx8(w[0], w[1], lane, oA, oB);
                    const size_t ra = (size_t)(rowx + ai * HALF + m * 16);
                    *(u32x4*)(O + ra * ldc + colx) = oA; *(u32x4*)(O + (ra + 8) * ldc + colx) = oB; }
        } else if (pn < 25) {
            const bool isk = (pn == 24); const int head = isk ? wc : 4 * (pn - 20) + wc; const float* gw = isk ? kn : qn; const float sc = isk ? 1.f : ATT_C2;
            f32x4 g[2][2]; float nmax = 0.f;
#pragma unroll
            for (int bj = 0; bj < 2; ++bj)
#pragma unroll
                for (int n = 0; n < 2; ++n) g[bj][n] = *(const f32x4*)(gw + 32 * bj + 8 * fq + 4 * n) * sc;
#pragma unroll
            for (int ai = 0; ai < 2; ++ai)
#pragma unroll
                for (int m = 0; m < 4; ++m) { const int row = row0 + ai * HALF + m * 16; const float rs = rsv[ai][m];
                    f32x4 v[2][2]; float s = 0.f;
#pragma unroll
                    for (int bj = 0; bj < 2; ++bj)
#pragma unroll
                        for (int n = 0; n < 2; ++n) { v[bj][n] = acc[ai][bj][m][n] * rs; s += (v[bj][n][0] * v[bj][n][0] + v[bj][n][1] * v[bj][n][1]) + (v[bj][n][2] * v[bj][n][2] + v[bj][n][3] * v[bj][n][3]); }
                    s += __shfl_xor(s, 16); s += __shfl_xor(s, 32);
                    const float r = rsqrtf(s * (1.f / 64.f) + RMS_EPS_F);
                    float nn = 0.f;
#pragma unroll
                    for (int bj = 0; bj < 2; ++bj) { const f32x4 o0 = v[bj][0] * r * g[bj][0], o1 = v[bj][1] * r * g[bj][1]; const int col = head * 64 + 32 * bj + 8 * fq;
                        { f32x4 q0, q1; unpack8(pack8(o0, o1), q0, q1); nn += (q0[0] * q0[0] + q0[1] * q0[1]) + (q0[2] * q0[2] + q0[3] * q0[3]) + (q1[0] * q1[0] + q1[1] * q1[1]) + (q1[2] * q1[2] + q1[3] * q1[3]); }
                        if (isk) { float* ko = (row < MPROMPT) ? koP + (size_t)row * 256 : koS + (size_t)(row - MPROMPT) * 256; *(f32x4*)(ko + col) = o0; *(f32x4*)(ko + col + 4) = o1;
                                   *(u32x4*)(K + (size_t)row * 256 + col) = pack8(o0, o1); }
                        else *(u32x4*)(Q + (size_t)row * 1024 + col) = pack8(o0, o1); }
                    nn += __shfl_xor(nn, 16); nn += __shfl_xor(nn, 32); nmax = fmaxf(nmax, nn); }
            nmax = fmaxf(nmax, __shfl_xor(nmax, 1)); nmax = fmaxf(nmax, __shfl_xor(nmax, 2)); nmax = fmaxf(nmax, __shfl_xor(nmax, 4)); nmax = fmaxf(nmax, __shfl_xor(nmax, 8));
            if (fr == 0 && fq == 0) __hip_atomic_fetch_max((unsigned*)(ws + WS_CTL) + (isk ? CW_KMAX2 : CW_QMAX2), __float_as_uint(nmax), __ATOMIC_RELAXED, __HIP_MEMORY_SCOPE_AGENT);
        } else {
            if (wc == 0) {
                const f32x4 b0 = *(const f32x4*)(dtb + 8 * fq), b1 = *(const f32x4*)(dtb + 8 * fq + 4);
#pragma unroll
                for (int ai = 0; ai < 2; ++ai)
#pragma unroll
                    for (int m = 0; m < 4; ++m) { const int row = row0 + ai * HALF + m * 16; const float rs = rsv[ai][m];
                        f32x4 v0 = acc[ai][0][m][0] * rs + b0, v1 = acc[ai][0][m][1] * rs + b1;
#pragma unroll
                        for (int e = 0; e < 4; ++e) { v0[e] = softplus_f(v0[e]); v1[e] = softplus_f(v1[e]); }
                        *(f32x4*)(DT + (size_t)row * 32 + 8 * fq) = v0; *(f32x4*)(DT + (size_t)row * 32 + 8 * fq + 4) = v1; }
            } else if (wc == 1 && fq < 2) {
                const f32x4 b0 = *(const f32x4*)(bf + 8 * fq), b1 = *(const f32x4*)(bf + 8 * fq + 4);
#pragma unroll
                for (int ai = 0; ai < 2; ++ai)
#pragma unroll
                    for (int m = 0; m < 4; ++m) { const int row = row0 + ai * HALF + m * 16; const float rs = rsv[ai][m];
                        f32x4 v0 = acc[ai][0][m][0] * rs + b0, v1 = acc[ai][0][m][1] * rs + b1;
#pragma unroll
                        for (int e = 0; e < 4; ++e) { v0[e] = logsigmoid_f(v0[e]); v1[e] = logsigmoid_f(v1[e]); }
                        float* lo = (row < MPROMPT) ? lfP + (size_t)row * 16 : lfS + (size_t)(row - MPROMPT) * 16;
                        *(f32x4*)(lo + 8 * fq) = v0; *(f32x4*)(lo + 8 * fq + 4) = v1;
                        *(f32x4*)(LOGF + (size_t)row * 16 + 8 * fq) = v0; *(f32x4*)(LOGF + (size_t)row * 16 + 8 * fq + 4) = v1; }
            }
        }
    }
};
template <class Epi, class Sched, bool ALIGN_EPI = false, bool SP2 = false>
__device__ __forceinline__ void gemm_phase(PG8_LAS unsigned char* lds, const Gemm g, const Sched& S, const Epi& E) {
    const int tid = threadIdx.x, wid = __builtin_amdgcn_readfirstlane(tid >> 6), lane = tid & 63, wr = wid >> 2, wc = wid & 3, fr = lane & 15, fq = lane >> 4;
    const int K = g.K, nt = K / BK;
    unsigned voffA[2], voffB[2];
#pragma unroll
    for (int i = 0; i < 2; ++i) { int R, C; stage_rc(tid * 16 + i * 8192, R, C); const int Rb = Epi::PERM ? ((R & ~31) + perm32(R & 31)) : R;
        voffA[i] = (unsigned)(R * K + C) * 2u; voffB[i] = (unsigned)(Rb * K + C) * 2u; }
    const size_t kstep = (size_t)(BK * 2);
    const size_t hstep = (size_t)HALF * K * 2;
    const size_t tstep = 2 * hstep;
    const unsigned ldsw = (unsigned)wid * 1024u;
    const int aoff = lds_byte(wr * 64 + fr, fq * 8), boff = lds_byte(wc * 32 + fr, fq * 8);
#define PG8_SA(b, h) (((b) * 2 + (h)) * HTB)
#define PG8_SB(b, h) ((4 + (b) * 2 + (h)) * HTB)
#define PG8_STAGE(bufoff, gbase, voff) do { _Pragma("unroll") for (int _i = 0; _i < 2; ++_i) \
        __builtin_amdgcn_global_load_lds((const unsigned*)((const char*)(gbase) + (voff)[_i]), (PG8_LAS unsigned*)(lds + (bufoff) + ldsw + _i * 8192), 16, 0, 0); } while (0)
#define PG8_LDA(dst, b, h) do { _Pragma("unroll") for (int m = 0; m < 4; ++m) { if constexpr (Epi::FP8) dst[m][0] = __builtin_shufflevector(*(const PG8_LAS v4i*)(lds + PG8_SA(b, h) + aoff + m * 2048), *(const PG8_LAS v4i*)(lds + PG8_SA(b, h) + aoff + m * 2048 + 1024), 0, 1, 2, 3, 4, 5, 6, 7); \
        else { _Pragma("unroll") for (int k = 0; k < 2; ++k) dst[m][k] = *(const PG8_LAS bf16x8*)(lds + PG8_SA(b, h) + aoff + m * 2048 + k * 1024); } } } while (0)
#define PG8_LDB(dst, b, h) do { _Pragma("unroll") for (int n = 0; n < 2; ++n) { if constexpr (Epi::FP8) dst[n][0] = __builtin_shufflevector(*(const PG8_LAS v4i*)(lds + PG8_SB(b, h) + boff + n * 2048), *(const PG8_LAS v4i*)(lds + PG8_SB(b, h) + boff + n * 2048 + 1024), 0, 1, 2, 3, 4, 5, 6, 7); \
        else { _Pragma("unroll") for (int k = 0; k < 2; ++k) dst[n][k] = *(const PG8_LAS bf16x8*)(lds + PG8_SB(b, h) + boff + n * 2048 + k * 1024); } } } while (0)
#define PG8_MMA(ai, bj, At, Bt) do { __builtin_amdgcn_s_setprio(1); \
        if constexpr (Epi::FP8) {   \
            _Pragma("unroll") for (int m = 0; m < 4; ++m) _Pragma("unroll") for (int n = 0; n < 2; ++n) \
                asm volatile("v_mfma_f32_16x16x128_f8f6f4 %0, %1, %2, %0" : "+v"(acc[ai][bj][m][n]) : "v"(Bt[n][0]), "v"(At[m][0]));   \
        } else { \
        _Pragma("unroll") for (int m = 0; m < 4; ++m) _Pragma("unroll") for (int n = 0; n < 2; ++n) _Pragma("unroll") for (int k = 0; k < 2; ++k) \
        acc[ai][bj][m][n] = __builtin_amdgcn_mfma_f32_16x16x32_bf16(Bt[n][k], At[m][k], acc[ai][bj][m][n], 0, 0, 0); } __builtin_amdgcn_s_setprio(0); } while (0)
#define PG8_WAIT_V(n) asm volatile("s_waitcnt vmcnt(" #n ")" ::: "memory")
#define PG8_WAIT_L(n) asm volatile("s_waitcnt lgkmcnt(" #n ")" ::: "memory")
#define PG8_BAR __builtin_amdgcn_s_barrier()
#define PG8_SCHED __builtin_amdgcn_sched_barrier(0)
    Unit cur, nxt; int ui = 0;
    if (!S.next(0, cur)) return;
    f32x4 acc[2][2][4][2];
#pragma unroll
    for (int a = 0; a < 2; ++a)
#pragma unroll
        for (int b = 0; b < 2; ++b)
#pragma unroll
            for (int m = 0; m < 4; ++m)
#pragma unroll
                for (int n = 0; n < 2; ++n) acc[a][b][m][n] = (f32x4){0.f, 0.f, 0.f, 0.f};
    typename FragSel<Epi::FP8>::type At[4][Epi::FP8 ? 1 : 2], B0[2][Epi::FP8 ? 1 : 2], B1[2][Epi::FP8 ? 1 : 2];
    const char* cA = (const char*)g.A + (size_t)cur.pm * tstep; const char* cB = (const char*)g.Bt + (size_t)cur.pn * tstep;
    S.a_ready(cur);
    if constexpr (SP2) {
        PG8_STAGE(PG8_SB(0, 0), cB, voffB); PG8_STAGE(PG8_SB(0, 1), cB + hstep, voffB); PG8_STAGE(PG8_SA(0, 0), cA, voffA); PG8_STAGE(PG8_SA(0, 1), cA + hstep, voffA);
        if (wr == 1) PG8_BAR;
        PG8_WAIT_V(2); PG8_BAR;
        PG8_STAGE(PG8_SB(1, 0), cB + kstep, voffB); PG8_STAGE(PG8_SA(1, 0), cA + kstep, voffA); PG8_STAGE(PG8_SB(1, 1), cB + hstep + kstep, voffB);
        PG8_WAIT_V(6); PG8_BAR;
    } else {
        PG8_STAGE(PG8_SB(0, 0), cB, voffB); PG8_STAGE(PG8_SA(0, 0), cA, voffA); PG8_STAGE(PG8_SB(0, 1), cB + hstep, voffB); PG8_STAGE(PG8_SA(0, 1), cA + hstep, voffA);
        if (wr == 1) PG8_BAR;
        PG8_WAIT_V(4); PG8_BAR;
        PG8_STAGE(PG8_SB(1, 0), cB + kstep, voffB); PG8_STAGE(PG8_SA(1, 0), cA + kstep, voffA); PG8_STAGE(PG8_SB(1, 1), cB + hstep + kstep, voffB);
        PG8_WAIT_V(6); PG8_BAR;
    }
    for (;;) {
        const bool has_next = S.next(ui + 1, nxt);
        const char* nA = has_next ? (const char*)g.A + (size_t)nxt.pm * tstep : cA; const char* nB = has_next ? (const char*)g.Bt + (size_t)nxt.pn * tstep : cB;
        for (int t = 0; t < nt; t += 2) {
            const bool last = (t == nt - 2);
            const char* a1 = cA + (size_t)(t + 1) * kstep;
            const char* a2 = last ? nA : cA + (size_t)(t + 2) * kstep; const char* b2 = last ? nB : cB + (size_t)(t + 2) * kstep;
            const char* a3 = a2 + kstep; const char* b3 = b2 + kstep;
            if (last && has_next) S.a_ready(nxt);
            if constexpr (SP2) {
            PG8_LDB(B0, 0, 0); PG8_LDB(B1, 0, 1); PG8_SCHED; PG8_LDA(At, 0, 0); PG8_STAGE(PG8_SA(1, 1), a1 + hstep, voffA);
            PG8_WAIT_V(8); PG8_WAIT_L(0); PG8_BAR; PG8_MMA(0, 0, At, B0); PG8_MMA(0, 1, At, B1); PG8_BAR; PG8_SCHED;
            PG8_LDA(At, 0, 1); PG8_STAGE(PG8_SB(0, 0), b2, voffB); PG8_STAGE(PG8_SB(0, 1), b2 + hstep, voffB); PG8_STAGE(PG8_SA(0, 0), a2, voffA);
            PG8_WAIT_V(8); PG8_WAIT_L(0); PG8_BAR; PG8_MMA(1, 0, At, B0); PG8_MMA(1, 1, At, B1); PG8_BAR; PG8_SCHED;
            PG8_LDB(B0, 1, 0); PG8_LDB(B1, 1, 1); PG8_SCHED; PG8_LDA(At, 1, 0); PG8_STAGE(PG8_SA(0, 1), a2 + hstep, voffA);
            PG8_WAIT_V(8); PG8_WAIT_L(0); PG8_BAR; PG8_MMA(0, 0, At, B0); PG8_MMA(0, 1, At, B1); PG8_BAR; PG8_SCHED;
            PG8_LDA(At, 1, 1); PG8_STAGE(PG8_SB(1, 0), b3, voffB); PG8_STAGE(PG8_SB(1, 1), b3 + hstep, voffB); PG8_STAGE(PG8_SA(1, 0), a3, voffA);
            PG8_WAIT_V(8); PG8_WAIT_L(0); PG8_BAR; PG8_MMA(1, 0, At, B0); PG8_MMA(1, 1, At, B1); PG8_BAR; PG8_SCHED;
            } else {
            PG8_LDB(B0, 0, 0); PG8_SCHED; PG8_LDA(At, 0, 0); PG8_STAGE(PG8_SA(1, 1), a1 + hstep, voffA);
            PG8_WAIT_L(8); PG8_BAR; PG8_WAIT_L(0); PG8_MMA(0, 0, At, B0); PG8_BAR; PG8_SCHED;
            PG8_LDB(B1, 0, 1); PG8_STAGE(PG8_SB(0, 0), b2, voffB);
            PG8_BAR; PG8_WAIT_L(0); PG8_MMA(0, 1, At, B1); PG8_BAR;
            PG8_LDA(At, 0, 1); PG8_STAGE(PG8_SA(0, 0), a2, voffA);
            PG8_BAR; PG8_WAIT_L(0); PG8_MMA(1, 0, At, B0); PG8_BAR; PG8_SCHED;
            PG8_STAGE(PG8_SB(0, 1), b2 + hstep, voffB);
            PG8_WAIT_V(6); PG8_BAR; PG8_MMA(1, 1, At, B1); PG8_BAR;
            PG8_LDB(B0, 1, 0); PG8_SCHED; PG8_LDA(At, 1, 0); PG8_STAGE(PG8_SA(0, 1), a2 + hstep, voffA);
            PG8_WAIT_L(8); PG8_BAR; PG8_WAIT_L(0); PG8_MMA(0, 0, At, B0); PG8_BAR; PG8_SCHED;
            PG8_LDB(B1, 1, 1); PG8_STAGE(PG8_SB(1, 0), b3, voffB);
            PG8_BAR; PG8_WAIT_L(0); PG8_MMA(0, 1, At, B1); PG8_BAR;
            PG8_LDA(At, 1, 1); PG8_STAGE(PG8_SA(1, 0), a3, voffA);
            PG8_BAR; PG8_WAIT_L(0); PG8_MMA(1, 0, At, B0); PG8_BAR; PG8_SCHED;
            PG8_STAGE(PG8_SB(1, 1), b3 + hstep, voffB);
            PG8_WAIT_V(6); PG8_BAR; PG8_MMA(1, 1, At, B1); PG8_BAR;
            }
        }
        if constexpr (ALIGN_EPI) { if (wr == 0) PG8_BAR; }
        if constexpr (Epi::FP8) asm volatile("s_nop 15\n\ts_nop 15" ::: "memory");
        if constexpr (!Epi::AFTER_DRAIN) { E(acc, cur, wr, wc, fr, fq); if constexpr (Epi::PROBE_TWICE) { asm volatile("" ::: "memory"); E(acc, cur, wr, wc, fr, fq); } S.done(cur); }
        if (!has_next) break;
#pragma unroll
        for (int a = 0; a < 2; ++a)
#pragma unroll
            for (int b = 0; b < 2; ++b)
#pragma unroll
                for (int m = 0; m < 4; ++m)
#pragma unroll
                    for (int n = 0; n < 2; ++n) acc[a][b][m][n] = (f32x4){0.f, 0.f, 0.f, 0.f};
        cur = nxt; cA = nA; cB = nB; ++ui;
        if constexpr (ALIGN_EPI) { if (wr == 1) PG8_BAR; }
    }
    PG8_WAIT_V(0);
    if constexpr (!ALIGN_EPI) { if (wr == 0) PG8_BAR; }
    PG8_BAR;
    if constexpr (Epi::AFTER_DRAIN) { E.fused(acc, cur, wr, wc, fr, fq, lds, wid, lane); S.done(cur); }
#undef PG8_SA
#undef PG8_SB
#undef PG8_STAGE
#undef PG8_LDA
#undef PG8_LDB
#undef PG8_MMA
#undef PG8_WAIT_V
#undef PG8_WAIT_L
#undef PG8_BAR
#undef PG8_SCHED
}
}
#define GAS __attribute__((address_space(1)))
#define LAS __attribute__((address_space(3)))
typedef unsigned short bf16;
typedef unsigned v4u __attribute__((ext_vector_type(4)));
typedef unsigned v2u __attribute__((ext_vector_type(2)));
typedef float f32x4 __attribute__((ext_vector_type(4)));
typedef float f32x16 __attribute__((ext_vector_type(16)));
typedef short bf16x8 __attribute__((ext_vector_type(8)));
typedef short s16x4 __attribute__((ext_vector_type(4)));
typedef GAS unsigned gu32;
#define RLX_AGENT __ATOMIC_RELAXED, __HIP_MEMORY_SCOPE_AGENT
#define LDS_WAIT() asm volatile("s_waitcnt lgkmcnt(0)" ::: "memory")
#define VM_WAIT() asm volatile("s_waitcnt vmcnt(0)" ::: "memory")
__device__ __forceinline__ unsigned f2bf(float f) { unsigned u = __builtin_bit_cast(unsigned, f); return (u + 0x7fffu + ((u >> 16) & 1u)) >> 16; }
__device__ __forceinline__ unsigned pk2(float lo, float hi) { unsigned r; asm("v_cvt_pk_bf16_f32 %0, %1, %2" : "=v"(r) : "v"(lo), "v"(hi)); return r; }
__device__ __forceinline__ unsigned pk2_t(float lo, float hi) { return pg8::cvt_pk_bf16_t(lo, hi); }
__device__ __forceinline__ float bflo(unsigned w) { return __uint_as_float(w << 16); }
__device__ __forceinline__ float bfhi(unsigned w) { return __uint_as_float(w & 0xffff0000u); }
__device__ __forceinline__ float wave_sum(float v) {
#pragma unroll
    for (int o = 1; o < 64; o <<= 1) v += __shfl_xor(v, o);
    return v;
}
#define XB_TMO      128
#define XB_XCNT(j)  (256  + 64 * (j))
#define XB_XSUB(j)  (1280 + 64 * (j))
#define XB_XGEN(j)  (2304 + 64 * (j))
#define XB_TOP      3328
#define XB_TOPGEN   3392
#define XCD_BAR_WORDS 3456
#define XB_SPIN_CAP (1u << 18)

__device__ __forceinline__ unsigned xb_ld(unsigned* p)              { return __hip_atomic_load(p, __ATOMIC_RELAXED, __HIP_MEMORY_SCOPE_AGENT); }
__device__ __forceinline__ unsigned xb_add(unsigned* p, unsigned v) { return __hip_atomic_fetch_add(p, v, __ATOMIC_RELAXED, __HIP_MEMORY_SCOPE_AGENT); }
__device__ __forceinline__ unsigned xb_xcc_id() { return (unsigned)__builtin_amdgcn_s_getreg((3 << 11) | 20) & 0xFu; }
#define XB_SPIN(cond, bar) do { unsigned _sp = 0; while (cond) { __builtin_amdgcn_s_sleep(1); \
    if ((++_sp & 255u) == 0u) { if (xb_ld(&(bar)[XB_TMO])) break; if (_sp > XB_SPIN_CAP) { atomicAdd(&(bar)[XB_TMO], 1u); break; } } } } while (0)

struct XcdBarrier {
    unsigned* bar; unsigned x;
    volatile LAS unsigned* st;
};

__device__ __forceinline__ XcdBarrier xcd_barrier_post(unsigned* bar, volatile LAS unsigned* st) {
    XcdBarrier b; b.bar = bar; b.x = xb_xcc_id(); b.st = st;
    if (threadIdx.x == 0) (void)xb_add(&bar[XB_XCNT(b.x)], 1u);
    return b;
}
__device__ __forceinline__ void xcd_barrier_complete(unsigned* bar, unsigned x, unsigned& nloc, unsigned& nx) {
    const unsigned G = gridDim.x * gridDim.y * gridDim.z;
    unsigned sum, cnt, mine, sp = 0u;
    for (;;) {
        sum = 0u; cnt = 0u; mine = 0u;
#pragma unroll
        for (unsigned j = 0; j < 16; ++j) { const unsigned c = xb_ld(&bar[XB_XCNT(j)]); sum += c; cnt += (c > 0u) ? 1u : 0u; mine = (j == x) ? c : mine; }
        if (sum == G) break;
        __builtin_amdgcn_s_sleep(1);
        if ((++sp & 255u) == 0u) { if (xb_ld(&bar[XB_TMO])) break; if (sp > XB_SPIN_CAP) { atomicAdd(&bar[XB_TMO], 1u); break; } }
    }
    nloc = mine > 0u ? mine : 1u; nx = cnt > 0u ? cnt : 1u;
}

__device__ __forceinline__ void xcd_barrier(const XcdBarrier& b) {
    asm volatile("s_waitcnt vmcnt(0)" ::: "memory");
    __syncthreads();
    if (threadIdx.x == 0) {
        unsigned* bar = b.bar;
        __builtin_amdgcn_s_waitcnt(0);
        unsigned nloc = b.st[0], nx = b.st[1];
        if (nloc == 0u) { xcd_barrier_complete(bar, b.x, nloc, nx); b.st[0] = nloc; b.st[1] = nx; }
        const unsigned old = xb_add(&bar[XB_XSUB(b.x)], 1u);
        const unsigned gen = old / nloc;
        if (old + 1u == (gen + 1u) * nloc) {
            __builtin_amdgcn_fence(__ATOMIC_RELEASE, "agent");
            asm volatile("s_waitcnt vmcnt(0)" ::: "memory");
            const unsigned og = xb_add(&bar[XB_TOP], 1u);
            const unsigned tg = og / nx;
            if (og + 1u == (tg + 1u) * nx) xb_add(&bar[XB_TOPGEN], 1u);
            else XB_SPIN(xb_ld(&bar[XB_TOPGEN]) == tg, bar);
            __builtin_amdgcn_fence(__ATOMIC_ACQUIRE, "agent");
            xb_add(&bar[XB_XGEN(b.x)], 1u);
            asm volatile("s_waitcnt vmcnt(0)" ::: "memory");
        } else {
            XB_SPIN(xb_ld(&bar[XB_XGEN(b.x)]) == gen, bar);
            __builtin_amdgcn_fence(__ATOMIC_ACQUIRE, "agent");
            asm volatile("s_waitcnt vmcnt(0)" ::: "memory");
        }
    }
    __syncthreads();
}
struct MapPlain { const float* W; int N; __device__ __forceinline__ const float* operator()(int n, int& ld) const { ld = N; return W + n; } };
struct MapGU { const float* W; __device__ __forceinline__ const float* operator()(int n, int& ld) const { ld = DFF; const int pn = n >> 8, j = n & 127; return W + 128 * pn + j; } };
struct MapWin { const float* W; __device__ __forceinline__ const float* operator()(int n, int& ld) const { ld = INDIM; const int pn = n >> 8, ct = n & 255; int c;
        const int pl = 64 * ((ct >> 5) & 3) + 32 * (ct >> 7) + (ct & 31);
        if (pn < 20) c = 256 * pn + pl;
        else if (pn < 25) { const int bj = ct >> 7, wc = (ct >> 5) & 3, j = ct & 31; c = (pn == 24 ? 6176 + 64 * wc : 5152 + 64 * (4 * (pn - 20) + wc)) + 32 * bj + j; }
        else if (pn == 25) c = 6432 + pl;
        else if (pn < 30) c = 6704 + 256 * (pn - 26) + pl;
        else if (pn < 34) c = 7728 + 256 * (pn - 30) + pl;
        else c = ct < 32 ? 5120 + ct : (ct < 48 ? 6688 + (ct - 32) : -1);
        return c < 0 ? nullptr : W + c; } };
template <class Map> __device__ __forceinline__ void p0_transpose_item(const Map& mp, const float* ksc, int K, bf16* WT, LAS float* scr, int kb, int nb, int lane, unsigned char* W8 = nullptr, float SC = 1.f) {
    const int k0 = 64 * kb, n0 = 64 * nb; int ld; const float* src = mp(n0 + lane, ld);
    float v[64];
#pragma unroll
    for (int i = 0; i < 64; ++i) v[i] = src ? src[(size_t)(k0 + i) * ld] : 0.f;
    const float sc = ksc ? ksc[k0 + lane] : 1.f;
#pragma unroll
    for (int i = 0; i < 64; ++i) scr[i * 65 + lane] = v[i] * __shfl(sc, i);
    LDS_WAIT(); asm volatile("" ::: "memory");
    const int c = lane & 7;
#pragma unroll
    for (int j = 0; j < 8; ++j) { const int n = (lane >> 3) + 8 * j; const LAS float* s = scr + (8 * c) * 65 + n;
        v4u o; o.x = pk2(s[0 * 65], s[1 * 65]); o.y = pk2(s[2 * 65], s[3 * 65]); o.z = pk2(s[4 * 65], s[5 * 65]); o.w = pk2(s[6 * 65], s[7 * 65]);
        if (WT) *(GAS v4u*)(WT + (size_t)(n0 + n) * K + k0 + 8 * c) = o;
        if (W8) { int w0 = 0, w1 = 0;
            w0 = __builtin_amdgcn_cvt_pk_fp8_f32(s[0 * 65] * SC, s[1 * 65] * SC, w0, false); w0 = __builtin_amdgcn_cvt_pk_fp8_f32(s[2 * 65] * SC, s[3 * 65] * SC, w0, true);
            w1 = __builtin_amdgcn_cvt_pk_fp8_f32(s[4 * 65] * SC, s[5 * 65] * SC, w1, false); w1 = __builtin_amdgcn_cvt_pk_fp8_f32(s[6 * 65] * SC, s[7 * 65] * SC, w1, true);
            v2u o8; o8.x = (unsigned)w0; o8.y = (unsigned)w1; *(GAS v2u*)(W8 + (size_t)(n0 + n) * K + k0 + 8 * c) = o8; } }
    LDS_WAIT(); asm volatile("" ::: "memory");
}
__device__ __forceinline__ void p0_row_to_bf16(const float* xrow, bf16* orow, pg8::ssq_t* ssq, int lane) {
    const GAS f32x4* xr = (const GAS f32x4*)xrow + lane;
    f32x4 v[4]; float s = 0.f;
#pragma unroll
    for (int j = 0; j < 4; ++j) { v[j] = xr[64 * j]; s += (v[j].x * v[j].x + v[j].y * v[j].y) + (v[j].z * v[j].z + v[j].w * v[j].w); }
    s = wave_sum(s);
    GAS unsigned long long* o8 = (GAS unsigned long long*)orow + lane;
#pragma unroll
    for (int j = 0; j < 4; ++j) o8[64 * j] = (unsigned long long)pk2(v[j].x, v[j].y) | ((unsigned long long)pk2(v[j].z, v[j].w) << 32);
    if (lane == 0) *ssq = pg8::ssq_fx(s);
}
__device__ __forceinline__ void p0_rows_to_bf16(const float* xrow, bf16* orow, pg8::ssq_t* ssq, int lane) {
    const GAS f32x4* xr = (const GAS f32x4*)xrow + lane;
    f32x4 v[8]; float s0 = 0.f, s1 = 0.f;
#pragma unroll
    for (int j = 0; j < 8; ++j) v[j] = xr[64 * j];
#pragma unroll
    for (int j = 0; j < 4; ++j) { s0 += (v[j].x * v[j].x + v[j].y * v[j].y) + (v[j].z * v[j].z + v[j].w * v[j].w); s1 += (v[4 + j].x * v[4 + j].x + v[4 + j].y * v[4 + j].y) + (v[4 + j].z * v[4 + j].z + v[4 + j].w * v[4 + j].w); }
    s0 = wave_sum(s0); s1 = wave_sum(s1);
    GAS unsigned long long* o8 = (GAS unsigned long long*)orow + lane;
#pragma unroll
    for (int j = 0; j < 8; ++j) o8[64 * j] = (unsigned long long)pk2(v[j].x, v[j].y) | ((unsigned long long)pk2(v[j].z, v[j].w) << 32);
    if (lane == 0) { ssq[0] = pg8::ssq_fx(s0); ssq[1] = pg8::ssq_fx(s1); }
}
__device__ __forceinline__ f32x16 mfma32(bf16x8 a, bf16x8 b, f32x16 c) { return __builtin_amdgcn_mfma_f32_32x32x16_bf16(a, b, c, 0, 0, 0); }
__device__ __forceinline__ int crow(int r, int hi) { return (r & 3) + 8 * (r >> 2) + 4 * hi; }
typedef short v4i16_t __attribute__((ext_vector_type(4)));
__device__ __forceinline__ s16x4 ds_tr(LAS const unsigned char* p) { return __builtin_bit_cast(s16x4, __builtin_amdgcn_ds_read_tr16_b64_v4i16((LAS v4i16_t*)p)); }
__device__ __forceinline__ bf16x8 tr_frag(LAS const unsigned char* tile, int pitch, int ka, int kb, int cb, int lane) {
    const int i = lane & 15, q = i >> 2, pp = i & 3, c16 = cb + 16 * ((lane >> 4) & 1);
    const s16x4 lo = ds_tr(tile + (ka + q) * pitch + (c16 + 4 * pp) * 2), hi = ds_tr(tile + (kb + q) * pitch + (c16 + 4 * pp) * 2);
    return (bf16x8){lo[0], lo[1], lo[2], lo[3], hi[0], hi[1], hi[2], hi[3]};
}
__device__ __forceinline__ float wave_scan_incl(float v, int lane) {
#pragma unroll
    for (int o = 1; o < 64; o <<= 1) { const float t = __shfl_up(v, o); if (lane >= o) v += t; }
    return v;
}
__device__ __forceinline__ float silu1(float x) { return x * __builtin_amdgcn_rcpf(1.f + __builtin_amdgcn_exp2f(-1.4426950408889634f * x)); }
__device__ __forceinline__ float exp_fast(float x) { return __builtin_amdgcn_exp2f(1.4426950408889634f * x); }
__device__ __forceinline__ void unpk8(const v4u w, float (&f)[8]) { f[0] = bflo(w.x); f[1] = bfhi(w.x); f[2] = bflo(w.y); f[3] = bfhi(w.y); f[4] = bflo(w.z); f[5] = bfhi(w.z); f[6] = bflo(w.w); f[7] = bfhi(w.w); }
__device__ __forceinline__ v4u pk8(const float (&f)[8]) { v4u o; o.x = pk2(f[0], f[1]); o.y = pk2(f[2], f[3]); o.z = pk2(f[4], f[5]); o.w = pk2(f[6], f[7]); return o; }

struct ConvW { float w[4][8]; float b[8]; };
__device__ __forceinline__ void conv_load_w(ConvW& cw, const float* convw, const float* convb, int col) {
#pragma unroll
    for (int j = 0; j < 4; ++j) { const f32x4 a = *(const f32x4*)(convw + (size_t)j * CONVD + col), b = *(const f32x4*)(convw + (size_t)j * CONVD + col + 4);
        cw.w[j][0] = a[0]; cw.w[j][1] = a[1]; cw.w[j][2] = a[2]; cw.w[j][3] = a[3]; cw.w[j][4] = b[0]; cw.w[j][5] = b[1]; cw.w[j][6] = b[2]; cw.w[j][7] = b[3]; }
    const f32x4 a = *(const f32x4*)(convb + col), b = *(const f32x4*)(convb + col + 4);
    cw.b[0] = a[0]; cw.b[1] = a[1]; cw.b[2] = a[2]; cw.b[3] = a[3]; cw.b[4] = b[0]; cw.b[5] = b[1]; cw.b[6] = b[2]; cw.b[7] = b[3];
}
__device__ __forceinline__ void conv_item(unsigned char* ws, const float* convw, const float* convb, int item, int lane) {
    asm volatile("" : "+v"(lane));
    const int cbk = item % 6, rb = item / 6; const int col = 512 * cbk + 8 * lane; const long row0 = 16l * rb; const int tpos0 = (int)(row0 & (SEQ - 1));
    const bf16* XBC = (const bf16*)(ws + WS_XBC); bf16* XC = (bf16*)(ws + WS_XC);
    v4u raw[19];
#pragma unroll
    for (int k = 0; k < 19; ++k) { raw[k] = (v4u){0u, 0u, 0u, 0u}; if (tpos0 - 3 + k >= 0) raw[k] = *(const GAS v4u*)(XBC + (size_t)(row0 - 3 + k) * CONVD + col); }
    ConvW cw; conv_load_w(cw, convw, convb, col);
    float x0[8], x1[8], x2[8], x3[8];
    unpk8(raw[0], x1); unpk8(raw[1], x2); unpk8(raw[2], x3);
#pragma unroll
    for (int k = 3; k < 19; ++k) {
#pragma unroll
        for (int e = 0; e < 8; ++e) { x0[e] = x1[e]; x1[e] = x2[e]; x2[e] = x3[e]; }
        unpk8(raw[k], x3); float y[8];
#pragma unroll
        for (int e = 0; e < 8; ++e) y[e] = silu1(cw.b[e] + cw.w[0][e] * x0[e] + cw.w[1][e] * x1[e] + cw.w[2][e] * x2[e] + cw.w[3][e] * x3[e]);
        *(GAS v4u*)(XC + (size_t)(row0 - 3 + k) * CONVD + col) = pk8(y); }
}

__device__ __forceinline__ void conv_item_q(unsigned char* ws, const float* convw, const float* convb, long row0, int colbase, int lane) {
    asm volatile("" : "+v"(lane));
    const int col = colbase + 8 * (lane & 15); const long r0 = row0 + 16 * (lane >> 4); const int tpos0 = (int)(r0 & (SEQ - 1));
    const bf16* XBC = (const bf16*)(ws + WS_XBC); bf16* XC = (bf16*)(ws + WS_XC);
    v4u raw[19];
#pragma unroll
    for (int k = 0; k < 19; ++k) { raw[k] = (v4u){0u, 0u, 0u, 0u}; if (tpos0 - 3 + k >= 0) raw[k] = *(const GAS v4u*)(XBC + (size_t)(r0 - 3 + k) * CONVD + col); }
    ConvW cw; conv_load_w(cw, convw, convb, col);
    float x0[8], x1[8], x2[8], x3[8];
    unpk8(raw[0], x1); unpk8(raw[1], x2); unpk8(raw[2], x3);
#pragma unroll
    for (int k = 3; k < 19; ++k) {
#pragma unroll
        for (int e = 0; e < 8; ++e) { x0[e] = x1[e]; x1[e] = x2[e]; x2[e] = x3[e]; }
        unpk8(raw[k], x3); float y[8];
#pragma unroll
        for (int e = 0; e < 8; ++e) y[e] = silu1(cw.b[e] + cw.w[0][e] * x0[e] + cw.w[1][e] * x1[e] + cw.w[2][e] * x2[e] + cw.w[3][e] * x3[e]);
        *(GAS v4u*)(XC + (size_t)(r0 - 3 + k) * CONVD + col) = pk8(y); }
}

constexpr int P4_BM = 0, P4_BM_PITCH = 320, P4_X = 40960, P4_X_PITCH = 1088, P4_WGT = P4_X + 64 * P4_X_PITCH;
static_assert(P4_WGT + 4096 <= MISC_OFF, "states LDS map");
__device__ __forceinline__ void p4_unit(unsigned char* ws, const float* convw, const float* convb, LAS unsigned char* lds, int unit, int tid, int lane, int wave) {
    asm volatile("" : "+v"(tid));
    lane = tid & 63;
    const int g = unit & 3, c = (unit >> 2) & 31, b = unit >> 7;
    const size_t row0 = (size_t)b * SEQ + (size_t)c * CHUNK;
    const bf16* XC = (const bf16*)(ws + WS_XC);
    const float* DT = (const float*)(ws + WS_DT); float* ACS = (float*)(ws + WS_ACS); const float* par = (const float*)(ws + WS_PAR);
    LAS float* wgtT = (LAS float*)(lds + P4_WGT);
    conv_item(ws, convw, convb, (int)(((row0 >> 4) + wave) * 6 + g), lane);
    if (wave < 4) conv_item_q(ws, convw, convb, (long)row0 + 64 * (wave & 1), ((wave >> 1) ? 2560 : 2048) + 128 * g, lane);
    __syncthreads();
    v4u braw[4], xraw[8];
#pragma unroll
    for (int i = 0; i < 4; ++i) { const int id = tid + 512 * i, l = id >> 4, ch = id & 15; braw[i] = *(const GAS v4u*)(XC + (row0 + l) * CONVD + 2048 + 128 * g + 8 * ch); }
#pragma unroll
    for (int i = 0; i < 8; ++i) { const int id = tid + 512 * i, l = id >> 6, ch = id & 63; xraw[i] = *(const GAS v4u*)(XC + (row0 + l) * CONVD + 512 * g + 8 * ch); }
    { const int hd = 8 * g + wave; const float Ah = -expf(par[PAR_ALOG + hd]);
      const float d0 = DT[(row0 + 2 * lane) * 32 + hd], d1 = DT[(row0 + 2 * lane + 1) * 32 + hd];
      const float a0 = d0 * Ah, a1 = d1 * Ah; const float inc = wave_scan_incl(a0 + a1, lane);
      const float acs1 = inc, acs0 = inc - a1, last = __shfl(inc, 63);
      wgtT[wave * 128 + 2 * lane] = d0 * exp_fast(last - acs0); wgtT[wave * 128 + 2 * lane + 1] = d1 * exp_fast(last - acs1);
      ACS[(row0 + 2 * lane) * 32 + hd] = acs0; ACS[(row0 + 2 * lane + 1) * 32 + hd] = acs1; }
#pragma unroll
    for (int i = 0; i < 4; ++i) { const int id = tid + 512 * i, l = id >> 4, ch = id & 15; *(LAS v4u*)(lds + P4_BM + l * P4_BM_PITCH + 16 * ch) = braw[i]; }
    f32x16 acc[2][4];
#pragma unroll
    for (int pt = 0; pt < 2; ++pt)
#pragma unroll
        for (int nt = 0; nt < 4; ++nt) acc[pt][nt] = (f32x16){};
#pragma unroll 1
    for (int hf = 0; hf < 2; ++hf) {
#pragma unroll
        for (int i = 0; i < 8; ++i) { const int id = tid + 512 * i, l = id >> 6, ch = id & 63; *(LAS v4u*)(lds + P4_X + l * P4_X_PITCH + 16 * ch) = xraw[i]; }
        __syncthreads();
        if (hf == 0) {
#pragma unroll
            for (int i = 0; i < 8; ++i) { const int id = tid + 512 * i, l = id >> 6, ch = id & 63; xraw[i] = *(const GAS v4u*)(XC + (row0 + 64 + l) * CONVD + 512 * g + 8 * ch); } }
        { LAS const unsigned char* xt = lds + P4_X; LAS const unsigned char* bm = lds + P4_BM; const int h = lane >> 5;
#pragma unroll
          for (int ks = 0; ks < 4; ++ks) { bf16x8 af[2], bfr[4];
              const f32x4 w0 = *(LAS const f32x4*)(wgtT + wave * 128 + 64 * hf + 16 * ks + 8 * h), w1 = *(LAS const f32x4*)(wgtT + wave * 128 + 64 * hf + 16 * ks + 8 * h + 4);
#pragma unroll
              for (int pt = 0; pt < 2; ++pt) { const v4u xr = __builtin_bit_cast(v4u, tr_frag(xt, P4_X_PITCH, 16 * ks + 8 * h, 16 * ks + 8 * h + 4, 64 * wave + 32 * pt, lane));
                  v4u xw; xw.x = pk2(bflo(xr.x) * w0[0], bfhi(xr.x) * w0[1]); xw.y = pk2(bflo(xr.y) * w0[2], bfhi(xr.y) * w0[3]); xw.z = pk2(bflo(xr.z) * w1[0], bfhi(xr.z) * w1[1]); xw.w = pk2(bflo(xr.w) * w1[2], bfhi(xr.w) * w1[3]);
                  af[pt] = __builtin_bit_cast(bf16x8, xw); }
#pragma unroll
              for (int nt = 0; nt < 4; ++nt) bfr[nt] = tr_frag(bm, P4_BM_PITCH, 64 * hf + 16 * ks + 8 * h, 64 * hf + 16 * ks + 8 * h + 4, 32 * nt, lane);
#pragma unroll
              for (int pt = 0; pt < 2; ++pt)
#pragma unroll
                  for (int nt = 0; nt < 4; ++nt) acc[pt][nt] = mfma32(af[pt], bfr[nt], acc[pt][nt]); } }
        __syncthreads();
    }
    { bf16* ST = (bf16*)(ws + WS_ST) + ((size_t)(b * NCHUNK + c) * SH + 8 * g + wave) * (SP * SN); const int h = lane >> 5, r = lane & 31;
#pragma unroll
      for (int pt = 0; pt < 2; ++pt)
#pragma unroll
          for (int nt = 0; nt < 4; ++nt)
#pragma unroll
              for (int q = 0; q < 16; ++q) ST[(32 * pt + crow(q, h)) * SN + 32 * nt + r] = (bf16)f2bf(acc[pt][nt][q]); }
}
constexpr int P4S_WAVE = 12288, P4S_BS = 0, P4S_CS = 4096, P4S_XS = 8192, P4S_YO = 10240;
__device__ __forceinline__ void p4s_item(unsigned char* ws, float* dout, const float* convw, const float* convb, const float* sconv, const float* sssm, LAS unsigned char* wl, int item, int lane) {
    asm volatile("" : "+v"(lane));
    const int hd = item & 31, b = item >> 5, g = hd >> 3; const size_t row0 = (size_t)MP + (size_t)b * DECS;
    const bf16* XBC = (const bf16*)(ws + WS_XBC); const float* DT = (const float*)(ws + WS_DT); const float* par = (const float*)(ws + WS_PAR); float* YRAW = (float*)(ws + WS_YRAW);
    LAS float* Bs = (LAS float*)(wl + P4S_BS); LAS float* Cs = (LAS float*)(wl + P4S_CS); LAS float* xsl = (LAS float*)(wl + P4S_XS); LAS float* yo = (LAS float*)(wl + P4S_YO);
    float xs[8];
#pragma unroll
    for (int part = 0; part < 5; ++part) {
        const int col = part == 0 ? 64 * hd + lane : (part == 1 ? 2048 + 128 * g + lane : (part == 2 ? 2048 + 128 * g + 64 + lane : (part == 3 ? 2560 + 128 * g + lane : 2560 + 128 * g + 64 + lane)));
        float xa[11];
#pragma unroll
        for (int j = 0; j < 3; ++j) xa[j] = sconv[((size_t)b * 3 + j) * CONVD + col];
#pragma unroll
        for (int i = 0; i < 8; ++i) xa[3 + i] = __uint_as_float((unsigned)XBC[(row0 + i) * CONVD + col] << 16);
        const float w0 = convw[col], w1 = convw[CONVD + col], w2 = convw[2 * CONVD + col], w3 = convw[3 * CONVD + col], bb = convb[col];
#pragma unroll
        for (int i = 0; i < 8; ++i) { const float y = silu1(bb + w0 * xa[i] + w1 * xa[i + 1] + w2 * xa[i + 2] + w3 * xa[i + 3]);
            if (part == 0) { xs[i] = y; xsl[i * 64 + lane] = y; } else if (part == 1) Bs[i * 128 + lane] = y; else if (part == 2) Bs[i * 128 + 64 + lane] = y; else if (part == 3) Cs[i * 128 + lane] = y; else Cs[i * 128 + 64 + lane] = y; }
        if (part == 0 || (hd & 7) == 0) {
#pragma unroll
            for (int j = 0; j < 3; ++j) dout[O_CONVS + ((size_t)b * 3 + j) * CONVD + col] = xa[8 + j]; }
    }
    float dt[8], acs[8]; { const float Ah = -expf(par[PAR_ALOG + hd]); float cs = 0.f;
#pragma unroll
      for (int i = 0; i < 8; ++i) { dt[i] = DT[(row0 + i) * 32 + hd]; cs += dt[i] * Ah; acs[i] = cs; } }
    float cb = 0.f; { const int l = lane >> 3, sx = lane & 7;
#pragma unroll 8
      for (int n = 0; n < 128; n += 4) { const f32x4 c = *(LAS const f32x4*)(Cs + l * 128 + n), bv = *(LAS const f32x4*)(Bs + sx * 128 + n); cb += (c[0] * bv[0] + c[1] * bv[1]) + (c[2] * bv[2] + c[3] * bv[3]); } }
    float y[8]; const float Dk = par[PAR_DSKIP + hd];
#pragma unroll
    for (int l = 0; l < 8; ++l) { float a = Dk * xs[l];
#pragma unroll
        for (int s = 0; s <= l; ++s) a += __shfl(cb, 8 * l + s) * exp_fast(acs[l] - acs[s]) * dt[s] * xs[s];
        y[l] = a; }
    const float* h0 = sssm + ((size_t)b * SH + hd) * (SP * SN); float* hout = dout + O_SSMS + ((size_t)b * SH + hd) * (SP * SN);
    float wg[8], ea[8];
#pragma unroll
    for (int l = 0; l < 8; ++l) { wg[l] = dt[l] * exp_fast(acs[7] - acs[l]); ea[l] = exp_fast(acs[l]); }
    const float ed = ea[7]; const int pp = lane >> 3, nc = lane & 7;
#pragma unroll 2
    for (int it = 0; it < 8; ++it) { const int p = 8 * it + pp;
        f32x4 hv[4], nv[4];
#pragma unroll
        for (int j = 0; j < 4; ++j) { hv[j] = *(const f32x4*)(h0 + p * SN + 16 * nc + 4 * j); nv[j] = hv[j] * ed; }
#pragma unroll
        for (int l = 0; l < 8; ++l) { const float xv = xsl[l * 64 + p] * wg[l]; float d = 0.f;
#pragma unroll
            for (int j = 0; j < 4; ++j) { const f32x4 c = *(LAS const f32x4*)(Cs + l * 128 + 16 * nc + 4 * j), bv = *(LAS const f32x4*)(Bs + l * 128 + 16 * nc + 4 * j);
                d += (c[0] * hv[j][0] + c[1] * hv[j][1]) + (c[2] * hv[j][2] + c[3] * hv[j][3]); nv[j] += bv * xv; }
            d += __shfl_xor(d, 1); d += __shfl_xor(d, 2); d += __shfl_xor(d, 4);
            if (nc == l) yo[l * 64 + p] = d; }
#pragma unroll
        for (int j = 0; j < 4; ++j) *(f32x4*)(hout + p * SN + 16 * nc + 4 * j) = nv[j]; }
#pragma unroll
    for (int l = 0; l < 8; ++l) YRAW[(size_t)(8 * b + l) * DSSM + 64 * hd + lane] = y[l] + ea[l] * yo[l * 64 + lane];
}
__device__ __forceinline__ void p4s_norm_item(unsigned char* ws, const float* ssdn, int item, int lane) {
    asm volatile("" : "+v"(lane));
    const int g = item & 3, i = item >> 2; const size_t row = (size_t)MP + i; const int ch0 = 512 * g + 8 * lane;
    const bf16* Zb = (const bf16*)(ws + WS_Z); bf16* YS = (bf16*)(ws + WS_YS); const float* YRAW = (const float*)(ws + WS_YRAW) + (size_t)i * DSSM + ch0;
    float z[8], y[8]; unpk8(*(const GAS v4u*)(Zb + row * DSSM + ch0), z); const f32x4 ya = *(const f32x4*)YRAW, yb = *(const f32x4*)(YRAW + 4); float ss = 0.f;
    y[0] = ya[0]; y[1] = ya[1]; y[2] = ya[2]; y[3] = ya[3]; y[4] = yb[0]; y[5] = yb[1]; y[6] = yb[2]; y[7] = yb[3];
#pragma unroll
    for (int e = 0; e < 8; ++e) { y[e] *= silu1(z[e]); ss += y[e] * y[e]; }
    ss = wave_sum(ss); const float rs = rsqrtf(ss * (1.f / 512.f) + 1e-6f);
#pragma unroll
    for (int e = 0; e < 8; ++e) y[e] = y[e] * rs * ssdn[ch0 + e];
    *(GAS v4u*)(YS + row * DSSM + ch0) = pk8(y);
}

__device__ __forceinline__ void p5_scan(unsigned char* ws, float* dout, int gtid, int gthreads) {
    bf16* ST = (bf16*)(ws + WS_ST); const float* ACS = (const float*)(ws + WS_ACS);
    for (int gid = gtid; gid < NBATCH * SH * SP * (SN / 8); gid += gthreads) {
        const int nch = gid & 15, p = (gid >> 4) & 63, hd = (gid >> 10) & 31, b = gid >> 15;
        float h[8] = {};
#pragma unroll 4
        for (int c = 0; c < NCHUNK; ++c) {
            GAS v4u* slot = (GAS v4u*)(ST + ((size_t)(b * NCHUNK + c) * SH + hd) * (SP * SN) + p * SN + nch * 8);
            const v4u sv = *slot; *slot = pk8(h);
            const float dec = expf(ACS[((size_t)b * SEQ + (size_t)c * CHUNK + CHUNK - 1) * 32 + hd]);
            float s[8]; unpk8(sv, s);
#pragma unroll
            for (int e = 0; e < 8; ++e) h[e] = dec * h[e] + s[e];
        }
        float* o = dout + O_SSMP + ((size_t)(b * SH + hd) * SP + p) * SN + nch * 8;
        *(f32x4*)o = (f32x4){h[0], h[1], h[2], h[3]}; *(f32x4*)(o + 4) = (f32x4){h[4], h[5], h[6], h[7]};
    }
}

constexpr int P6_C = 0, P6_B = 34816, P6_PITCH = 272, P6_X = 69632, P6_X_PITCH = 192, P6_X_WAVE = 32 * 192, P6_ACS = P6_X + 8 * P6_X_WAVE, P6_DT = P6_ACS + 4096, P6_SSQ = P6_DT + 4096;
static_assert(P6_SSQ + 4096 <= MISC_OFF, "phase 6 LDS map");
__device__ __forceinline__ float half_sum32(float v) {
    v += __shfl_xor(v, 1); v += __shfl_xor(v, 2); v += __shfl_xor(v, 4); v += __shfl_xor(v, 8); v += __shfl_xor(v, 16); return v; }
__device__ __forceinline__ void p6_unit(unsigned char* ws, const float* ssdn, LAS unsigned char* lds, int unit, int tid, int lane, int wave) {
    asm volatile("" : "+v"(tid));
    lane = tid & 63;
    const int g = unit & 3, c = (unit >> 2) & 31, b = unit >> 7; const size_t row0 = (size_t)b * SEQ + (size_t)c * CHUNK;
    const bf16* XC = (const bf16*)(ws + WS_XC); const float* DT = (const float*)(ws + WS_DT); const float* ACS = (const float*)(ws + WS_ACS); const float* par = (const float*)(ws + WS_PAR);
    const bf16* Zb = (const bf16*)(ws + WS_Z); bf16* YS = (bf16*)(ws + WS_YS);
    LAS float* acsT = (LAS float*)(lds + P6_ACS); LAS float* dtT = (LAS float*)(lds + P6_DT); LAS float* ssqT = (LAS float*)(lds + P6_SSQ);
    const int h = lane >> 5, r = lane & 31, hdl = wave, hd = 8 * g + wave;
    __syncthreads();
    v4u craw[4], braw[4], xraw[16];
#pragma unroll
    for (int i = 0; i < 4; ++i) { const int id = tid + 512 * i, l = id >> 4, ch = id & 15;
        craw[i] = *(const GAS v4u*)(XC + (row0 + l) * CONVD + 2560 + 128 * g + 8 * ch); braw[i] = *(const GAS v4u*)(XC + (row0 + l) * CONVD + 2048 + 128 * g + 8 * ch); }
#pragma unroll
    for (int i = 0; i < 16; ++i) { const int id = lane + 64 * i, rr = id >> 3, ch = id & 7; xraw[i] = *(const GAS v4u*)(XC + (row0 + rr) * CONVD + 512 * g + 64 * hdl + 8 * ch); }
    float ta[2], td[2];
#pragma unroll
    for (int i = 0; i < 2; ++i) { const int l = lane + 64 * i; ta[i] = ACS[(row0 + l) * 32 + hd]; td[i] = DT[(row0 + l) * 32 + hd]; }
    const float Dk = par[PAR_DSKIP + hd];
    const float gn0 = ssdn[512 * g + 64 * hdl + r], gn1 = ssdn[512 * g + 64 * hdl + 32 + r];
    const bf16* Hc = (const bf16*)(ws + WS_ST) + ((size_t)(b * NCHUNK + c) * SH + hd) * (SP * SN) + r * SN + 8 * h;
#pragma unroll
    for (int i = 0; i < 4; ++i) { const int id = tid + 512 * i, l = id >> 4, ch = id & 15; *(LAS v4u*)(lds + P6_C + l * P6_PITCH + 16 * ch) = craw[i]; *(LAS v4u*)(lds + P6_B + l * P6_PITCH + 16 * ch) = braw[i]; }
#pragma unroll
    for (int i = 0; i < 2; ++i) { acsT[hdl * 128 + lane + 64 * i] = ta[i]; dtT[hdl * 128 + lane + 64 * i] = td[i]; }
    LAS unsigned char* xb = lds + P6_X + wave * P6_X_WAVE;
    bf16x8 xf[4][2][2];
#pragma unroll
    for (int jb = 0; jb < 4; ++jb) {
#pragma unroll
        for (int i = 0; i < 4; ++i) { const int id = lane + 64 * i, rr = id >> 3, ch = id & 7; *(LAS v4u*)(xb + rr * P6_X_PITCH + 16 * ch) = xraw[4 * jb + i]; }
#pragma unroll
        for (int t = 0; t < 2; ++t)
#pragma unroll
            for (int pt = 0; pt < 2; ++pt) xf[jb][t][pt] = tr_frag(xb, P6_X_PITCH, 16 * t + 4 * h, 16 * t + 8 + 4 * h, 32 * pt, lane);
        asm volatile("s_waitcnt lgkmcnt(0)" ::: "memory");
    }
    __syncthreads();
    const bf16* Zw = Zb + (row0 + (lane >> 3)) * DSSM + 512 * g + 64 * hdl + 8 * (lane & 7);
    v4u zraw[4];
#pragma unroll
    for (int i = 0; i < 4; ++i) zraw[i] = *(const GAS v4u*)(Zw + (size_t)(8 * i) * DSSM);
#pragma unroll 1
    for (int lt = 0; lt < 4; ++lt) {
#pragma unroll
        for (int i = 0; i < 4; ++i) *(LAS v4u*)(xb + (8 * i + (lane >> 3)) * P6_X_PITCH + 16 * (lane & 7)) = zraw[i];
        if (lt < 3) {
#pragma unroll
            for (int i = 0; i < 4; ++i) zraw[i] = *(const GAS v4u*)(Zw + (size_t)(32 * (lt + 1) + 8 * i) * DSSM); }
        f32x16 acc[2]; acc[0] = (f32x16){}; acc[1] = (f32x16){};
        { bf16x8 hf[8], hg[8];
#pragma unroll
          for (int i = 0; i < 8; ++i) { hf[i] = *(const bf16x8*)(Hc + 16 * i); hg[i] = *(const bf16x8*)(Hc + 32 * SN + 16 * i); }
          bf16x8 cfr[8];
#pragma unroll
          for (int ks = 0; ks < 8; ++ks) cfr[ks] = *(LAS const bf16x8*)(lds + P6_C + (32 * lt + r) * P6_PITCH + (16 * ks + 8 * h) * 2);
          __builtin_amdgcn_sched_barrier(0);
#pragma unroll
          for (int ks = 0; ks < 8; ++ks) { acc[0] = mfma32(cfr[ks], hf[ks], acc[0]); acc[1] = mfma32(cfr[ks], hg[ks], acc[1]); }
          __builtin_amdgcn_sched_barrier(0); }
#pragma unroll
        for (int a = 0; a < 4; ++a) { const f32x4 av = *(LAS const f32x4*)(acsT + hdl * 128 + 32 * lt + 8 * a + 4 * h);
#pragma unroll
            for (int k = 0; k < 4; ++k) { const float ea = exp_fast(av[k]); acc[0][4 * a + k] *= ea; acc[1][4 * a + k] *= ea; } }
        const float al = acsT[hdl * 128 + 32 * lt + r];
#pragma unroll
        for (int jb = 0; jb < 4; ++jb) if (jb <= lt) {
            f32x16 X = (f32x16){};
            { bf16x8 bfr[8], cfr[8];
#pragma unroll
              for (int ks = 0; ks < 8; ++ks) { bfr[ks] = *(LAS const bf16x8*)(lds + P6_B + (32 * jb + r) * P6_PITCH + (16 * ks + 8 * h) * 2); cfr[ks] = *(LAS const bf16x8*)(lds + P6_C + (32 * lt + r) * P6_PITCH + (16 * ks + 8 * h) * 2); }
              __builtin_amdgcn_sched_barrier(0);
#pragma unroll
              for (int ks = 0; ks < 8; ++ks) X = mfma32(bfr[ks], cfr[ks], X);
              __builtin_amdgcn_sched_barrier(0); }
            unsigned gp[8];
#pragma unroll
            for (int a = 0; a < 4; ++a) { const f32x4 av = *(LAS const f32x4*)(acsT + hdl * 128 + 32 * jb + 8 * a + 4 * h), dv = *(LAS const f32x4*)(dtT + hdl * 128 + 32 * jb + 8 * a + 4 * h);
                float v[4];
#pragma unroll
                for (int k = 0; k < 4; ++k) { const int sl = 8 * a + 4 * h + k;
                    float gv = X[4 * a + k] * exp_fast(fminf(al - av[k], 0.f)) * dv[k];
                    if (jb == lt) { gv = (sl <= r) ? gv : 0.f; if (sl == r) gv += Dk; }
                    v[k] = gv; }
                gp[2 * a] = pk2(v[0], v[1]); gp[2 * a + 1] = pk2(v[2], v[3]); }
            const bf16x8 g0 = __builtin_bit_cast(bf16x8, (v4u){gp[0], gp[1], gp[2], gp[3]}), g1 = __builtin_bit_cast(bf16x8, (v4u){gp[4], gp[5], gp[6], gp[7]});
#pragma unroll
            for (int pt = 0; pt < 2; ++pt) { acc[pt] = mfma32(g0, xf[jb][0][pt], acc[pt]); acc[pt] = mfma32(g1, xf[jb][1][pt], acc[pt]); }
            __builtin_amdgcn_sched_barrier(0);
        }
        { const int i15 = lane & 15, qq = i15 >> 2, pp = i15 & 3, g16 = (lane >> 4) & 1;
#pragma unroll
          for (int a = 0; a < 4; ++a) { s16x4 zv[2];
#pragma unroll
              for (int pt = 0; pt < 2; ++pt) zv[pt] = ds_tr(xb + (8 * a + 4 * h + qq) * P6_X_PITCH + (32 * pt + 16 * g16 + 4 * pp) * 2);
#pragma unroll
              for (int k = 0; k < 4; ++k) { const int q = 4 * a + k, l = 32 * lt + crow(q, h);
                  const float y0 = acc[0][q] * silu1(__uint_as_float((unsigned)(unsigned short)zv[0][k] << 16)), y1 = acc[1][q] * silu1(__uint_as_float((unsigned)(unsigned short)zv[1][k] << 16)); acc[0][q] = y0; acc[1][q] = y1;
                  const float ss = half_sum32(y0 * y0 + y1 * y1); if (r == 0) ssqT[l * 8 + hdl] = ss; } } }
        __syncthreads();
#pragma unroll
        for (int q = 0; q < 16; ++q) { const int ll = crow(q, h), l = 32 * lt + ll;
            const f32x4 sa = *(LAS const f32x4*)(ssqT + l * 8), sb = *(LAS const f32x4*)(ssqT + l * 8 + 4);
            const float rs = rsqrtf(((sa[0] + sa[1]) + (sa[2] + sa[3]) + (sb[0] + sb[1]) + (sb[2] + sb[3])) * (1.f / 512.f) + 1e-6f);
            *(LAS bf16*)(xb + ll * 144 + r * 2) = (bf16)f2bf(acc[0][q] * rs * gn0); *(LAS bf16*)(xb + ll * 144 + (32 + r) * 2) = (bf16)f2bf(acc[1][q] * rs * gn1); }
#pragma unroll
        for (int i = 0; i < 4; ++i) { const int l2 = 8 * i + (lane >> 3), ch = lane & 7;
            *(GAS v4u*)(YS + (row0 + 32 * lt + l2) * DSSM + 512 * g + 64 * hdl + 8 * ch) = *(LAS const v4u*)(xb + l2 * 144 + 16 * ch); }
    }
}
__device__ __forceinline__ void ptot_item(unsigned char* ws, const float* clogf, const int* ptab, int item, int lane) {
    asm volatile("" : "+v"(lane));
    const int b = item >> 7, pg = item & 127; const int pid = ptab[b * NPAGES + pg];
    const float* src = clogf + (size_t)pid * PAGE * AH; const int h = lane & 15, rg = lane >> 4; float s = 0.f;
#pragma unroll
    for (int i = 0; i < 32; ++i) s += src[(32 * rg + i) * AH + h];
    s += __shfl_xor(s, 16); s += __shfl_xor(s, 32);
    if (lane < 16) ((float*)(ws + WS_PTOT))[(size_t)item * AH + h] = s;
}
__device__ __forceinline__ void cpl_item(unsigned char* ws, const float* clogf, const int* ptab, int item, int lane) {
    asm volatile("" : "+v"(lane));
    const int b = item >> 7, pg = item & 127; const int pid = ptab[b * NPAGES + pg];
    const float* src = clogf + (size_t)pid * PAGE * AH; const float* ptot = (const float*)(ws + WS_PTOT) + (size_t)b * NPAGES * AH;
    const int h = lane & 15, rg = lane >> 4; float off = 0.f;
#pragma unroll 8
    for (int p = rg; p < pg; p += 4) off += ptot[p * AH + h];
    off += __shfl_xor(off, 16); off += __shfl_xor(off, 32);
    float v[32], s = 0.f;
#pragma unroll
    for (int i = 0; i < 32; ++i) { s += src[(32 * rg + i) * AH + h]; v[i] = s; }
    const float t0 = __shfl(s, h), t1 = __shfl(s, 16 + h), t2 = __shfl(s, 32 + h);
    off += (rg > 0 ? t0 : 0.f) + (rg > 1 ? t1 : 0.f) + (rg > 2 ? t2 : 0.f);
    float* dst = (float*)(ws + WS_CPL) + ((size_t)b * PAST + (size_t)pg * PAGE) * AH;
#pragma unroll
    for (int i = 0; i < 32; ++i) dst[(32 * rg + i) * AH + h] = (off + v[i]) * 1.4426950408889634f;
}
__device__ __forceinline__ void ck_item(unsigned char* ws, int item, int lane) {
    asm volatile("" : "+v"(lane));
    const int h = item & 15, b = item >> 4;
    const float* LOGF = (const float*)(ws + WS_LOGF) + ((size_t)b * SEQ + 64 * lane) * AH + h; float* CK = (float*)(ws + WS_CK) + ((size_t)b * AH + h) * SEQ + 64 * lane;
    float v[64], s = 0.f;
#pragma unroll
    for (int i = 0; i < 64; ++i) v[i] = LOGF[(size_t)i * AH];
#pragma unroll
    for (int i = 0; i < 64; ++i) { s += v[i]; v[i] = s; }
    const float off = wave_scan_incl(s, lane) - s;
#pragma unroll
    for (int i = 0; i < 64; i += 4) *(f32x4*)(CK + i) = (f32x4){(off + v[i]) * 1.4426950408889634f, (off + v[i + 1]) * 1.4426950408889634f, (off + v[i + 2]) * 1.4426950408889634f, (off + v[i + 3]) * 1.4426950408889634f};
}
#include <hip/hip_bf16.h>
#include <cmath>
namespace attn_body {
using bf16=__hip_bfloat16;
using bf16x8=__attribute__((ext_vector_type(8)))short;
using s16x4=__attribute__((ext_vector_type(4)))short;
using f32x16=__attribute__((ext_vector_type(16)))float;
using u32x4=__attribute__((ext_vector_type(4)))unsigned;
constexpr int BATCH=4,NHEAD=16,SEQ=4096,D=64,DM=NHEAD*D,KP=256;
constexpr int NW=8,QBLK=32,QB=QBLK*NW,KVBLK=64,NQB=SEQ/QB;
constexpr int ATTN_PITCH=DM, ATTN_UNIT_ROWS=QB;
__device__ __forceinline__ int crow(int r,int hi){return (r&3)+8*(r>>2)+4*hi;}
#define SBAR() __builtin_amdgcn_sched_barrier(0)
__device__ __forceinline__ void cmask(f32x16&p0,f32x16&p1,int jb,int qrel,int hi){
  const float NEG=-INFINITY; int kb=64*jb+4*hi;
  #pragma unroll
  for(int r=0;r<16;++r){int kv=kb+(r&3)+8*(r>>2); if(kv>qrel)p0[r]=NEG; if(kv+32>qrel)p1[r]=NEG;}
}

constexpr int NSLOT=3, SLOTB=8192;
constexpr int LDS_K=0, LDS_V=NSLOT*SLOTB, LDS_WS=2*NSLOT*SLOTB, LDS_OST=LDS_WS+NW*64*4, LDS_CK=LDS_OST+NW*4096, LDS_BYTES=LDS_CK+SEQ*4;
constexpr float C2=0.125f*1.4426950408889634f;
__device__ __forceinline__ void glds16(const void*gsrc,unsigned lds_dst){unsigned keep;
  asm volatile("s_mov_b32 %0, m0\n\ts_mov_b32 m0, %2\n\ts_nop 0\n\tglobal_load_lds_dwordx4 %1, off\n\ts_mov_b32 m0, %0":"=&s"(keep):"v"(gsrc),"s"(lds_dst):"memory");}
__device__ __forceinline__ float max3f(float a,float b,float c){float r;asm("v_max3_f32 %0, %1, %2, %3":"=v"(r):"v"(a),"v"(b),"v"(c));return r;}
__device__ __forceinline__ float max2f(float a,float b){float r;asm("v_max_f32_e32 %0, %1, %2":"=v"(r):"v"(a),"v"(b));return r;}
__device__ __forceinline__ float fadd_s(float a,float b){float r;asm("v_add_f32_e32 %0, %1, %2":"=v"(r):"v"(a),"v"(b));return r;}
__device__ __forceinline__ float fsub_s(float a,float b){float r;asm("v_sub_f32_e32 %0, %1, %2":"=v"(r):"v"(a),"v"(b));return r;}
typedef float f32x2_t __attribute__((ext_vector_type(2))); typedef float f32x4_t __attribute__((ext_vector_type(4))); typedef __bf16 bf16x2_t __attribute__((ext_vector_type(2)));
__device__ __forceinline__ unsigned cvtpk_s(float lo,float hi){f32x2_t v={lo,hi};bf16x2_t b=__builtin_convertvector(v,bf16x2_t);return __builtin_bit_cast(unsigned,b);}
#define WAIT_BAR(N) asm volatile("s_waitcnt vmcnt(" #N ") lgkmcnt(0)\n\ts_barrier":::"memory")

__device__ __forceinline__ void qkt(f32x16&p0,f32x16&p1,const char*Kslot,const bf16x8*qr,int r32,int hi){
  const char*kb=Kslot+hi*1024+r32*16;
  #pragma unroll
  for(int d0=0;d0<4;++d0){
    const bf16x8 b0=*reinterpret_cast<const bf16x8*>(kb+d0*2048);
    const bf16x8 b1=*reinterpret_cast<const bf16x8*>(kb+d0*2048+512);
    {p0=__builtin_amdgcn_mfma_f32_32x32x16_bf16(b0,qr[d0],p0,0,0,0);p1=__builtin_amdgcn_mfma_f32_32x32x16_bf16(b1,qr[d0],p1,0,0,0);}}
}
typedef __attribute__((address_space(3))) char* lds_cptr;
typedef short v4i16_t __attribute__((ext_vector_type(4)));
__device__ __forceinline__ void kload8(bf16x8*kf,lds_cptr kp){
  kf[0]=*(const __attribute__((address_space(3))) bf16x8*)(kp);      kf[1]=*(const __attribute__((address_space(3))) bf16x8*)(kp+512);
  kf[2]=*(const __attribute__((address_space(3))) bf16x8*)(kp+2048); kf[3]=*(const __attribute__((address_space(3))) bf16x8*)(kp+2560);
  kf[4]=*(const __attribute__((address_space(3))) bf16x8*)(kp+4096); kf[5]=*(const __attribute__((address_space(3))) bf16x8*)(kp+4608);
  kf[6]=*(const __attribute__((address_space(3))) bf16x8*)(kp+6144); kf[7]=*(const __attribute__((address_space(3))) bf16x8*)(kp+6656);
}
__device__ __forceinline__ void kload2(bf16x8*kf,lds_cptr kp,int j){ kf[2*j]=*(const __attribute__((address_space(3))) bf16x8*)(kp+j*2048); kf[2*j+1]=*(const __attribute__((address_space(3))) bf16x8*)(kp+j*2048+512); }
__device__ __forceinline__ s16x4 vtr(lds_cptr p){ return __builtin_bit_cast(s16x4,__builtin_amdgcn_ds_read_tr16_b64_v4i16((__attribute__((address_space(3))) v4i16_t*)p)); }
__device__ __forceinline__ float rowmax(const f32x16&p0,const f32x16&p1){
  float a=max3f(p0[0],p0[1],p1[0]),b=max3f(p0[2],p0[3],p1[1]);a=max3f(a,p1[2],p1[3]);
  #pragma unroll
  for(int r=4;r<16;r+=4){a=max3f(a,p0[r],p0[r+1]);b=max3f(b,p0[r+2],p0[r+3]);a=max3f(a,p1[r],p1[r+1]);b=max3f(b,p1[r+2],p1[r+3]);}
  const float m=max2f(a,b);
  auto rr=__builtin_amdgcn_permlane32_swap(__float_as_uint(m),__float_as_uint(m),false,false);
  return max2f(__uint_as_float(rr[0]),__uint_as_float(rr[1]));
}
__device__ __forceinline__ void pv(f32x16*o,int vb,bf16x8 pa0,bf16x8 pa1,bf16x8 pa2,bf16x8 pa3){
  #pragma unroll
  for(int d0=0;d0<2;++d0){s16x4 lo[4],hi[4];
    #pragma unroll
    for(int ks=0;ks<4;++ks){
      asm volatile("ds_read_b64_tr_b16 %0,%1 offset:%c2":"=&v"(lo[ks]):"v"(vb),"i"(d0*4096+ks*1024):"memory");
      asm volatile("ds_read_b64_tr_b16 %0,%1 offset:%c2":"=&v"(hi[ks]):"v"(vb),"i"(d0*4096+ks*1024+512):"memory");}
    asm volatile("s_waitcnt lgkmcnt(0)":::"memory");SBAR();
    #define PK(k) (bf16x8){lo[k][0],lo[k][1],lo[k][2],lo[k][3],hi[k][0],hi[k][1],hi[k][2],hi[k][3]}
    o[d0]=__builtin_amdgcn_mfma_f32_32x32x16_bf16(pa0,PK(0),o[d0],0,0,0);
    o[d0]=__builtin_amdgcn_mfma_f32_32x32x16_bf16(pa1,PK(1),o[d0],0,0,0);
    o[d0]=__builtin_amdgcn_mfma_f32_32x32x16_bf16(pa2,PK(2),o[d0],0,0,0);
    o[d0]=__builtin_amdgcn_mfma_f32_32x32x16_bf16(pa3,PK(3),o[d0],0,0,0);
    #undef PK
  }
}

#ifndef ATTN_STORE16
#define ATTN_STORE16(p,v) (*(u32x4*)(p)=(v))
#endif
template<int THRL> __device__ __forceinline__ void attn_unit(int b,int h,int qb,const bf16*Q,const bf16*__restrict__ K,const bf16*__restrict__ V,bf16*O,const float*__restrict__ CKT,float skip_thr,char*shm){
  int tid_=threadIdx.x; asm volatile("":"+v"(tid_));
  const int tid=tid_,lane=tid&63,r32=lane&31,hi=lane>>5; const int wid=__builtin_amdgcn_readfirstlane(tid>>6);
  const long rowbase=(long)b*SEQ; const int q0=qb*QB;
  const bf16*Qw=Q+(rowbase+q0+wid*QBLK)*DM+h*D;
  const bf16*Kh=K+rowbase*KP+(h>>2)*D,*Vh=V+rowbase*KP+(h>>2)*D;
  const unsigned lds0=(unsigned)(uintptr_t)shm;
  float*wsf=(float*)(shm+LDS_WS)+wid*64;
  const bf16*ksrc=Kh+(long)lane*KP+wid*8;
  const bf16*vsrc=Vh+(long)(16*(wid&3)+(lane>>2))*KP+(wid>>2)*32+(lane&3)*8;
  const unsigned kdst=lds0+LDS_K+wid*1024, vdst=lds0+LDS_V+wid*1024;
  #define DMA_K(t,slot) glds16(ksrc+(long)((t)+t0)*KVBLK*KP,(unsigned)__builtin_amdgcn_readfirstlane(kdst+(slot)))
  #define DMA_V(t,slot) glds16(vsrc+(long)((t)+t0)*KVBLK*KP,(unsigned)__builtin_amdgcn_readfirstlane(vdst+(slot)))
  const int vb0=(int)(lds0+LDS_V)+((lane>>4)&1)*32+(lane&3)*8+(4*hi+((lane&15)>>2))*64;
  const char*Kbase=shm+LDS_K; bf16x8 kf[8];
  const lds_cptr shm3=(lds_cptr)shm; const lds_cptr kp0=shm3+LDS_K+hi*1024+r32*16; const lds_cptr vp0=shm3+LDS_V+((lane>>4)&1)*32+(lane&3)*8+(4*hi+((lane&15)>>2))*64;
  int NT=(q0+QB)/KVBLK;
  { __attribute__((address_space(3))) float*ckt=(__attribute__((address_space(3))) float*)(shm3+LDS_CK); const float*src=CKT+((long)b*NHEAD+h)*SEQ; for(int i=tid;i<q0+QB;i+=NW*64)ckt[i]=-src[i]; }
  asm volatile("s_waitcnt lgkmcnt(0)\n\ts_barrier":::"memory");
  int t0=0; { const __attribute__((address_space(3))) float*ck0=(const __attribute__((address_space(3))) float*)(shm3+LDS_CK); const float cq=ck0[q0];
    int lo=0,hi=NT-4;
    while(lo<hi){ const int mid=(lo+hi)>>1; if(cq-ck0[64*mid+63]>skip_thr)lo=mid+1; else hi=mid; }
    t0=lo&~1; }
  NT-=t0;
  const __attribute__((address_space(3))) float*ckt3=(const __attribute__((address_space(3))) float*)(shm3+LDS_CK)+64*t0;
  #define LDBIAS(C0,C1,t) do{ const __attribute__((address_space(3))) float*cp_=ckt3+64*(t)+4*hi; \
    _Pragma("unroll") for(int a_=0;a_<4;++a_){ const f32x4_t v0_=*(const __attribute__((address_space(3))) f32x4_t*)(cp_+8*a_), v1_=*(const __attribute__((address_space(3))) f32x4_t*)(cp_+32+8*a_); \
      _Pragma("unroll") for(int b_=0;b_<4;++b_){ C0[4*a_+b_]=v0_[b_]; C1[4*a_+b_]=v1_[b_]; } } }while(0)
  DMA_K(0,0);DMA_V(0,0);DMA_K(1,SLOTB);
  bf16x8 qr[4];
  #pragma unroll
  for(int d0=0;d0<4;++d0)qr[d0]=*reinterpret_cast<const bf16x8*>(&Qw[(long)r32*DM+d0*16+hi*8]);
  float mhat=0.f,l_reg=0.f;f32x16 o[2];o[0]=f32x16{};o[1]=f32x16{};
  const int qrel=wid*QBLK+r32;
  #define CMASK(P0,P1,t) do{int jb_=(t)-(NT-4); if(jb_>=0)cmask(P0,P1,jb_,qrel,hi);}while(0)
  bool resc=false;
  #define START(P0,P1) do{ const float rm=rowmax(P0,P1); resc=false; \
    { const float dl=rm; mhat=fadd_s(mhat,dl); \
      _Pragma("unroll") for(int r=0;r<16;++r){P0[r]=fsub_s(P0[r],dl);P1[r]=fsub_s(P1[r],dl);} \
      } \
    _Pragma("unroll") for(int r=0;r<16;++r)P0[r]=__builtin_amdgcn_exp2f(P0[r]); }while(0)
  #define RESC() do{ if(resc){ asm volatile("s_waitcnt lgkmcnt(0)":::"memory"); \
      _Pragma("unroll") for(int d_=0;d_<2;++d_) _Pragma("unroll") for(int r=0;r<16;++r)o[d_][r]*=wsf[crow(r,hi)]; } }while(0)
  f32x16 pA0,pA1,pB0,pB1;
  int sl_prev=0,sl_cur=0,sl_next=SLOTB;
  #define ROT() do{sl_prev=sl_cur;sl_cur=sl_next;sl_next=(sl_next==(NSLOT-1)*SLOTB)?0:sl_next+SLOTB;}while(0)
  DMA_K(2,2*SLOTB);
  WAIT_BAR(3);
  LDBIAS(pA0,pA1,0); qkt(pA0,pA1,Kbase,qr,r32,hi);asm volatile("s_nop 15\n\ts_nop 7":"+v"(pA0),"+v"(pA1));CMASK(pA0,pA1,0);
  START(pA0,pA1);
  _Pragma("unroll") for(int r=0;r<16;++r)pA1[r]=__builtin_amdgcn_exp2f(pA1[r]);
  LDBIAS(pB0,pB1,1);
  WAIT_BAR(0);
  DMA_K(3,0);DMA_V(1,SLOTB);
  ROT();
  kload8(kf,kp0+sl_cur);
  WAIT_BAR(2);
  s16x4 vlo[8],vhi[8]; u32x4 pw0,pw1,pw2,pw3;
  #define PKW(P,B) cvtpk_s(P[B],P[B+1])
  #define PAF(k) __builtin_bit_cast(bf16x8,pw##k)
  #define VFR(i) (bf16x8){vlo[i][0],vlo[i][1],vlo[i][2],vlo[i][3],vhi[i][0],vhi[i][1],vhi[i][2],vhi[i][3]}
  #define PIN(x) asm volatile("":"+v"(x))
  #define MX3(a,b,c) __builtin_fmaxf(__builtin_fmaxf((a),(b)),(c))
  #define GAPA(MF,A0,A1,A2,A3,W0,W1,PW) do{ MF; sacc+=A0; sacc+=A1; sacc+=A2; sacc+=A3; PIN(sacc); W0; W1; PIN(PW); SBAR(); }while(0)
  #define EX(v) __builtin_amdgcn_exp2f(v)
  #define GAPB(MF,X,B) do{ MF; X[B]=EX(X[B]-mh_); X[B+1]=EX(X[B+1]-mh_); X[B+2]=EX(X[B+2]-mh_); X[B+3]=EX(X[B+3]-mh_); PIN(X); SBAR(); }while(0)
  #define VRD(i) do{ vlo[i]=vtr(vp_+(((i)>>2)*4096+((i)&3)*1024)); vhi[i]=vtr(vp_+(((i)>>2)*4096+((i)&3)*1024+512)); }while(0)
  #define KRD(G,j) do{ if(G){ kload2(kf,kp0+sl_next,j); SBAR(); } }while(0)
  #define STEP(C0,C1,P0,P1,t,GK,GV,GL) do{ SBAR(); \
    const lds_cptr vp_=vp0+sl_prev; \
    VRD(0); SBAR(); float sacc=(P0[0]+P0[1]); \
    GAPA(C0=__builtin_amdgcn_mfma_f32_32x32x16_bf16(kf[0],qr[0],C0,0,0,0), P0[2],P0[3],P0[4],P0[5],     pw0[0]=PKW(P0,0), pw0[1]=PKW(P0,2), pw0); \
    VRD(4); SBAR(); GAPA(C1=__builtin_amdgcn_mfma_f32_32x32x16_bf16(kf[1],qr[0],C1,0,0,0), P0[6],P0[7],P0[8],P0[9],     pw0[2]=PKW(P0,4), pw0[3]=PKW(P0,6), pw0); \
    VRD(1); SBAR(); GAPA(C0=__builtin_amdgcn_mfma_f32_32x32x16_bf16(kf[2],qr[1],C0,0,0,0),   P0[10],P0[11],P0[12],P0[13], pw1[0]=PKW(P0,8), pw1[1]=PKW(P0,10), pw1); \
    VRD(5); SBAR(); GAPA(C1=__builtin_amdgcn_mfma_f32_32x32x16_bf16(kf[3],qr[1],C1,0,0,0),   P0[14],P0[15],P1[0],P1[1],   pw1[2]=PKW(P0,12),pw1[3]=PKW(P0,14), pw1); \
    VRD(2); SBAR(); GAPA(C0=__builtin_amdgcn_mfma_f32_32x32x16_bf16(kf[4],qr[2],C0,0,0,0),   P1[2],P1[3],P1[4],P1[5],     pw2[0]=PKW(P1,0), pw2[1]=PKW(P1,2), pw2); \
    VRD(6); SBAR(); GAPA(C1=__builtin_amdgcn_mfma_f32_32x32x16_bf16(kf[5],qr[2],C1,0,0,0),   P1[6],P1[7],P1[8],P1[9],     pw2[2]=PKW(P1,4), pw2[3]=PKW(P1,6), pw2); \
    VRD(3); SBAR(); GAPA(C0=__builtin_amdgcn_mfma_f32_32x32x16_bf16(kf[6],qr[3],C0,0,0,0),   P1[10],P1[11],P1[12],P1[13], pw3[0]=PKW(P1,8), pw3[1]=PKW(P1,10), pw3); \
    VRD(7); SBAR(); GAPA(C1=__builtin_amdgcn_mfma_f32_32x32x16_bf16(kf[7],qr[3],C1,0,0,0),   P1[14],P1[15],0.f,0.f,       pw3[2]=PKW(P1,12),pw3[3]=PKW(P1,14), pw3); \
    l_reg+=sacc; \
    if(GK){DMA_K((t)+3,sl_cur);} if(GV){DMA_V((t)+1,sl_next);} \
    CMASK(C0,C1,t); \
    { float a=MX3(C0[0],C0[1],C1[0]),b=MX3(C0[2],C0[3],C1[1]); a=MX3(a,C1[2],C1[3]); \
      _Pragma("unroll") for(int r=4;r<16;r+=4){a=MX3(a,C0[r],C0[r+1]);b=MX3(b,C0[r+2],C0[r+3]);a=MX3(a,C1[r],C1[r+1]);b=MX3(b,C1[r+2],C1[r+3]);} \
      float rm=__builtin_fmaxf(a,b); { auto rr=__builtin_amdgcn_permlane32_swap(__float_as_uint(rm),__float_as_uint(rm),false,false); rm=__builtin_fmaxf(__uint_as_float(rr[0]),__uint_as_float(rr[1])); } \
      resc=false; \
      rm-=mhat; \
      if(__builtin_expect(__any(rm>(float)THRL),0)){ const float dl=__builtin_fmaxf(rm,0.f); mhat+=dl; \
        const float f=__builtin_amdgcn_exp2f(-dl); l_reg*=f; if(hi==0)wsf[r32]=f; resc=true; } } \
    const float mh_=mhat; if(GL){ LDBIAS(P0,P1,(t)+1); } SBAR(); \
    GAPB(o[0]=__builtin_amdgcn_mfma_f32_32x32x16_bf16(PAF(0),VFR(0),o[0],0,0,0), C0,0); \
    GAPB(o[1]=__builtin_amdgcn_mfma_f32_32x32x16_bf16(PAF(0),VFR(4),o[1],0,0,0), C0,4); \
    KRD(GL,0); GAPB(o[0]=__builtin_amdgcn_mfma_f32_32x32x16_bf16(PAF(1),VFR(1),o[0],0,0,0), C0,8); \
    KRD(GL,1); GAPB(o[1]=__builtin_amdgcn_mfma_f32_32x32x16_bf16(PAF(1),VFR(5),o[1],0,0,0), C0,12); \
    KRD(GL,2); GAPB(o[0]=__builtin_amdgcn_mfma_f32_32x32x16_bf16(PAF(2),VFR(2),o[0],0,0,0), C1,0); \
    KRD(GL,3); GAPB(o[1]=__builtin_amdgcn_mfma_f32_32x32x16_bf16(PAF(2),VFR(6),o[1],0,0,0), C1,4); \
    GAPB(o[0]=__builtin_amdgcn_mfma_f32_32x32x16_bf16(PAF(3),VFR(3),o[0],0,0,0), C1,8); \
    GAPB(o[1]=__builtin_amdgcn_mfma_f32_32x32x16_bf16(PAF(3),VFR(7),o[1],0,0,0), C1,12); \
    }while(0)
  int t=1;
  #undef CMASK
  #define CMASK(P0,P1,t) do{}while(0)
  for(;t+5<NT;t+=2){
    STEP(pB0,pB1,pA0,pA1,t,true,true,true);     WAIT_BAR(2); RESC(); ROT();
    STEP(pA0,pA1,pB0,pB1,t+1,true,true,true);   WAIT_BAR(2); RESC(); ROT();
  }
  #undef CMASK
  #define CMASK(P0,P1,t) do{int jb_=(t)-(NT-4); if(jb_>=0)cmask(P0,P1,jb_,qrel,hi);}while(0)
  #define ENDW(tt) do{ if((tt)+3<NT){WAIT_BAR(2);} else if((tt)+2<NT){WAIT_BAR(1);} else {WAIT_BAR(0);} }while(0)
  for(;t+1<NT;t+=2){
    STEP(pB0,pB1,pA0,pA1,t,(t+3<NT),(t+1<NT),(t+1<NT));       ENDW(t);   RESC(); ROT();
    STEP(pA0,pA1,pB0,pB1,t+1,(t+4<NT),(t+2<NT),(t+2<NT));     ENDW(t+1); RESC(); ROT();
  }
  STEP(pB0,pB1,pA0,pA1,NT-1,false,false,false); RESC();
  { float sacc=pB0[0]+pB0[1]; _Pragma("unroll") for(int r=2;r<16;++r)sacc+=pB0[r]; _Pragma("unroll") for(int r=0;r<16;++r)sacc+=pB1[r]; l_reg+=sacc;
    pw0=(u32x4){PKW(pB0,0),PKW(pB0,2),PKW(pB0,4),PKW(pB0,6)};pw1=(u32x4){PKW(pB0,8),PKW(pB0,10),PKW(pB0,12),PKW(pB0,14)};pw2=(u32x4){PKW(pB1,0),PKW(pB1,2),PKW(pB1,4),PKW(pB1,6)};pw3=(u32x4){PKW(pB1,8),PKW(pB1,10),PKW(pB1,12),PKW(pB1,14)};
    SBAR(); pv(o,vb0+sl_cur,PAF(0),PAF(1),PAF(2),PAF(3)); }
  #undef PKW
  #undef PAF
  #undef VFR
  #undef PIN
  #undef MX3
  #undef GAPA
  #undef GAPB
  #undef EX
  #undef VRD
  #undef KRD
  #undef STEP
  #undef ENDW
  {auto rr=__builtin_amdgcn_permlane32_swap(__float_as_uint(l_reg),__float_as_uint(l_reg),false,false);l_reg=__uint_as_float(rr[0])+__uint_as_float(rr[1]);}
  if(hi==0)wsf[32+r32]=l_reg;asm volatile("s_waitcnt lgkmcnt(0)":::"memory");
  float rli[16];
  #pragma unroll
  for(int r=0;r<16;++r)rli[r]=__builtin_amdgcn_rcpf(wsf[32+crow(r,hi)]);
  bf16*Ow=O+(rowbase+q0+wid*QBLK)*DM+h*D;
  { bf16*stg=(bf16*)(shm+LDS_OST)+wid*2048;
    #pragma unroll
    for(int r=0;r<16;++r){const int orow=crow(r,hi);
      #pragma unroll
      for(int d0=0;d0<2;++d0)stg[orow*64+d0*32+r32]=__float2bfloat16(o[d0][r]*rli[r]);}
    asm volatile("s_waitcnt lgkmcnt(0)":::"memory");
    #pragma unroll
    for(int i=0;i<4;++i){const int row=i*8+(lane>>3),ch=lane&7; const u32x4 v=*(const u32x4*)(stg+row*64+ch*8); ATTN_STORE16(Ow+(long)row*DM+ch*8,v);} }
  asm volatile("s_waitcnt lgkmcnt(0)\n\ts_barrier":::"memory");
  #undef DMA_K
  #undef DMA_V
  #undef CMASK
  #undef START
  #undef RESC
  #undef ROT
}
constexpr int ATTN_LDS_BYTES=LDS_BYTES;
struct AttnTensors { const bf16* Q; const bf16* K; const bf16* V; bf16* O; const float* CKT; };
template<int THRL=8> __device__ __forceinline__ void attn_phase(char*lds,const AttnTensors&T,float skip_thr,int vcu,int G,int i_lo,int i_hi){
  for(int cl=vcu;cl<BATCH*NHEAD*4;cl+=G){ const int s=cl&3,bh=cl>>2;
    #pragma unroll 1
    for(int i=i_lo;i<i_hi;++i){ const int qb=(i==0)?s:(i==1)?7-s:(i==2)?8+s:15-s; attn_unit<THRL>(bh/NHEAD,bh%NHEAD,qb,T.Q,T.K,T.V,T.O,T.CKT,skip_thr,lds); } }
}
#undef SBAR
#undef WAIT_BAR
}
constexpr int DK_OFF = 0, DK_PITCH = 144, DK_HEAD = 64 * 144, DV_OFF = 4 * DK_HEAD, DV_PITCH = 192, DV_HEAD = 64 * 192, DC_OFF = DV_OFF + 4 * DV_HEAD, DW_OFF = DC_OFF + 4096;
constexpr int DPART_STRIDE = 32 + 32 + 32 * 64;
static_assert(DW_OFF + 2048 <= MISC_OFF, "decode LDS map");
__device__ __forceinline__ void dec_unit(unsigned char* ws, const float* ck, const float* cv, const int* ptab, LAS unsigned char* lds, int unit, int tid, int lane, int wave) {
    asm volatile("" : "+v"(tid));
    lane = tid & 63;
    const int b = unit & 31, sp = unit >> 5; const int kvh = wave >> 1, kh = wave & 1, h = lane >> 5, r = lane & 31, g = r >> 3, qi = r & 7, hq = 4 * kvh + g;
    const int tile0 = sp < 4 ? 35 * sp : (sp == 4 ? 140 : (sp == 5 ? 176 : (sp == 6 ? 212 : 238))), ntile = sp < 4 ? 35 : (sp < 6 ? 36 : (sp == 6 ? 26 : 18));
    const bf16* Qb = (const bf16*)(ws + WS_Q); const float* CPL = (const float*)(ws + WS_CPL) + ((size_t)b * PAST + (size_t)tile0 * 64) * AH;
    bf16x8 qf[4];
#pragma unroll
    for (int ks = 0; ks < 4; ++ks) qf[ks] = *(const bf16x8*)(Qb + ((size_t)MP + 8 * b + qi) * 1024 + hq * 64 + 16 * ks + 8 * h);
    float m;
    { const bf16* Kb = (const bf16*)(ws + WS_K) + ((size_t)MP + 8 * b + qi) * 256 + kvh * 64; const bf16* Qr = Qb + ((size_t)MP + 8 * b + qi) * 1024 + hq * 64; float d = 0.f;
#pragma unroll
      for (int k = 0; k < 8; ++k) { float qa[8], ka[8]; unpk8(*(const GAS v4u*)(Qr + 8 * k), qa); unpk8(*(const GAS v4u*)(Kb + 8 * k), ka);
#pragma unroll
          for (int e = 0; e < 8; ++e) d += qa[e] * ka[e]; }
      const float* LOGF = (const float*)(ws + WS_LOGF) + ((size_t)MP + 8 * b) * AH + hq; float cum = ((const float*)(ws + WS_CPL))[((size_t)b * PAST + PAST - 1) * AH + hq];
      for (int k = 0; k <= qi; ++k) cum += LOGF[k * AH] * 1.4426950408889634f;
      m = d - cum; }
    float l = 0.f; f32x16 o[2]; o[0] = (f32x16){}; o[1] = (f32x16){};
    LAS float* wsf = (LAS float*)(lds + DW_OFF) + wave * 64; LAS unsigned* flg = (LAS unsigned*)(lds + DW_OFF + 2048 - 16);
    f32x4 kr[8], vr[8], cr;
    __syncthreads();
    if (tid == 0) { flg[0] = 0u; flg[1] = 0u; }
    { const int ta = tile0 + ntile - 1; const int pid = ptab[b * NPAGES + (ta >> 1)]; const float* kb = ck + ((size_t)pid * PAGE + 64 * (ta & 1)) * 256;
#pragma unroll
      for (int i = 0; i < 8; ++i) kr[i] = *(const GAS f32x4*)(kb + 4 * (tid + 512 * i));
      if (tid < 256) cr = *(const GAS f32x4*)(CPL + (size_t)(ntile - 1) * 64 * AH + 4 * tid); }
    bool vhave = false;
#pragma unroll 1
    for (int tt = ntile - 1; tt >= 0; --tt) {
#pragma unroll
        for (int i = 0; i < 8; ++i) { const int idx = tid + 512 * i, tok = idx >> 6, w = idx & 63, hh = w >> 4, d = (w & 15) * 4;
            *(LAS v2u*)(lds + DK_OFF + hh * DK_HEAD + tok * DK_PITCH + d * 2) = (v2u){pk2(kr[i][0], kr[i][1]), pk2(kr[i][2], kr[i][3])}; }
        if (vhave) {
#pragma unroll
            for (int i = 0; i < 8; ++i) { const int idx = tid + 512 * i, tok = idx >> 6, w = idx & 63, hh = w >> 4, d = (w & 15) * 4;
                *(LAS v2u*)(lds + DV_OFF + hh * DV_HEAD + tok * DV_PITCH + d * 2) = (v2u){pk2(vr[i][0], vr[i][1]), pk2(vr[i][2], vr[i][3])}; } }
        if (tid < 256) *(LAS f32x4*)(lds + DC_OFF + 16 * tid) = cr;
        if (tid == 0) flg[(tt + 1) & 1] = 0u;
        __syncthreads();
        if (tt > 0) { const int t1 = tt - 1, ta = tile0 + t1; const int pid = ptab[b * NPAGES + (ta >> 1)]; const float* kb = ck + ((size_t)pid * PAGE + 64 * (ta & 1)) * 256;
#pragma unroll
            for (int i = 0; i < 8; ++i) kr[i] = *(const GAS f32x4*)(kb + 4 * (tid + 512 * i));
            if (tid < 256) cr = *(const GAS f32x4*)(CPL + (size_t)t1 * 64 * AH + 4 * tid); }
        f32x16 s; const LAS float* cp = (const LAS float*)(lds + DC_OFF);
#pragma unroll
        for (int q = 0; q < 16; ++q) s[q] = -cp[(32 * kh + crow(q, h)) * AH + hq];
#pragma unroll
        for (int ks = 0; ks < 4; ++ks) { const bf16x8 kf = *(LAS const bf16x8*)(lds + DK_OFF + kvh * DK_HEAD + (32 * kh + r) * DK_PITCH + (16 * ks + 8 * h) * 2); s = mfma32(kf, qf[ks], s); }
        float tm = s[0];
#pragma unroll
        for (int q = 1; q < 16; ++q) tm = fmaxf(tm, s[q]);
        { auto rr = __builtin_amdgcn_permlane32_swap(__float_as_uint(tm), __float_as_uint(tm), false, false); tm = fmaxf(__uint_as_float(rr[0]), __uint_as_float(rr[1])); }
        const bool need = __any(tm - m >= -152.f);
        if (need && lane == 0) flg[tt & 1] = 1u;
        __syncthreads();
        const bool need_any = (flg[tt & 1] != 0u);
        if (need_any) {
            if (!vhave) {
                const int ta = tile0 + tt; const int pid = ptab[b * NPAGES + (ta >> 1)]; const float* vb = cv + ((size_t)pid * PAGE + 64 * (ta & 1)) * 256;
#pragma unroll
                for (int i = 0; i < 8; ++i) vr[i] = *(const GAS f32x4*)(vb + 4 * (tid + 512 * i));
#pragma unroll
                for (int i = 0; i < 8; ++i) { const int idx = tid + 512 * i, tok = idx >> 6, w = idx & 63, hh = w >> 4, d = (w & 15) * 4;
                    *(LAS v2u*)(lds + DV_OFF + hh * DV_HEAD + tok * DV_PITCH + d * 2) = (v2u){pk2(vr[i][0], vr[i][1]), pk2(vr[i][2], vr[i][3])}; }
                __syncthreads();
            }
            if (tt > 0) { const int ta = tile0 + tt - 1; const int pid = ptab[b * NPAGES + (ta >> 1)]; const float* vb = cv + ((size_t)pid * PAGE + 64 * (ta & 1)) * 256;
#pragma unroll
                for (int i = 0; i < 8; ++i) vr[i] = *(const GAS f32x4*)(vb + 4 * (tid + 512 * i)); }
            if (need) {
                const float mn = fmaxf(m, tm), alpha = __builtin_amdgcn_exp2f(m - mn); m = mn;
                float ps = 0.f;
#pragma unroll
                for (int q = 0; q < 16; ++q) { s[q] = __builtin_amdgcn_exp2f(s[q] - mn); ps += s[q]; }
                l = l * alpha + ps;
                if (h == 0) wsf[r] = alpha;
                unsigned pp[8];
#pragma unroll
                for (int q = 0; q < 16; q += 2) pp[q >> 1] = pk2_t(s[q], s[q + 1]);
                const bf16x8 p0 = __builtin_bit_cast(bf16x8, (v4u){pp[0], pp[1], pp[2], pp[3]}), p1 = __builtin_bit_cast(bf16x8, (v4u){pp[4], pp[5], pp[6], pp[7]});
#pragma unroll
                for (int q = 0; q < 16; ++q) { const float a = wsf[crow(q, h)]; o[0][q] *= a; o[1][q] *= a; }
                LAS const unsigned char* vt = lds + DV_OFF + kvh * DV_HEAD;
#pragma unroll
                for (int dt = 0; dt < 2; ++dt) { const bf16x8 v0 = tr_frag(vt, DV_PITCH, 32 * kh + 4 * h, 32 * kh + 8 + 4 * h, 32 * dt, lane), v1 = tr_frag(vt, DV_PITCH, 32 * kh + 16 + 4 * h, 32 * kh + 24 + 4 * h, 32 * dt, lane);
                    o[dt] = mfma32(p0, v0, o[dt]); o[dt] = mfma32(p1, v1, o[dt]); }
            }
        }
        vhave = need_any && tt > 0;
        __syncthreads();
    }
    { auto rr = __builtin_amdgcn_permlane32_swap(__float_as_uint(l), __float_as_uint(l), false, false); l = __uint_as_float(rr[0]) + __uint_as_float(rr[1]); }
    float* part = (float*)(ws + WS_DPART) + ((size_t)(b * KVH + kvh) * 16 + 2 * sp + kh) * DPART_STRIDE;
    if (h == 0) { part[r] = m; part[32 + r] = l; }
#pragma unroll
    for (int dt = 0; dt < 2; ++dt)
#pragma unroll
        for (int q = 0; q < 16; ++q) part[64 + crow(q, h) * 64 + 32 * dt + r] = o[dt][q];
}

__device__ __forceinline__ void dec_combine(unsigned char* ws, int unit, int tid) {
    asm volatile("" : "+v"(tid));
    const int b = unit >> 2, kvh = unit & 3, j = tid >> 4, dq = tid & 15, g = j >> 3, qi = j & 7, hq = 4 * kvh + g;
    const bf16* Qb = (const bf16*)(ws + WS_Q); const bf16* Kb = (const bf16*)(ws + WS_K); const bf16* Vb = (const bf16*)(ws + WS_V); bf16* YA = (bf16*)(ws + WS_YA);
    const float* LOGF = (const float*)(ws + WS_LOGF); const float* CPL = (const float*)(ws + WS_CPL);
    const float* part = (const float*)(ws + WS_DPART) + (size_t)(b * KVH + kvh) * 16 * DPART_STRIDE;
    const size_t rq = (size_t)MP + 8 * b + qi;
    const v2u qw = *(const GAS v2u*)(Qb + rq * 1024 + hq * 64 + 4 * dq); const float q0 = bflo(qw.x), q1 = bfhi(qw.x), q2 = bflo(qw.y), q3 = bfhi(qw.y);
    float sn[8]; float cum = CPL[((size_t)b * PAST + PAST - 1) * AH + hq];
#pragma unroll
    for (int jj = 0; jj < 8; ++jj) { const size_t rk = (size_t)MP + 8 * b + jj; cum += LOGF[rk * AH + hq] * 1.4426950408889634f;
        const v2u kw = *(const GAS v2u*)(Kb + rk * 256 + kvh * 64 + 4 * dq); float d = q0 * bflo(kw.x) + q1 * bfhi(kw.x) + q2 * bflo(kw.y) + q3 * bfhi(kw.y);
        d += __shfl_xor(d, 1); d += __shfl_xor(d, 2); d += __shfl_xor(d, 4); d += __shfl_xor(d, 8);
        sn[jj] = (jj <= qi) ? d - cum : -1e30f; }
    float mp[16], M = -1e30f;
#pragma unroll
    for (int n = 0; n < 16; ++n) { mp[n] = part[(size_t)n * DPART_STRIDE + j]; M = fmaxf(M, mp[n]); }
#pragma unroll
    for (int jj = 0; jj < 8; ++jj) M = fmaxf(M, sn[jj]);
    float L = 0.f; f32x4 O = (f32x4){0.f, 0.f, 0.f, 0.f};
#pragma unroll
    for (int n = 0; n < 16; ++n) { const float w = __builtin_amdgcn_exp2f(mp[n] - M); L += w * part[(size_t)n * DPART_STRIDE + 32 + j];
        O += *(const f32x4*)(part + (size_t)n * DPART_STRIDE + 64 + j * 64 + 4 * dq) * w; }
#pragma unroll
    for (int jj = 0; jj < 8; ++jj) { const float w = __builtin_amdgcn_exp2f(sn[jj] - M); L += w; const size_t rk = (size_t)MP + 8 * b + jj;
        const v2u vw = *(const GAS v2u*)(Vb + rk * 256 + kvh * 64 + 4 * dq); O += (f32x4){bflo(vw.x), bfhi(vw.x), bflo(vw.y), bfhi(vw.y)} * w; }
    const float il = 1.f / L;
    *(GAS v2u*)(YA + rq * 1024 + hq * 64 + 4 * dq) = (v2u){pk2(O[0] * il, O[1] * il), pk2(O[2] * il, O[3] * il)};
}
template <bool OUT8 = false> struct SResidT {
    const float* resF; const bf16* resB; float* outF; bf16* outB; pg8::ssq_t* ssq; float alpha;
    __device__ __forceinline__ void operator()(int row, int col, f32x4 v, int t) const {
        f32x4 rr; if (resF) rr = *(const f32x4*)(resF + (size_t)row * 1024 + col); else { const v2u w = *(const GAS v2u*)(resB + (size_t)row * 1024 + col); rr = (f32x4){bflo(w.x), bfhi(w.x), bflo(w.y), bfhi(w.y)}; }
        const f32x4 o = rr + v * alpha;
        if (outF) *(f32x4*)(outF + (size_t)row * 1024 + col) = o;
        if (outB) *(GAS v2u*)(outB + (size_t)row * 1024 + col) = (v2u){pk2(o[0], o[1]), pk2(o[2], o[3])};
        if constexpr (OUT8) { int w = 0; const f32x4 q = o * pg8::H2_F8_SCALE; w = __builtin_amdgcn_cvt_pk_fp8_f32(__builtin_amdgcn_fmed3f(q[0], -448.f, 448.f), __builtin_amdgcn_fmed3f(q[1], -448.f, 448.f), w, false);
            w = __builtin_amdgcn_cvt_pk_fp8_f32(__builtin_amdgcn_fmed3f(q[2], -448.f, 448.f), __builtin_amdgcn_fmed3f(q[3], -448.f, 448.f), w, true);
            *(GAS unsigned*)((unsigned char*)outB + ((WS_H2F8 + (size_t)MP * 1024) - (WS_XB + (size_t)MP * 2048)) + (size_t)row * 1024 + col) = (unsigned)w; }
        if (ssq) { float s = (o[0] * o[0] + o[1] * o[1]) + (o[2] * o[2] + o[3] * o[3]); s += __shfl_xor(s, 1); s += __shfl_xor(s, 2); s += __shfl_xor(s, 4);
            if ((t & 7) == 0) __hip_atomic_fetch_add(ssq + row, pg8::ssq_fx(s), __ATOMIC_RELAXED, __HIP_MEMORY_SCOPE_AGENT); } }
};
using SResid = SResidT<false>;
struct SGateMul { const bf16* G; bf16* MPo;
    __device__ __forceinline__ void operator()(int row, int col, f32x4 v, int) const { const v2u g = *(const GAS v2u*)(G + (size_t)row * 1024 + col);
        const f32x4 o = (f32x4){bflo(g.x), bfhi(g.x), bflo(g.y), bfhi(g.y)} * v; *(GAS v2u*)(MPo + (size_t)row * 1024 + col) = (v2u){pk2(o[0], o[1]), pk2(o[2], o[3])}; } };
struct SGateAdd { const bf16* G; const bf16* MPi; bf16* O;
    __device__ __forceinline__ void operator()(int row, int col, f32x4 v, int) const { const v2u g = *(const GAS v2u*)(G + (size_t)row * 1024 + col), m = *(const GAS v2u*)(MPi + (size_t)row * 1024 + col);
        const f32x4 o = (f32x4){bflo(m.x), bfhi(m.x), bflo(m.y), bfhi(m.y)} + (f32x4){bflo(g.x), bfhi(g.x), bflo(g.y), bfhi(g.y)} * v;
        *(GAS v2u*)(O + (size_t)row * 1024 + col) = (v2u){pk2(o[0], o[1]), pk2(o[2], o[3])}; } };
template <int K, class Epi> __device__ __forceinline__ void smallm_phase(const bf16* A, const bf16* Bt, LAS unsigned char* lds, const Epi& E, int G) {
    int tid = threadIdx.x; asm volatile("" : "+v"(tid));
    const int lane = tid & 63, wave = __builtin_amdgcn_readfirstlane(tid >> 6), r = lane & 31, h = lane >> 5;
    constexpr int KW = K / 8, NS = KW / 16;
    LAS float* red = (LAS float*)lds;
    for (int tile = (int)blockIdx.x; tile < 256; tile += G) {
        const int tm = tile >> 5, tn = tile & 31;
        const bf16* ap = A + (size_t)(32 * tm + r) * K + wave * KW + 8 * h; const bf16* bp = Bt + (size_t)(32 * tn + r) * K + wave * KW + 8 * h;
        f32x16 acc = (f32x16){};
        constexpr int UN = (NS % 11 == 0) ? 11 : 8;
#pragma unroll 1
        for (int k0 = 0; k0 < NS; k0 += UN) { bf16x8 a[UN], b[UN];
#pragma unroll
            for (int k = 0; k < UN; ++k) { a[k] = *(const bf16x8*)(ap + 16 * (k0 + k)); b[k] = *(const bf16x8*)(bp + 16 * (k0 + k)); }
#pragma unroll
            for (int k = 0; k < UN; ++k) acc = mfma32(a[k], b[k], acc); }
        __syncthreads();
#pragma unroll
        for (int q = 0; q < 16; ++q) red[(wave * 32 + crow(q, h)) * 33 + r] = acc[q];
        __syncthreads();
        if (tid < 256) { const int row = tid >> 3, c4 = (tid & 7) * 4; f32x4 v = (f32x4){0.f, 0.f, 0.f, 0.f};
#pragma unroll
            for (int w = 0; w < 8; ++w) { const LAS float* p = red + (w * 32 + row) * 33 + c4; v += (f32x4){p[0], p[1], p[2], p[3]}; }
            E(32 * tm + row, 32 * tn + c4, v, tid); }
    }
    __syncthreads();
}
constexpr int NPHASE = 11;
struct Args { const float* in[30]; const int* page_table; float* out; unsigned char* ws; int ph_lo, ph_hi; };
static_assert(sizeof(Args) == 30 * 8 + 8 + 8 + 8 + 8, "Args has no padding bytes");
enum { I_XP = 0, I_XS, I_CK, I_CV, I_CLF, I_SSM, I_SCONV, I_PT, I_F1N, I_F1G, I_F1U, I_F1D, I_MIXN, I_WIN, I_CONVW, I_CONVB, I_DTB, I_ALOG, I_DSKIP, I_SSDN, I_QN, I_KN, I_BF,
       I_WSP, I_WAP, I_WO, I_F2N, I_F2G, I_F2U, I_F2D };

__global__ void __launch_bounds__(NWAVES * 64, 2) mega_fwd(Args args) {
    extern __shared__ __attribute__((aligned(16))) unsigned char lds_raw[];
    LAS unsigned char* lds = (LAS unsigned char*)lds_raw;
    volatile LAS unsigned* MISC = (volatile LAS unsigned*)(lds + MISC_OFF);
    const int tid = threadIdx.x, lane = tid & 63, wave = __builtin_amdgcn_readfirstlane(tid >> 6);
    const int G = gridDim.x; const int vcu = (G % 8 == 0) ? ((int)blockIdx.x % 8) * (G / 8) + (int)blockIdx.x / 8 : (int)blockIdx.x;
    unsigned char* ws = args.ws; float* dout = args.out;
    gu32* ctl = (gu32*)(ws + WS_CTL);
    for (int u = tid; u < 64; u += NWAVES * 64) MISC[u] = 0u;
    __syncthreads();
    XcdBarrier bar = xcd_barrier_post((unsigned*)ctl + CW_BAR, MISC + 8);
    const int lo = args.ph_lo, hi = args.ph_hi;
#define IN(k) (lo <= (k) && (k) < hi)
#define SEAM(k) do { if (IN(k) && IN((k) + 1)) xcd_barrier(bar); } while (0)
    const int gw = vcu * NWAVES + wave, NGW = G * NWAVES;
    pg8::ssq_t* ssqX = (pg8::ssq_t*)(ws + WS_SSQX); pg8::ssq_t* ssqH = (pg8::ssq_t*)(ws + WS_CTL + CTL_SSQH); pg8::ssq_t* ssqH2 = (pg8::ssq_t*)(ws + WS_CTL + CTL_SSQH2);
    bf16 *Wgu1 = (bf16*)(ws + WS_WGU1), *Wd1 = (bf16*)(ws + WS_WD1), *Win = (bf16*)(ws + WS_WIN), *Wsp = (bf16*)(ws + WS_WSP), *Wap = (bf16*)(ws + WS_WAP), *Wo = (bf16*)(ws + WS_WO),
         *Wgu2 = (bf16*)(ws + WS_WGU2), *Wd2 = (bf16*)(ws + WS_WD2);
    bf16 *XB = (bf16*)(ws + WS_XB), *ACT = (bf16*)(ws + WS_ACT), *HB = (bf16*)(ws + WS_HB), *Zb = (bf16*)(ws + WS_Z), *XBC = (bf16*)(ws + WS_XBC), *Qb = (bf16*)(ws + WS_Q), *Kb = (bf16*)(ws + WS_K),
         *Vb = (bf16*)(ws + WS_V), *GSb = (bf16*)(ws + WS_GS), *GAb = (bf16*)(ws + WS_GA);
    float *DTf = (float*)(ws + WS_DT), *LOGFf = (float*)(ws + WS_LOGF);

    constexpr int I_GU = (5632 / 64) * (1024 / 64), I_D = (1024 / 64) * (2816 / 64), I_W = (NWIN / 64) * (1024 / 64), I_SP = (1024 / 64) * (2048 / 64), I_SQ = (1024 / 64) * (1024 / 64);
    constexpr int T_GU1 = I_GU, T_D1 = T_GU1 + I_D, T_WIN = T_D1 + I_W, T_SP = T_WIN + I_SP, T_AP = T_SP + I_SQ, T_WO = T_AP + I_SQ, T_GU2 = T_WO + I_GU, T_END = T_GU2 + I_D;
#define TRANSPOSE_RANGE(LO, HI, IDX, NIDX) do { LAS float* scr = (LAS float*)(lds + RING_OFF + wave * 16640);     \
        for (int it = (LO) + (IDX); it < (HI); it += (NIDX)) { int r = it; \
            if (r < T_GU1) { if ((r % 88) & 2) p0_transpose_item(MapGU{args.in[I_F1U]}, args.in[I_F1N], 1024, Wgu1, scr, r / 88, r % 88, lane); else p0_transpose_item(MapGU{args.in[I_F1G]}, args.in[I_F1N], 1024, Wgu1, scr, r / 88, r % 88, lane); continue; } r -= T_GU1; \
            if (r < I_D) { p0_transpose_item(MapPlain{args.in[I_F1D], 1024}, nullptr, 2816, Wd1, scr, r / 16, r % 16, lane); continue; } r -= I_D; \
            if (r < I_W) { p0_transpose_item(MapWin{args.in[I_WIN]}, args.in[I_MIXN], 1024, Win, scr, r / 140, r % 140, lane); continue; } r -= I_W; \
            if (r < I_SP) { p0_transpose_item(MapPlain{args.in[I_WSP], 1024}, nullptr, 2048, Wsp, scr, r / 16, r % 16, lane); continue; } r -= I_SP; \
            if (r < I_SQ) { p0_transpose_item(MapPlain{args.in[I_WAP], 1024}, nullptr, 1024, Wap, scr, r / 16, r % 16, lane); continue; } r -= I_SQ; \
            if (r < I_SQ) { p0_transpose_item(MapPlain{args.in[I_WO], 1024}, nullptr, 1024, Wo, scr, r / 16, r % 16, lane); continue; } r -= I_SQ; \
            if (r < I_GU) { if ((r % 88) & 2) p0_transpose_item(MapGU{args.in[I_F2U]}, args.in[I_F2N], 1024, (bf16*)nullptr, scr, r / 88, r % 88, lane, ws + WS_WGU2F8, pg8::WGU_F8_SCALE); else p0_transpose_item(MapGU{args.in[I_F2G]}, args.in[I_F2N], 1024, (bf16*)nullptr, scr, r / 88, r % 88, lane, ws + WS_WGU2F8, pg8::WGU_F8_SCALE); continue; } r -= I_GU; \
            p0_transpose_item(MapPlain{args.in[I_F2D], 1024}, nullptr, 2816, Wd2, scr, r / 16, r % 16, lane, ws + WS_WD2F8, pg8::WD_F8_SCALE); } } while (0)
    if (IN(0)) {
        if (G == 256) { TRANSPOSE_RANGE(0, T_GU1, gw, NGW); } else { TRANSPOSE_RANGE(0, T_END, gw, NGW); }
        for (int m = 2 * gw; m < MT; m += 2 * NGW) { const float* xr = (m < MP) ? args.in[I_XP] + (size_t)m * 1024 : args.in[I_XS] + (size_t)(m - MP) * 1024; p0_rows_to_bf16(xr, XB + (size_t)m * 1024, ssqX + m, lane); }
        if (blockIdx.x == 0 && tid < 256) { float* par = (float*)(ws + WS_PAR); float v;
            if (tid < 64) v = args.in[I_QN][tid]; else if (tid < 128) v = args.in[I_KN][tid - 64]; else if (tid < 160) v = args.in[I_DTB][tid - 128]; else if (tid < 176) v = args.in[I_BF][tid - 160];
            else if (tid < 192) v = 0.f; else if (tid < 224) v = args.in[I_ALOG][tid - 192]; else v = args.in[I_DSKIP][tid - 224];
            par[tid] = v; }
        if (G != 256) { for (int it = gw; it < DECB * NPAGES; it += NGW) ptot_item(ws, args.in[I_CLF], args.page_table, it, lane); }
    }
    SEAM(0);
    if (IN(1)) {
        if (G == 256 && blockIdx.x >= 150) { TRANSPOSE_RANGE(T_GU1, T_WIN, ((int)blockIdx.x - 150) * NWAVES + wave, 106 * NWAVES);
            for (int it = ((int)blockIdx.x - 150) * NWAVES + wave; it < DECB * NPAGES; it += 106 * NWAVES) ptot_item(ws, args.in[I_CLF], args.page_table, it, lane);
            __syncthreads(); }
        pg8::Gemm g{XB, Wgu1, MT, 5632, 1024}; pg8::StaticOrder S; S.init(MT, 5632, G, (int)blockIdx.x);
        pg8::EpiSwiglu E{ACT, ssqX, 1.f};
        pg8::gemm_phase<pg8::EpiSwiglu, pg8::StaticOrder, true, true>(lds + RING_OFF, g, S, E);
    }
    SEAM(1);
    if (IN(2)) {
        pg8::Gemm g{ACT, Wd1, MP, 1024, DFF}; pg8::StaticOrder S; S.init(MP, 1024, G, (int)blockIdx.x);
        pg8::EpiResid E{args.in[I_XP], nullptr, nullptr, HB, ssqH, 0.5f};
        pg8::gemm_phase<pg8::EpiResid, pg8::StaticOrder, true, true>(lds + RING_OFF, g, S, E);
        smallm_phase<DFF>(ACT + (size_t)MP * DFF, Wd1, lds, SResid{args.in[I_XS], nullptr, nullptr, HB + (size_t)MP * 1024, ssqH + MP, 0.5f}, G);
    }
    SEAM(2);
    if (IN(3)) {
        if (G == 256 && ((blockIdx.x >> 3) & 1)) { TRANSPOSE_RANGE(T_WIN, T_END, ((int)blockIdx.x >> 4) * 8 * NWAVES + ((int)blockIdx.x & 7) * NWAVES + wave, 128 * NWAVES); __syncthreads(); }
        pg8::Gemm g{HB, Win, MT, NWIN, 1024}; pg8::StaticOrder S; S.init(MT, NWIN, G, (int)blockIdx.x);
        pg8::EpiWin E{ws, dout};
        pg8::gemm_phase<pg8::EpiWin, pg8::StaticOrder, true, true>(lds + RING_OFF, g, S, E);
    }
    SEAM(3);
    if (IN(4)) {
        { LAS unsigned char* wl = lds + wave * P4S_WAVE;
          if (NGW == 2048) { const int half = vcu * 4 + (wave >> 1);
              if ((wave & 1) == 0) p4s_item(ws, dout, args.in[I_CONVW], args.in[I_CONVB], args.in[I_SCONV], args.in[I_SSM], wl, half, lane);
              else if (half < NBATCH * AH) ck_item(ws, half, lane);
          } else {
              for (int it = gw; it < NBATCH * AH; it += NGW) ck_item(ws, it, lane);
              for (int it = gw; it < DECB * SH; it += NGW) p4s_item(ws, dout, args.in[I_CONVW], args.in[I_CONVB], args.in[I_SCONV], args.in[I_SSM], wl, it, lane);
          }
          for (int it = gw; it < DECB * NPAGES; it += NGW) cpl_item(ws, args.in[I_CLF], args.page_table, it, lane); }
        for (int i = (int)blockIdx.x * 512 + tid; i < NBATCH * 3 * CONVD; i += G * 512) { const int bb = i / (3 * CONVD), rem = i % (3 * CONVD), j = rem / CONVD, col = rem % CONVD;
            dout[O_CONVP + i] = __uint_as_float((unsigned)XBC[((size_t)bb * SEQ + SEQ - 3 + j) * CONVD + col] << 16); }
        for (int u = (int)blockIdx.x; u < 512; u += G) p4_unit(ws, args.in[I_CONVW], args.in[I_CONVB], lds, u, tid, lane, wave);
        __syncthreads();
    }
    SEAM(4);
    if (IN(5)) {
        for (int it = gw; it < MS * SG; it += NGW) p4s_norm_item(ws, args.in[I_SSDN], it, lane);
        p5_scan(ws, dout, (int)blockIdx.x * 512 + tid, G * 512);
        const attn_body::AttnTensors AT{(const attn_body::bf16*)Qb, (const attn_body::bf16*)Kb, (const attn_body::bf16*)Vb, (attn_body::bf16*)(ws + WS_YA), (const float*)(ws + WS_CK)};
        const float skip_thr = 153.f + 2.f * sqrtf(__uint_as_float(__hip_atomic_load((unsigned*)ctl + CW_QMAX2, RLX_AGENT)) * __uint_as_float(__hip_atomic_load((unsigned*)ctl + CW_KMAX2, RLX_AGENT))) * 1.0001f;
        const int nbefore = ((blockIdx.x >> 3) & 1) ? 0 : 4;
        attn_body::attn_phase<8>((char*)lds_raw, AT, skip_thr, vcu, G, 0, nbefore);
        __syncthreads();
        for (int u = (int)blockIdx.x; u < DECB * 8; u += G) dec_unit(ws, args.in[I_CK], args.in[I_CV], args.page_table, lds, u, tid, lane, wave);
        __syncthreads();
        attn_body::attn_phase<8>((char*)lds_raw, AT, skip_thr, vcu, G, nbefore, 4);
    }
    SEAM(5);
    if (IN(6)) { for (int u = (int)blockIdx.x; u < DECB * KVH; u += G) dec_combine(ws, u, tid);
        for (int u = (int)blockIdx.x; u < 512; u += G) p6_unit(ws, args.in[I_SSDN], lds, u, tid, lane, wave); __syncthreads(); }
    SEAM(6);
    if (IN(7)) {
        { pg8::Gemm g{(const bf16*)(ws + WS_YS), Wsp, MP, 1024, DSSM}; pg8::StaticOrder S; S.init(MP, 1024, G, (int)blockIdx.x);
          pg8::EpiGateMul E{GSb, (bf16*)(ws + WS_MP)};
          pg8::gemm_phase<pg8::EpiGateMul, pg8::StaticOrder, true, true>(lds + RING_OFF, g, S, E); }
        { pg8::Gemm g{(const bf16*)(ws + WS_YA), Wap, MP, 1024, 1024}; pg8::StaticOrder S; S.init(MP, 1024, G, (int)blockIdx.x);
          pg8::EpiGateAdd E{GAb, (const bf16*)(ws + WS_MP), (bf16*)(ws + WS_MG)};
          pg8::gemm_phase<pg8::EpiGateAdd, pg8::StaticOrder, true, true>(lds + RING_OFF, g, S, E); }
        smallm_phase<DSSM>((const bf16*)(ws + WS_YS) + (size_t)MP * DSSM, Wsp, lds, SGateMul{GSb + (size_t)MP * 1024, (bf16*)(ws + WS_MP) + (size_t)MP * 1024}, G);
        smallm_phase<1024>((const bf16*)(ws + WS_YA) + (size_t)MP * 1024, Wap, lds, SGateAdd{GAb + (size_t)MP * 1024, (const bf16*)(ws + WS_MP) + (size_t)MP * 1024, (bf16*)(ws + WS_MG) + (size_t)MP * 1024}, G);
    }
    SEAM(7);
    if (IN(8)) {
        pg8::Gemm g{(const bf16*)(ws + WS_MG), Wo, MP, 1024, 1024}; pg8::StaticOrder S; S.init(MP, 1024, G, (int)blockIdx.x);
        pg8::EpiResidT<false, true> E{nullptr, HB, nullptr, XB, ssqH2, 1.0f};
        pg8::gemm_phase<pg8::EpiResidT<false, true>, pg8::StaticOrder, true, true>(lds + RING_OFF, g, S, E);
        smallm_phase<1024>((const bf16*)(ws + WS_MG) + (size_t)MP * 1024, Wo, lds, SResidT<true>{nullptr, HB + (size_t)MP * 1024, nullptr, XB + (size_t)MP * 1024, ssqH2 + MP, 1.0f}, G);
    }
    SEAM(8);
    if (IN(9)) {
        pg8::Gemm g{(const bf16*)(ws + WS_H2F8), (const bf16*)(ws + WS_WGU2F8), MT, 5632, 512}; pg8::StaticOrder S; S.init(MT, 5632, G, (int)blockIdx.x);
        pg8::EpiSwigluT<true, true> E{ACT, ssqH2, 1.f / (pg8::H2_F8_SCALE * pg8::WGU_F8_SCALE)};
        pg8::gemm_phase<pg8::EpiSwigluT<true, true>, pg8::StaticOrder, true, true>(lds + RING_OFF, g, S, E);
    }
    SEAM(9);
    if (IN(10)) {
        pg8::Gemm g{ACT, (const bf16*)(ws + WS_WD2F8), MP, 1024, DFF / 2}; pg8::StaticOrder S; S.init(MP, 1024, G, (int)blockIdx.x);
        pg8::EpiResidT<true> E{nullptr, XB, dout, nullptr, nullptr, 0.5f / (pg8::ACT_F8_SCALE * pg8::WD_F8_SCALE)};
        pg8::gemm_phase<pg8::EpiResidT<true>, pg8::StaticOrder, true, true>(lds + RING_OFF, g, S, E);
        smallm_phase<DFF>(ACT + (size_t)MP * DFF, Wd2, lds, SResid{nullptr, XB + (size_t)MP * 1024, dout + (size_t)MP * 1024, nullptr, nullptr, 0.5f}, G);
    }
#undef IN
#undef SEAM
}

extern "C" void kernel_launch(void* const* d_in, const int* in_sizes, int n_in, void* d_out, int out_size, void* d_ws, size_t ws_size, hipStream_t stream) {
    static int grid = 0;
    if (grid == 0) {
        if (n_in != 30 || (size_t)out_size != O_END || ws_size < WS_END) { fprintf(stderr, "kernel_launch: unexpected problem (n_in %d, out %d, ws %zu)\n", n_in, out_size, ws_size); grid = -1; return; }
        int dev = 0, cus = 0, per_cu = 0;
        if (hipGetDevice(&dev) != hipSuccess || hipDeviceGetAttribute(&cus, hipDeviceAttributeMultiprocessorCount, dev) != hipSuccess) { grid = -1; return; }
        if (hipFuncSetAttribute((const void*)mega_fwd, hipFuncAttributeMaxDynamicSharedMemorySize, LDS_BYTES) != hipSuccess) { fprintf(stderr, "kernel_launch: hipFuncSetAttribute failed\n"); grid = -1; return; }
        if (hipOccupancyMaxActiveBlocksPerMultiprocessor(&per_cu, (const void*)mega_fwd, NWAVES * 64, LDS_BYTES) != hipSuccess || per_cu < 1) { fprintf(stderr, "kernel_launch: occupancy query reports %d\n", per_cu); }
        (void)hipGetLastError();
        grid = cus;
    }
    if (grid < 0) return;
    if (hipMemsetAsync((char*)d_ws + WS_CTL, 0, CTL_ZERO_BYTES, stream) != hipSuccess) return;
    Args a{};
    for (int i = 0; i < 30; ++i) a.in[i] = (const float*)d_in[i];
    a.page_table = (const int*)d_in[I_PT]; a.out = (float*)d_out; a.ws = (unsigned char*)d_ws; a.ph_lo = 0; a.ph_hi = NPHASE;
    hipLaunchKernelGGL(mega_fwd, dim3(grid), dim3(NWAVES * 64), LDS_BYTES, stream, a);
}
```
